# Optimizing an MI355X kernel written in HIP

```python
import jax, jax.numpy as jnp
from jax import lax
import numpy as np

D_MODEL = 1024
BATCH = 2
SEQ = 8192
DEPTH = 2

POOL_WINDOWS = (2, 4, 8, 16)
POOL_GROUPS = 4
POOL_CH = D_MODEL // 8
POOL_WIDTH = POOL_GROUPS * POOL_CH
CONV_WIDTH = D_MODEL // 2
CONV_K = 31
SGU_CHUNK = 128
SGU_HEADS = 4
SGU_HEAD_DIM = D_MODEL // 8
SGU_WIDTH = SGU_HEADS * SGU_HEAD_DIM
N_BRANCH = 3
BRANCH_WIDTH = 512
IN_WIDTH = POOL_WIDTH + 2 * CONV_WIDTH + 2 * SGU_WIDTH + N_BRANCH * D_MODEL
N_EXPERTS = 32
TOP_K = 4
D_FF = D_MODEL
SWIGLU_LIMIT = 7.0
SWIGLU_ALPHA = 1.702
MOE_BLOCK = 256
PLE_DIM = 256
EPS = 1e-6

kernel_name = "hybrid_pool_conv_sgu_moe_block"


def rms_norm(x, g):
    xf = x.astype(jnp.float32)
    y = xf * lax.rsqrt(jnp.mean(xf * xf, axis=-1, keepdims=True) + EPS)
    return (y * g.astype(jnp.float32)).astype(x.dtype)


def layer_norm(x, g, b):
    xf = x.astype(jnp.float32)
    mu = jnp.mean(xf, axis=-1, keepdims=True)
    var = jnp.mean(jnp.square(xf - mu), axis=-1, keepdims=True)
    y = (xf - mu) * lax.rsqrt(var + EPS)
    return (y * g.astype(jnp.float32) + b.astype(jnp.float32)).astype(x.dtype)


def causal_multiscale_pool(z, pool_w, pool_scale):
    B, S, _ = z.shape
    zf = z.astype(jnp.float32).reshape(B, S, POOL_GROUPS, POOL_CH)
    cs = jnp.cumsum(zf, axis=1)
    t = jnp.arange(S)
    outs = []
    for g, w in enumerate(POOL_WINDOWS):
        c = cs[:, :, g]
        prev = jnp.pad(c, ((0, 0), (w, 0), (0, 0)))[:, :S]
        count = jnp.minimum(t + 1, w).astype(jnp.float32)[None, :, None]
        outs.append((c - prev) / count - zf[:, :, g])
    pooled = jnp.stack(outs, axis=2).astype(z.dtype)
    mixed = jnp.einsum('bsgc,gcd->bsgd', pooled, pool_w).reshape(B, S, POOL_WIDTH)
    return mixed * pool_scale


def causal_depthwise_conv(z, w, b):
    K, C = w.shape
    y = lax.conv_general_dilated(z, w[:, None, :], window_strides=(1,), padding=((K - 1, 0),),
                                 dimension_numbers=('NWC', 'WIO', 'NWC'), feature_group_count=C)
    return y + b


def conformer_conv(z, conv_w, conv_b, norm_g, norm_b):
    a, gate = jnp.split(z, 2, axis=-1)
    y = a * jax.nn.sigmoid(gate)
    y = causal_depthwise_conv(y, conv_w, conv_b)
    y = layer_norm(y, norm_g, norm_b)
    return jax.nn.silu(y)


def chunked_spatial_gating(u, v, norm_g, norm_b, sgu_w, sgu_b):
    B, S, _ = v.shape
    n = S // SGU_CHUNK
    v = layer_norm(v, norm_g, norm_b)
    vh = v.reshape(B, n, SGU_CHUNK, SGU_HEADS, SGU_HEAD_DIM)
    mask = jnp.tril(jnp.ones((SGU_CHUNK, SGU_CHUNK), dtype=bool))
    w = jnp.where(mask[None], sgu_w, jnp.zeros_like(sgu_w))
    mixed = jnp.einsum('hts,bnshc->bnthc', w, vh) + sgu_b.T[None, None, :, :, None]
    return u * mixed.reshape(B, S, SGU_WIDTH)


def mixer_block(h, w_in, b_in, pool_w, pool_scale, conv_w, conv_b, conv_norm_g, conv_norm_b,
                sgu_norm_g, sgu_norm_b, sgu_w, sgu_b, branch_w, branch_b, w_out):
    B, S, D = h.shape
    z = h @ w_in + b_in
    cuts = np.cumsum([POOL_WIDTH, 2 * CONV_WIDTH, SGU_WIDTH, SGU_WIDTH]).tolist()
    za, zb, zu, zv, zg = jnp.split(z, cuts, axis=-1)
    ya = causal_multiscale_pool(za, pool_w, pool_scale)
    yb = conformer_conv(zb, conv_w, conv_b, conv_norm_g, conv_norm_b)
    yc = chunked_spatial_gating(zu, zv, sgu_norm_g, sgu_norm_b, sgu_w, sgu_b)
    branches = jnp.stack([ya, yb, yc], axis=2)
    proj = jnp.einsum('bskc,kcd->bskd', branches, branch_w) + branch_b
    gates = jax.nn.sigmoid(zg.reshape(B, S, N_BRANCH, D))
    merged = jnp.einsum('bskd,bskd->bsd', gates, proj)
    return merged @ w_out


def moe_ffn(h, router_w, router_b, w_up, b_up, w_down, b_down):
    B, S, D = h.shape
    hf = h.reshape(B * S, D)
    T = hf.shape[0]
    logits = (hf @ router_w + router_b).astype(jnp.float32)
    top_val, top_idx = lax.top_k(logits, TOP_K)
    weights = jax.nn.softmax(top_val, axis=-1)
    flat_e = top_idx.reshape(-1)
    order = jnp.argsort(flat_e)
    sorted_e = flat_e[order]
    tok = (order // TOP_K).astype(jnp.int32)
    gate = weights.reshape(-1)[order].astype(h.dtype)
    counts = jnp.bincount(flat_e, length=N_EXPERTS)
    padded = (counts + MOE_BLOCK - 1) // MOE_BLOCK * MOE_BLOCK
    pad_start = jnp.cumsum(padded) - padded
    start = jnp.cumsum(counts) - counts
    dest = pad_start[sorted_e] + jnp.arange(T * TOP_K) - start[sorted_e]
    n_blocks = -(-(T * TOP_K) // MOE_BLOCK) + N_EXPERTS
    rows = n_blocks * MOE_BLOCK
    slot_tok = jnp.zeros((rows,), jnp.int32).at[dest].set(tok)
    slot_gate = jnp.zeros((rows,), h.dtype).at[dest].set(gate)
    block_e = jnp.searchsorted(jnp.cumsum(padded), jnp.arange(n_blocks) * MOE_BLOCK, side='right')
    block_e = jnp.minimum(block_e, N_EXPERTS - 1)

    def run_block(args):
        tok_b, gate_b, e = args
        xb = hf[tok_b]
        gu = xb @ w_up[e] + b_up[e]
        x_glu, x_lin = jnp.split(gu, 2, axis=-1)
        x_glu = jnp.minimum(x_glu, SWIGLU_LIMIT)
        x_lin = jnp.clip(x_lin, -SWIGLU_LIMIT, SWIGLU_LIMIT)
        act = x_glu * jax.nn.sigmoid(SWIGLU_ALPHA * x_glu) * (x_lin + 1.0)
        y = act @ w_down[e] + b_down[e]
        return y * gate_b[:, None]

    ys = lax.map(run_block, (slot_tok.reshape(n_blocks, MOE_BLOCK),
                             slot_gate.reshape(n_blocks, MOE_BLOCK), block_e))
    out = jnp.zeros_like(hf).at[slot_tok].add(ys.reshape(rows, D))
    return out.reshape(B, S, D)


def setup_inputs(seed: int = 0) -> dict:
    key = jax.random.key(seed)
    ks = iter(jax.random.split(key, 40))
    f32 = jnp.float32
    L, D = DEPTH, D_MODEL

    def nrm(shape, scale):
        return jax.random.normal(next(ks), shape, f32) * scale

    def gain(shape):
        return 1.0 + nrm(shape, 0.05)

    return {
        "x": nrm((BATCH, SEQ, D), 1.0),
        "p": nrm((L, BATCH, SEQ, PLE_DIM), 1.0),
        "mix_norm": gain((L, D)),
        "w_in": nrm((L, D, IN_WIDTH), D ** -0.5),
        "b_in": nrm((L, IN_WIDTH), 0.02),
        "pool_w": nrm((L, POOL_GROUPS, POOL_CH, POOL_CH), POOL_CH ** -0.5),
        "pool_scale": gain((L, POOL_WIDTH)),
        "conv_w": nrm((L, CONV_K, CONV_WIDTH), CONV_K ** -0.5),
        "conv_b": nrm((L, CONV_WIDTH), 0.02),
        "conv_norm_g": gain((L, CONV_WIDTH)),
        "conv_norm_b": nrm((L, CONV_WIDTH), 0.02),
        "sgu_norm_g": gain((L, SGU_WIDTH)),
        "sgu_norm_b": nrm((L, SGU_WIDTH), 0.02),
        "sgu_w": nrm((L, SGU_HEADS, SGU_CHUNK, SGU_CHUNK), 0.5 * SGU_CHUNK ** -0.5),
        "sgu_b": gain((L, SGU_HEADS, SGU_CHUNK)),
        "branch_w": nrm((L, N_BRANCH, BRANCH_WIDTH, D), BRANCH_WIDTH ** -0.5),
        "branch_b": nrm((L, N_BRANCH, D), 0.02),
        "w_out": nrm((L, D, D), D ** -0.5),
        "moe_norm": gain((L, D)),
        "router_w": nrm((L, D, N_EXPERTS), D ** -0.5),
        "router_b": nrm((L, N_EXPERTS), 0.01),
        "expert_w_up": nrm((L, N_EXPERTS, D, 2 * D_FF), D ** -0.5),
        "expert_b_up": nrm((L, N_EXPERTS, 2 * D_FF), 0.02),
        "expert_w_down": nrm((L, N_EXPERTS, D_FF, D), D_FF ** -0.5),
        "expert_b_down": nrm((L, N_EXPERTS, D), 0.02),
        "ple_norm": gain((L, D)),
        "ple_gate_w": nrm((L, D, D), D ** -0.5),
        "ple_proj_w": nrm((L, PLE_DIM, D), PLE_DIM ** -0.5),
        "final_norm": gain((D,)),
    }


def reference(x, p, mix_norm, w_in, b_in, pool_w, pool_scale, conv_w, conv_b, conv_norm_g,
              conv_norm_b, sgu_norm_g, sgu_norm_b, sgu_w, sgu_b, branch_w, branch_b, w_out,
              moe_norm, router_w, router_b, expert_w_up, expert_b_up, expert_w_down,
              expert_b_down, ple_norm, ple_gate_w, ple_proj_w, final_norm):
    for i in range(DEPTH):
        h = rms_norm(x, mix_norm[i])
        x = x + mixer_block(h, w_in[i], b_in[i], pool_w[i], pool_scale[i], conv_w[i], conv_b[i],
                            conv_norm_g[i], conv_norm_b[i], sgu_norm_g[i], sgu_norm_b[i],
                            sgu_w[i], sgu_b[i], branch_w[i], branch_b[i], w_out[i])
        h = rms_norm(x, moe_norm[i])
        x = x + moe_ffn(h, router_w[i], router_b[i], expert_w_up[i], expert_b_up[i],
                        expert_w_down[i], expert_b_down[i])
        h = rms_norm(x, ple_norm[i])
        x = x + jax.nn.sigmoid(h @ ple_gate_w[i]) * (p[i] @ ple_proj_w[i])
    return rms_norm(x, final_norm)
```

```cpp
#include <hip/hip_runtime.h>
#include <hip/hip_cooperative_groups.h>
#include <cstdio>
#include <cstdint>
namespace cg = cooperative_groups;

#ifndef MK_N_LAUNCHES
#define MK_N_LAUNCHES 1
#endif

#define LAS __attribute__((address_space(3)))
#define GAS __attribute__((address_space(1)))
typedef unsigned short bf16_t;
typedef short bf16x8 __attribute__((ext_vector_type(8)));
typedef float f32x4 __attribute__((ext_vector_type(4)));
typedef float f32x16 __attribute__((ext_vector_type(16)));
typedef float f32x2 __attribute__((ext_vector_type(2)));
typedef unsigned u32x4 __attribute__((ext_vector_type(4)));
typedef unsigned u32x2 __attribute__((ext_vector_type(2)));

#ifndef SPLITK_TAIL
#define SPLITK_TAIL 1
#endif
constexpr int T = 16384, D = 1024, SEQ = 8192, NL = 2;
constexpr int NZ = 5632;
constexpr int ZPW = 5120;
constexpr int ZP_ZA = 0, ZP_GLU = 512, ZP_ZU = 1024, ZP_ZV = 1536, ZP_G = 2048;
constexpr int YW = 1536;
constexpr int NE = 32, TOPK = 4, PLE = 256, CONVK = 31;
constexpr int MAXTILES = 288, MAXROWS = MAXTILES * 256;
constexpr float EPS = 1e-6f;

constexpr size_t MiB = 1u << 20;
constexpr size_t WS_CTL = 0;
constexpr size_t WS_META = 1 * MiB;
constexpr size_t WS_TOPE = 2 * MiB;
constexpr size_t WS_TOPW = 3 * MiB;
constexpr size_t WS_SLOTOF = 4 * MiB;
constexpr size_t WS_SMALLW = 5 * MiB;
constexpr size_t SW_LAYER = 1 * MiB, SW_WPT = 0, SW_WSGU = 128 * 1024, SW_WRT = 256 * 1024, SW_BIN = 384 * 1024, SW_BUP = 512 * 1024;
constexpr size_t WS_WIN = 8 * MiB;
constexpr size_t WS_WBR = 32 * MiB;
constexpr size_t WS_WOUT = 40 * MiB;
constexpr size_t WS_WPG = 44 * MiB;
constexpr size_t WS_WPP = 48 * MiB;
constexpr size_t WS_PB = 50 * MiB;
constexpr size_t WS_WUP = 72 * MiB;
constexpr size_t WS_WDN = 328 * MiB;
constexpr size_t WS_XN = 456 * MiB;
constexpr size_t WS_ZP = 488 * MiB;
constexpr size_t WS_Y = 648 * MiB;
constexpr size_t WS_MG = 696 * MiB;
constexpr size_t WS_XG = 728 * MiB;
constexpr size_t WS_ACT = 872 * MiB;
constexpr size_t WS_YE = 1016 * MiB;
constexpr size_t WS_PP = 1160 * MiB;
constexpr size_t WS_YEX = 1192 * MiB;
constexpr size_t WS_END = 1288 * MiB;
constexpr size_t CTL_ZERO_BYTES = 32768;
constexpr int CW_BAR = 4096;
constexpr int CW_GCNT = 128;
constexpr size_t WS_TOKL = WS_XG;
constexpr size_t WS_X0 = WS_XN, WS_X1 = WS_XG + 16 * MiB, WS_X2 = WS_XG + 48 * MiB;
constexpr size_t WS_RS = WS_TOPE;

constexpr int RING_BYTES = 131072;
constexpr int LDS_TAB = RING_BYTES;
constexpr int LDS_BYTES = 147456;
constexpr int LDS_MISC = LDS_BYTES - 256;
constexpr int MT_CNT = 0, MT_TSTART = 32, MT_NTILE = 96, MT_SPLIT = 97, MT_TAILROW = 98, MT_NFULL = 99, MT_TE = 128, MT_TOKOFF = 512, MAX_UNITS_PER_WG = 9;
constexpr int YEX_ROWS = 16384;

__device__ __forceinline__ unsigned f2bf(float f) { unsigned u = __builtin_bit_cast(unsigned, f); return (u + 0x7fffu + ((u >> 16) & 1u)) >> 16; }
__device__ __forceinline__ unsigned pk2(float lo, float hi) { unsigned r; asm("v_cvt_pk_bf16_f32 %0, %1, %2" : "=v"(r) : "v"(lo), "v"(hi)); return r; }
__device__ __forceinline__ float bflo(unsigned u) { return __builtin_bit_cast(float, u << 16); }
__device__ __forceinline__ float bfhi(unsigned u) { return __builtin_bit_cast(float, u & 0xffff0000u); }
typedef unsigned long long rs_t;
__device__ __forceinline__ rs_t rs_fix(float ss) { return (rs_t)(ss * 1048576.0f + 0.5f); }
__device__ __forceinline__ float rstd_of(rs_t q) { return __builtin_amdgcn_rsqf((float)q * (1.0f / (1048576.0f * 1024.0f)) + 1e-6f); }
__device__ __forceinline__ float sigmoidf_(float v) { return __builtin_amdgcn_rcpf(1.0f + __builtin_amdgcn_exp2f(-1.44269504089f * v)); }
__device__ __forceinline__ float wave_sum(float v) {
#pragma unroll
    for (int o = 1; o < 64; o <<= 1) v += __shfl_xor(v, o);
    return v;
}
#ifndef WT_STORES
#define WT_STORES 0
#endif
__device__ __forceinline__ void st16(void* p, u32x4 v) {
#if WT_STORES
    asm volatile("global_store_dwordx4 %0, %1, off sc1\n\ts_nop 1" :: "v"(p), "v"(v) : "memory");
#else
    *(u32x4*)p = v;
#endif
}
#define LDS_WAIT() asm volatile("s_waitcnt lgkmcnt(0)" ::: "memory")
#define VM_WAIT() asm volatile("s_waitcnt vmcnt(0)" ::: "memory")

namespace pg8 {
constexpr int BM = 256, BK = 64, HALF = 128, HTB = HALF * BK * 2, NXCD = 8, WGM = 8;
__host__ __device__ __forceinline__ int lds_byte(int r, int c) { const int st = (r >> 4) * 2 + (c >> 5), rr = r & 15, cc = c & 31, ob = rr * 64 + cc * 2; return st * 1024 + (ob ^ (((ob >> 9) & 1) << 5)); }
__host__ __device__ __forceinline__ void stage_rc(int b, int& R, int& C) { const int st = b / 1024, sb = b % 1024, swz = sb ^ (((sb >> 9) & 1) << 5); R = (st >> 1) * 16 + swz / 64; C = (st & 1) * 32 + (swz % 64) / 2; }
__host__ __device__ __forceinline__ int perm32(int rho) { const int n = rho >> 4, i = rho & 15; return 8 * (i >> 2) + 4 * n + (i & 3); }

struct Unit { const char* A; const char* B; int pm, pn, aux, ord, nt; };

__device__ __forceinline__ void static_tile(int L, int nM, int nN, int& pm, int& pn) {
    const int nwg = nM * nN; int wgid = L;
    { const int q = nwg / NXCD, r = nwg % NXCD, xcd = wgid % NXCD, off = wgid / NXCD; wgid = (xcd < r ? xcd * (q + 1) : r * (q + 1) + (xcd - r) * q) + off; }
    const int nig = WGM * nN, gid = wgid / nig, fm = gid * WGM, gsz = (nM - fm) < WGM ? (nM - fm) : WGM;
    pm = fm + ((wgid % nig) % gsz); pn = (wgid % nig) / gsz;
}

template <class Epi, class Sched, bool GATHER = false>
__device__ __forceinline__ void gemm_phase(LAS unsigned char* lds, const int K_, const int lda, const int ldb, const Sched& S, const Epi& E, const LAS unsigned* gtab = nullptr) {
    int K = K_; asm volatile("" : "+s"(K));
    int tid_ = threadIdx.x; asm volatile("" : "+v"(tid_));
    const int tid = tid_, wid = __builtin_amdgcn_readfirstlane(tid >> 6), lane = tid & 63, wr = wid >> 2, wc = wid & 3, fr = lane & 15, fq = lane >> 4;
    const int nt0 = K / BK;
    unsigned voffA[2], voffB[2], gR[2], gC[2], vC[2][2], vN[2][2], vs[2][2];
#pragma unroll
    for (int i = 0; i < 2; ++i) { int R, C; stage_rc(tid * 16 + i * 8192, R, C); const int Rb = Epi::PERM ? ((R & ~31) + perm32(R & 31)) : R;
        voffA[i] = (unsigned)(R * lda + C) * 2u; voffB[i] = (unsigned)(Rb * ldb + C) * 2u; gR[i] = (unsigned)R; gC[i] = (unsigned)C * 2u; }
#define PG8_GLOAD(dst, u) do { _Pragma("unroll") for (int _h = 0; _h < 2; ++_h) _Pragma("unroll") for (int _i = 0; _i < 2; ++_i) dst[_h][_i] = gtab[(u) * 256 + _h * 128 + gR[_i]] + gC[_i]; } while (0)
#define PG8_STAGE_A(bufoff, h, gbase, VO) do { if constexpr (GATHER) { PG8_STAGE(bufoff, gbase, VO[h]); } else { PG8_STAGE(bufoff, (gbase) + (h) * hstepA, voffA); } } while (0)
    const size_t kstep = (size_t)(BK * 2);
    const size_t hstepA = (size_t)HALF * lda * 2, hstepB = (size_t)HALF * ldb * 2;
    const unsigned ldsw = (unsigned)wid * 1024u;
    const int aoff = lds_byte(wr * 64 + fr, fq * 8), boff = lds_byte(wc * 32 + fr, fq * 8);
#define PG8_SA(b, h) (((b) * 2 + (h)) * HTB)
#define PG8_SB(b, h) ((4 + (b) * 2 + (h)) * HTB)
#define PG8_STAGE(bufoff, gbase, voff) do { _Pragma("unroll") for (int _i = 0; _i < 2; ++_i) \
        __builtin_amdgcn_global_load_lds((const unsigned*)((const char*)(gbase) + (voff)[_i]), (LAS unsigned*)(lds + (bufoff) + ldsw + _i * 8192), 16, 0, 0); } while (0)
#define PG8_LDA(dst, b, h) do { _Pragma("unroll") for (int m = 0; m < 4; ++m) _Pragma("unroll") for (int k = 0; k < 2; ++k) dst[m][k] = *(const LAS bf16x8*)(lds + PG8_SA(b, h) + aoff + m * 2048 + k * 1024); } while (0)
#define PG8_LDB(dst, b, h) do { _Pragma("unroll") for (int n = 0; n < 2; ++n) _Pragma("unroll") for (int k = 0; k < 2; ++k) dst[n][k] = *(const LAS bf16x8*)(lds + PG8_SB(b, h) + boff + n * 2048 + k * 1024); } while (0)
#define PG8_MMA(ai, bj, At, Bt) do { __builtin_amdgcn_s_setprio(1); _Pragma("unroll") for (int m = 0; m < 4; ++m) _Pragma("unroll") for (int n = 0; n < 2; ++n) _Pragma("unroll") for (int k = 0; k < 2; ++k) \
        acc[ai][bj][m][n] = __builtin_amdgcn_mfma_f32_16x16x32_bf16(Bt[n][k], At[m][k], acc[ai][bj][m][n], 0, 0, 0); __builtin_amdgcn_s_setprio(0); } while (0)
#define PG8_WAIT_V(n) asm volatile("s_waitcnt vmcnt(" #n ")" ::: "memory")
#define PG8_WAIT_L(n) asm volatile("s_waitcnt lgkmcnt(" #n ")" ::: "memory")
#define PG8_BAR __builtin_amdgcn_s_barrier()
#define PG8_SCHED __builtin_amdgcn_sched_barrier(0)
    Unit cur, nxt; int ui = 0;
    if (!S.next(0, cur)) return;
    f32x4 acc[2][2][4][2];
#pragma unroll
    for (int a = 0; a < 2; ++a)
#pragma unroll
        for (int b = 0; b < 2; ++b)
#pragma unroll
            for (int m = 0; m < 4; ++m)
#pragma unroll
                for (int n = 0; n < 2; ++n) acc[a][b][m][n] = (f32x4){0.f, 0.f, 0.f, 0.f};
    bf16x8 At[4][2], B0[2][2], B1[2][2];
    const char* cA = cur.A; const char* cB = cur.B;
    if constexpr (GATHER) PG8_GLOAD(vC, 0);
    PG8_STAGE(PG8_SB(0, 0), cB, voffB); PG8_STAGE(PG8_SB(0, 1), cB + hstepB, voffB); PG8_STAGE_A(PG8_SA(0, 0), 0, cA, vC); PG8_STAGE_A(PG8_SA(0, 1), 1, cA, vC);
    if (wr == 1) PG8_BAR;
    PG8_WAIT_V(2); PG8_BAR;
    PG8_STAGE(PG8_SB(1, 0), cB + kstep, voffB); PG8_STAGE_A(PG8_SA(1, 0), 0, cA + kstep, vC); PG8_STAGE(PG8_SB(1, 1), cB + hstepB + kstep, voffB);
    PG8_WAIT_V(6); PG8_BAR;
    for (;;) {
        const bool has_next = S.next(ui + 1, nxt);
        const char* nA = has_next ? nxt.A : cA; const char* nB = has_next ? nxt.B : cB;
        if constexpr (GATHER) { if (has_next) PG8_GLOAD(vN, ui + 1); else {
#pragma unroll
            for (int _h = 0; _h < 2; ++_h)
#pragma unroll
                for (int _i = 0; _i < 2; ++_i) vN[_h][_i] = vC[_h][_i]; } }
        const int nt = cur.nt > 0 ? cur.nt : nt0;
        for (int t = 0; t < nt; t += 2) {
            const bool last = (t == nt - 2);
            if constexpr (GATHER) {
#pragma unroll
                for (int _h = 0; _h < 2; ++_h)
#pragma unroll
                    for (int _i = 0; _i < 2; ++_i) vs[_h][_i] = last ? vN[_h][_i] : vC[_h][_i]; }
            const char* a1 = cA + (size_t)(t + 1) * kstep;
            const char* a2 = last ? nA : cA + (size_t)(t + 2) * kstep; const char* b2 = last ? nB : cB + (size_t)(t + 2) * kstep;
            const char* a3 = a2 + kstep; const char* b3 = b2 + kstep;
            PG8_LDB(B0, 0, 0); PG8_LDB(B1, 0, 1); PG8_SCHED; PG8_LDA(At, 0, 0); PG8_STAGE_A(PG8_SA(1, 1), 1, a1, vC);
            PG8_WAIT_V(8); PG8_WAIT_L(0); PG8_BAR; PG8_MMA(0, 0, At, B0); PG8_MMA(0, 1, At, B1); PG8_BAR; PG8_SCHED;
            PG8_LDA(At, 0, 1); PG8_STAGE(PG8_SB(0, 0), b2, voffB); PG8_STAGE(PG8_SB(0, 1), b2 + hstepB, voffB); PG8_STAGE_A(PG8_SA(0, 0), 0, a2, vs);
            PG8_WAIT_V(8); PG8_WAIT_L(0); PG8_BAR; PG8_MMA(1, 0, At, B0); PG8_MMA(1, 1, At, B1); PG8_BAR; PG8_SCHED;
            PG8_LDB(B0, 1, 0); PG8_LDB(B1, 1, 1); PG8_SCHED; PG8_LDA(At, 1, 0); PG8_STAGE_A(PG8_SA(0, 1), 1, a2, vs);
            PG8_WAIT_V(8); PG8_WAIT_L(0); PG8_BAR; PG8_MMA(0, 0, At, B0); PG8_MMA(0, 1, At, B1); PG8_BAR; PG8_SCHED;
            PG8_LDA(At, 1, 1); PG8_STAGE(PG8_SB(1, 0), b3, voffB); PG8_STAGE(PG8_SB(1, 1), b3 + hstepB, voffB); PG8_STAGE_A(PG8_SA(1, 0), 0, a3, vs);
            PG8_WAIT_V(8); PG8_WAIT_L(0); PG8_BAR; PG8_MMA(1, 0, At, B0); PG8_MMA(1, 1, At, B1); PG8_BAR; PG8_SCHED;
        }
        if (wr == 0) PG8_BAR;
        bool zero = true; if (cur.aux >= 0) { if constexpr (Epi::EDUP) { (void)E(acc, cur, wr, wc, fr, fq); asm volatile("" ::: "memory"); } zero = E(acc, cur, wr, wc, fr, fq); }
        if constexpr (Epi::DRAIN) __builtin_amdgcn_s_waitcnt(0x0F70);
        if (!has_next) break;
        if (zero) {
#pragma unroll
            for (int a = 0; a < 2; ++a)
#pragma unroll
                for (int b = 0; b < 2; ++b)
#pragma unroll
                    for (int m = 0; m < 4; ++m)
#pragma unroll
                        for (int n = 0; n < 2; ++n) acc[a][b][m][n] = (f32x4){0.f, 0.f, 0.f, 0.f};
        }
        cur = nxt; cA = nA; cB = nB; ++ui;
        if constexpr (GATHER) {
#pragma unroll
            for (int _h = 0; _h < 2; ++_h)
#pragma unroll
                for (int _i = 0; _i < 2; ++_i) vC[_h][_i] = vN[_h][_i]; }
        if (wr == 1) PG8_BAR;
    }
    PG8_WAIT_V(0);
    PG8_BAR;
#undef PG8_SA
#undef PG8_SB
#undef PG8_STAGE
#undef PG8_STAGE_A
#undef PG8_GLOAD
#undef PG8_LDA
#undef PG8_LDB
#undef PG8_MMA
#undef PG8_WAIT_V
#undef PG8_WAIT_L
#undef PG8_BAR
#undef PG8_SCHED
}
}
using pg8::Unit;


struct DenseOrder {
    const char* A; const char* B; int nM, nN, G, c; size_t astep, bstep; int dup;
    __device__ __forceinline__ bool next(int i, Unit& u) const {
        const int L = (dup ? (i >> 1) : i) * G + c; if (L >= nM * nN) return false;
        int pm, pn; pg8::static_tile(L, nM, nN, pm, pn);
        u.pm = pm; u.pn = pn; u.ord = i; u.nt = 0; u.aux = (dup && !(i & 1)) ? -1 : 0; u.A = A + (size_t)pm * astep; u.B = B + (size_t)pn * bstep; return true;
    }
};
struct BranchOrder {
    const char* Y; const char* W; int G, c;
    __device__ __forceinline__ bool next(int i, Unit& u) const {
        const int tl = (i / 3) * G + c; if (tl >= 256) return false;
        int pm, pn; pg8::static_tile(tl, 64, 4, pm, pn); const int br = i % 3;
        u.pm = pm; u.pn = pn; u.ord = i; u.nt = 0; u.aux = br; u.A = Y + ((size_t)pm * 256 * YW + (size_t)br * 512) * 2; u.B = W + ((size_t)br * 1024 * 512 + (size_t)pn * 256 * 512) * 2; return true;
    }
};
struct MoeOrder {
    const char* A; const char* W; const LAS int* tile_e; int n_units, NP, G, c; size_t wstride, bstep, astep;
    int n_full, split;
    __device__ __forceinline__ bool next(int i, Unit& u) const {
        int L = i * G + c, q = 0, nq = 1;
        if (L >= n_full && split > 1) { const int j = L - n_full; L = n_full + j / split; q = j % split; nq = split; }
        if (L >= n_units) return false;
        const int tile = L / NP, pn = L - tile * NP; const int e = tile_e[tile];
        const size_t koff = (size_t)q * (1024 / nq) * 2;
        u.pm = tile; u.pn = pn; u.ord = i; u.aux = e | (q << 8); u.nt = 16 / nq; u.A = A + (size_t)tile * astep + koff; u.B = W + (size_t)e * wstride + (size_t)pn * bstep + koff; return true;
    }
};

typedef f32x4 Acc[2][2][4][2];
#ifndef EDUP_IN
#define EDUP_IN 0
#endif
#ifndef EDUP_UP
#define EDUP_UP 0
#endif
struct EpiIn {
    static constexpr bool PERM = true, DRAIN = false, EDUP = (EDUP_IN != 0);
    bf16_t* ZP; const float* bias; const rs_t* rs;
    __device__ __forceinline__ bool operator()(Acc& acc, const Unit& u, int wr, int wc, int fr, int fq) const {
        const int row0 = u.pm * 256 + wr * 64 + fr, pn = u.pn, cl = wc * 32 + 8 * fq;
        float rsv[2][4];
#pragma unroll
        for (int ai = 0; ai < 2; ++ai)
#pragma unroll
            for (int m = 0; m < 4; ++m) rsv[ai][m] = rstd_of(rs[row0 + ai * 128 + m * 16]);
        const float* bp = bias + pn * 256 + cl;
        f32x4 bv[2][2];
#pragma unroll
        for (int bj = 0; bj < 2; ++bj)
#pragma unroll
            for (int n = 0; n < 2; ++n) bv[bj][n] = *(const f32x4*)(bp + bj * 128 + 4 * n);
        if (pn >= 2 && pn < 6) {
            bf16_t* base = ZP + ZP_GLU + (pn - 2) * 128 + cl;
#pragma unroll
            for (int ai = 0; ai < 2; ++ai)
#pragma unroll
                for (int m = 0; m < 4; ++m) { float o[8];
#pragma unroll
                    for (int n = 0; n < 2; ++n) { const f32x4 a = acc[ai][0][m][n] * rsv[ai][m] + bv[0][n], g = acc[ai][1][m][n] * rsv[ai][m] + bv[1][n];
#pragma unroll
                        for (int j = 0; j < 4; ++j) o[4 * n + j] = a[j] * sigmoidf_(g[j]); }
                    u32x4 w; w.x = pk2(o[0], o[1]); w.y = pk2(o[2], o[3]); w.z = pk2(o[4], o[5]); w.w = pk2(o[6], o[7]);
                    st16(base + (size_t)(row0 + ai * 128 + m * 16) * ZPW, w); }
        } else {
            const bool sg = pn >= 10; const int dc = (pn < 2 ? pn * 256 : (pn - 2) * 256 + 0) ;
            bf16_t* base = ZP + dc + cl;
#pragma unroll
            for (int ai = 0; ai < 2; ++ai)
#pragma unroll
                for (int m = 0; m < 4; ++m)
#pragma unroll
                    for (int bj = 0; bj < 2; ++bj) { f32x4 v0 = acc[ai][bj][m][0] * rsv[ai][m] + bv[bj][0], v1 = acc[ai][bj][m][1] * rsv[ai][m] + bv[bj][1];
                        if (sg) {
#pragma unroll
                            for (int j = 0; j < 4; ++j) { v0[j] = sigmoidf_(v0[j]); v1[j] = sigmoidf_(v1[j]); } }
                        u32x4 w; w.x = pk2(v0[0], v0[1]); w.y = pk2(v0[2], v0[3]); w.z = pk2(v1[0], v1[1]); w.w = pk2(v1[2], v1[3]);
                        st16(base + (size_t)(row0 + ai * 128 + m * 16) * ZPW + bj * 128, w); }
        }
        return true;
    }
};
#ifndef GRND
#define GRND 3
#endif
struct EpiBranch {
    static constexpr bool PERM = true, DRAIN = false, EDUP = false;
    const bf16_t* ZP; const float* bb; bf16_t* MG;
    __device__ __forceinline__ bool operator()(Acc& acc, const Unit& u, int wr, int wc, int fr, int fq) const {
        const int row0 = u.pm * 256 + wr * 64 + fr, c0 = u.pn * 256 + wc * 32 + 8 * fq, br = u.aux;
        f32x4 bv[2][2];
#pragma unroll
        for (int bj = 0; bj < 2; ++bj)
#pragma unroll
            for (int n = 0; n < 2; ++n) bv[bj][n] = *(const f32x4*)(bb + br * 1024 + c0 + bj * 128 + 4 * n);
        const bf16_t* gp = ZP + ZP_G + br * 1024 + c0;
#pragma unroll
        for (int r0 = 0; r0 < 8; r0 += GRND) {
            u32x4 ga[GRND][2], gb[GRND][2];
#pragma unroll
            for (int rr = 0; rr < GRND; ++rr) if (r0 + rr < 8)
#pragma unroll
                for (int bj = 0; bj < 2; ++bj) { const size_t go = (size_t)(row0 + ((r0 + rr) >> 2) * 128 + ((r0 + rr) & 3) * 16) * ZPW + bj * 128;
                    ga[rr][bj] = *(const u32x4*)(gp + go); gb[rr][bj] = *(const u32x4*)(gp + (br < 2 ? 1024 : 0) + go); }
            __builtin_amdgcn_sched_barrier(0);
#pragma unroll
            for (int rr = 0; rr < GRND; ++rr) if (r0 + rr < 8) { const int ai = (r0 + rr) >> 2, m = (r0 + rr) & 3;
                const size_t ro = (size_t)(row0 + ai * 128 + m * 16);
#pragma unroll
                for (int bj = 0; bj < 2; ++bj) {
                    float f[8];
                    if (br < 2) {
#pragma unroll
                        for (int q = 0; q < 4; ++q) { f[2 * q] = bflo(ga[rr][bj][q]) * __builtin_amdgcn_rcpf(fmaxf(bflo(gb[rr][bj][q]), 1e-30f)); f[2 * q + 1] = bfhi(ga[rr][bj][q]) * __builtin_amdgcn_rcpf(fmaxf(bfhi(gb[rr][bj][q]), 1e-30f)); }
                    } else {
#pragma unroll
                        for (int q = 0; q < 4; ++q) { f[2 * q] = bflo(ga[rr][bj][q]); f[2 * q + 1] = bfhi(ga[rr][bj][q]); } }
#pragma unroll
                    for (int n = 0; n < 2; ++n)
#pragma unroll
                        for (int j = 0; j < 4; ++j) acc[ai][bj][m][n][j] = (acc[ai][bj][m][n][j] + bv[bj][n][j]) * f[4 * n + j];
                    if (br == 2) { const f32x4 v0 = acc[ai][bj][m][0], v1 = acc[ai][bj][m][1];
                        u32x4 w; w.x = pk2(v0[0], v0[1]); w.y = pk2(v0[2], v0[3]); w.z = pk2(v1[0], v1[1]); w.w = pk2(v1[2], v1[3]);
                        st16(MG + ro * D + c0 + bj * 128, w); }
                }
            }
            asm volatile("" ::: "memory");
        }
        return br == 2;
    }
};
struct EpiRes {
    static constexpr bool PERM = true, DRAIN = false, EDUP = false;
    const bf16_t* xin; bf16_t* xout; rs_t* rsout;
    __device__ __forceinline__ bool operator()(Acc& acc, const Unit& u, int wr, int wc, int fr, int fq) const {
        const int row0 = u.pm * 256 + wr * 64 + fr, c0 = u.pn * 256 + wc * 32 + 8 * fq;
#pragma unroll
        for (int ai = 0; ai < 2; ++ai) {
            u32x4 xv[4][2];
#pragma unroll
            for (int m = 0; m < 4; ++m)
#pragma unroll
                for (int bj = 0; bj < 2; ++bj) xv[m][bj] = *(const u32x4*)(xin + (size_t)(row0 + ai * 128 + m * 16) * D + c0 + bj * 128);
            __builtin_amdgcn_sched_barrier(0);
#pragma unroll
            for (int m = 0; m < 4; ++m) { const int r = row0 + ai * 128 + m * 16; float ss = 0.f;
#pragma unroll
                for (int bj = 0; bj < 2; ++bj) { const u32x4 x = xv[m][bj]; f32x4 v0 = acc[ai][bj][m][0], v1 = acc[ai][bj][m][1];
                    v0[0] += bflo(x.x); v0[1] += bfhi(x.x); v0[2] += bflo(x.y); v0[3] += bfhi(x.y); v1[0] += bflo(x.z); v1[1] += bfhi(x.z); v1[2] += bflo(x.w); v1[3] += bfhi(x.w);
                    ss += ((v0[0] * v0[0] + v0[1] * v0[1]) + (v0[2] * v0[2] + v0[3] * v0[3])) + ((v1[0] * v1[0] + v1[1] * v1[1]) + (v1[2] * v1[2] + v1[3] * v1[3]));
                    u32x4 w; w.x = pk2(v0[0], v0[1]); w.y = pk2(v0[2], v0[3]); w.z = pk2(v1[0], v1[1]); w.w = pk2(v1[2], v1[3]);
                    st16(xout + (size_t)r * D + c0 + bj * 128, w); }
                ss += __shfl_xor(ss, 16); ss += __shfl_xor(ss, 32);
                if (fq == 0) atomicAdd(rsout + r, rs_fix(ss)); }
            asm volatile("" ::: "memory"); }
        return true;
    }
};
struct EpiUp {
    static constexpr bool PERM = true, DRAIN = false, EDUP = (EDUP_UP != 0);
    bf16_t* ACT; const float* bup; const rs_t* rs; const LAS unsigned* tokoff;
    __device__ __forceinline__ bool operator()(Acc& acc, const Unit& u, int wr, int wc, int fr, int fq) const {
        const int row0 = u.pm * 256 + wr * 64 + fr, cl = wc * 32 + 8 * fq;
        float rsv[2][4];
#pragma unroll
        for (int ai = 0; ai < 2; ++ai)
#pragma unroll
            for (int m = 0; m < 4; ++m) rsv[ai][m] = rstd_of(rs[tokoff[u.ord * 256 + ai * 128 + wr * 64 + m * 16 + fr] >> 11]);
        const float* bp = bup + (u.aux & 255) * 2048 + u.pn * 256 + cl;
        f32x4 bg[2], bl[2];
#pragma unroll
        for (int n = 0; n < 2; ++n) { bg[n] = *(const f32x4*)(bp + 4 * n); bl[n] = *(const f32x4*)(bp + 128 + 4 * n); }
        bf16_t* base = ACT + u.pn * 128 + cl;
#pragma unroll
        for (int ai = 0; ai < 2; ++ai)
#pragma unroll
            for (int m = 0; m < 4; ++m) { float o[8];
#pragma unroll
                for (int n = 0; n < 2; ++n) { const f32x4 g = acc[ai][0][m][n] * rsv[ai][m] + bg[n], l = acc[ai][1][m][n] * rsv[ai][m] + bl[n];
#pragma unroll
                    for (int j = 0; j < 4; ++j) { const float gg = fminf(g[j], 7.0f), ll = fminf(fmaxf(l[j], -7.0f), 7.0f); o[4 * n + j] = gg * sigmoidf_(1.702f * gg) * (ll + 1.0f); } }
                u32x4 w; w.x = pk2(o[0], o[1]); w.y = pk2(o[2], o[3]); w.z = pk2(o[4], o[5]); w.w = pk2(o[6], o[7]);
                st16(base + (size_t)(row0 + ai * 128 + m * 16) * D, w); }
        return true;
    }
};
struct EpiBf {
    static constexpr bool PERM = true, DRAIN = false, EDUP = false;
    bf16_t* O; const float* bias; bf16_t* OX; int tail_row0;
    __device__ __forceinline__ bool operator()(Acc& acc, const Unit& u, int wr, int wc, int fr, int fq) const {
        const int row0 = u.pm * 256 + wr * 64 + fr, c0 = u.pn * 256 + wc * 32 + 8 * fq, e = u.aux & 255, q = (u.aux >> 8) & 3;
        f32x4 bv[2][2];
#pragma unroll
        for (int bj = 0; bj < 2; ++bj)
#pragma unroll
            for (int n = 0; n < 2; ++n) bv[bj][n] = (bias && q == 0) ? *(const f32x4*)(bias + e * 1024 + c0 + bj * 128 + 4 * n) : (f32x4){0.f, 0.f, 0.f, 0.f};
        bf16_t* ob = (q == 0) ? O + (size_t)row0 * D : OX + ((size_t)(q - 1) * YEX_ROWS + (size_t)(row0 - tail_row0)) * D;
#pragma unroll
        for (int ai = 0; ai < 2; ++ai)
#pragma unroll
            for (int m = 0; m < 4; ++m)
#pragma unroll
                for (int bj = 0; bj < 2; ++bj) { const f32x4 v0 = acc[ai][bj][m][0] + bv[bj][0], v1 = acc[ai][bj][m][1] + bv[bj][1];
                    u32x4 w; w.x = pk2(v0[0], v0[1]); w.y = pk2(v0[2], v0[3]); w.z = pk2(v1[0], v1[1]); w.w = pk2(v1[2], v1[3]);
                    st16(ob + (size_t)(ai * 128 + m * 16) * D + c0 + bj * 128, w); }
        return true;
    }
};
struct EpiPle {
    static constexpr bool PERM = true, DRAIN = false, EDUP = false;
    const bf16_t* xin; bf16_t* xout; const bf16_t* PP; const rs_t* rs; rs_t* rsout;
    __device__ __forceinline__ bool operator()(Acc& acc, const Unit& u, int wr, int wc, int fr, int fq) const {
        const int row0 = u.pm * 256 + wr * 64 + fr, c0 = u.pn * 256 + wc * 32 + 8 * fq;
#pragma unroll
        for (int am = 0; am < 4; ++am) { const int ai = am >> 1, m0 = (am & 1) * 2;
            u32x4 xv[2][2], pv[2][2]; float rsv[2];
#pragma unroll
            for (int mm = 0; mm < 2; ++mm) { const int r = row0 + ai * 128 + (m0 + mm) * 16; rsv[mm] = rstd_of(rs[r]);
#pragma unroll
                for (int bj = 0; bj < 2; ++bj) { xv[mm][bj] = *(const u32x4*)(xin + (size_t)r * D + c0 + bj * 128); pv[mm][bj] = *(const u32x4*)(PP + (size_t)r * D + c0 + bj * 128); } }
            __builtin_amdgcn_sched_barrier(0);
#pragma unroll
            for (int mm = 0; mm < 2; ++mm) { const int m = m0 + mm, r = row0 + ai * 128 + m * 16; float ss = 0.f;
#pragma unroll
                for (int bj = 0; bj < 2; ++bj) { const u32x4 x = xv[mm][bj], p = pv[mm][bj]; const f32x4 a0 = acc[ai][bj][m][0] * rsv[mm], a1 = acc[ai][bj][m][1] * rsv[mm]; float v[8];
                    v[0] = bflo(x.x) + sigmoidf_(a0[0]) * bflo(p.x); v[1] = bfhi(x.x) + sigmoidf_(a0[1]) * bfhi(p.x); v[2] = bflo(x.y) + sigmoidf_(a0[2]) * bflo(p.y); v[3] = bfhi(x.y) + sigmoidf_(a0[3]) * bfhi(p.y);
                    v[4] = bflo(x.z) + sigmoidf_(a1[0]) * bflo(p.z); v[5] = bfhi(x.z) + sigmoidf_(a1[1]) * bfhi(p.z); v[6] = bflo(x.w) + sigmoidf_(a1[2]) * bflo(p.w); v[7] = bfhi(x.w) + sigmoidf_(a1[3]) * bfhi(p.w);
                    ss += ((v[0] * v[0] + v[1] * v[1]) + (v[2] * v[2] + v[3] * v[3])) + ((v[4] * v[4] + v[5] * v[5]) + (v[6] * v[6] + v[7] * v[7]));
                    u32x4 w; w.x = pk2(v[0], v[1]); w.y = pk2(v[2], v[3]); w.z = pk2(v[4], v[5]); w.w = pk2(v[6], v[7]);
                    st16(xout + (size_t)r * D + c0 + bj * 128, w); }
                ss += __shfl_xor(ss, 16); ss += __shfl_xor(ss, 32);
                if (fq == 0) atomicAdd(rsout + r, rs_fix(ss)); }
            asm volatile("" ::: "memory"); }
        return true;
    }
};

#define XB_TMO      128
#define XB_XCNT(j)  (256  + 64 * (j))
#define XB_XSUB(j)  (1280 + 64 * (j))
#define XB_XGEN(j)  (2304 + 64 * (j))
#define XB_TOP      3328
#define XB_TOPGEN   3392
#define XCD_BAR_WORDS 3456
#define XB_SPIN_CAP (1u << 22)
__device__ __forceinline__ unsigned xb_ld(unsigned* p)              { return __hip_atomic_load(p, __ATOMIC_RELAXED, __HIP_MEMORY_SCOPE_AGENT); }
__device__ __forceinline__ unsigned xb_add(unsigned* p, unsigned v) { return __hip_atomic_fetch_add(p, v, __ATOMIC_RELAXED, __HIP_MEMORY_SCOPE_AGENT); }
__device__ __forceinline__ unsigned xb_xcc_id() { return (unsigned)__builtin_amdgcn_s_getreg((3 << 11) | 20) & 0xFu; }
#define XB_SPIN(cond, bar) do { unsigned _sp = 0; while (cond) { __builtin_amdgcn_s_sleep(1); \
    if ((++_sp & 255u) == 0u) { if (xb_ld(&(bar)[XB_TMO])) break; if (_sp > XB_SPIN_CAP) { atomicAdd(&(bar)[XB_TMO], 1u); break; } } } } while (0)
struct XcdBarrier { unsigned* bar; unsigned x; volatile LAS unsigned* st; };
__device__ __forceinline__ XcdBarrier xcd_barrier_post(unsigned* bar, volatile LAS unsigned* st) {
    XcdBarrier b; b.bar = bar; b.x = xb_xcc_id(); b.st = st;
    if (threadIdx.x == 0) (void)xb_add(&bar[XB_XCNT(b.x)], 1u);
    return b;
}
__device__ __forceinline__ void xcd_barrier_complete(unsigned* bar, unsigned x, unsigned& nloc, unsigned& nx) {
    const unsigned G = gridDim.x * gridDim.y * gridDim.z;
    unsigned sum, cnt, mine, sp = 0u;
    for (;;) {
        sum = 0u; cnt = 0u; mine = 0u;
#pragma unroll
        for (unsigned j = 0; j < 16; ++j) { const unsigned c = xb_ld(&bar[XB_XCNT(j)]); sum += c; cnt += (c > 0u) ? 1u : 0u; mine = (j == x) ? c : mine; }
        if (sum == G) break;
        __builtin_amdgcn_s_sleep(1);
        if ((++sp & 255u) == 0u) { if (xb_ld(&bar[XB_TMO])) break; if (sp > XB_SPIN_CAP) { atomicAdd(&bar[XB_TMO], 1u); break; } }
    }
    nloc = mine > 0u ? mine : 1u; nx = cnt > 0u ? cnt : 1u;
}
__device__ __forceinline__ void xcd_barrier(const XcdBarrier& b) {
    asm volatile("s_waitcnt vmcnt(0)" ::: "memory");
    __syncthreads();
    if (threadIdx.x == 0) {
        unsigned* bar = b.bar;
        __builtin_amdgcn_s_waitcnt(0);
        unsigned nloc = b.st[0], nx = b.st[1];
        if (nloc == 0u) { xcd_barrier_complete(bar, b.x, nloc, nx); b.st[0] = nloc; b.st[1] = nx; }
        const unsigned old = xb_add(&bar[XB_XSUB(b.x)], 1u);
        const unsigned gen = old / nloc;
        if (old + 1u == (gen + 1u) * nloc) {
            __builtin_amdgcn_fence(__ATOMIC_RELEASE, "agent");
            asm volatile("s_waitcnt vmcnt(0)" ::: "memory");
            const unsigned og = xb_add(&bar[XB_TOP], 1u);
            const unsigned tg = og / nx;
            if (og + 1u == (tg + 1u) * nx) xb_add(&bar[XB_TOPGEN], 1u);
            else XB_SPIN(xb_ld(&bar[XB_TOPGEN]) == tg, bar);
            __builtin_amdgcn_fence(__ATOMIC_ACQUIRE, "agent");
            xb_add(&bar[XB_XGEN(b.x)], 1u);
            asm volatile("s_waitcnt vmcnt(0)" ::: "memory");
        } else {
            XB_SPIN(xb_ld(&bar[XB_XGEN(b.x)]) == gen, bar);
            __builtin_amdgcn_fence(__ATOMIC_ACQUIRE, "agent");
            asm volatile("s_waitcnt vmcnt(0)" ::: "memory");
        }
    }
    __syncthreads();
}

struct Args { const float* in[29]; float* out; unsigned char* ws; int ph_lo, ph_hi, use_cg, pad; };
struct Frame {
    LAS unsigned char* lds; int tid, lane, wave, G, vcu;
    float* out; unsigned char* ws;
    __device__ __forceinline__ void refresh() { int t = threadIdx.x; asm volatile("" : "+v"(t)); tid = t; lane = t & 63; wave = __builtin_amdgcn_readfirstlane(t >> 6); }
};
__device__ __forceinline__ const float* kin(int i) {
    const char __attribute__((address_space(4)))* p = (const char __attribute__((address_space(4)))*)__builtin_amdgcn_kernarg_segment_ptr();
    asm volatile("" : "+s"(p));
    return *(const float* const __attribute__((address_space(4)))*)(p + 8 * i);
}
#define WSP(T_, off) ((T_*)(F.ws + (off)))

struct TrDesc { const float* W; bf16_t* WT; const float* scale; int N, dK, k0, n0, drow0; };
__device__ __forceinline__ void tr_load(const TrDesc& d, int lane, f32x4 (&v)[16], float (&sc)[16]) {
    const int kr = lane >> 4, nc = 4 * (lane & 15);
#pragma unroll
    for (int i = 0; i < 16; ++i) v[i] = __builtin_nontemporal_load((const f32x4*)(d.W + (size_t)(d.k0 + 4 * i + kr) * d.N + d.n0 + nc));
#pragma unroll
    for (int i = 0; i < 16; ++i) sc[i] = d.scale ? d.scale[d.k0 + 4 * i + kr] : 1.0f;
}
__device__ __forceinline__ void tr_store(const TrDesc& d, int lane, const f32x4 (&v)[16], const float (&sc)[16], LAS float* scr) {
    const int kr = lane >> 4, nc = 4 * (lane & 15);
#pragma unroll
    for (int i = 0; i < 16; ++i) { LAS float* s = scr + (4 * i + kr) * 65 + nc; s[0] = v[i][0] * sc[i]; s[1] = v[i][1] * sc[i]; s[2] = v[i][2] * sc[i]; s[3] = v[i][3] * sc[i]; }
    LDS_WAIT(); asm volatile("" ::: "memory");
    const int c = lane & 7;
#pragma unroll
    for (int it = 0; it < 8; ++it) { const int n = (lane >> 3) + 8 * it; const LAS float* s = scr + (8 * c) * 65 + n;
        u32x4 o; o.x = pk2(s[0 * 65], s[1 * 65]); o.y = pk2(s[2 * 65], s[3 * 65]); o.z = pk2(s[4 * 65], s[5 * 65]); o.w = pk2(s[6 * 65], s[7 * 65]);
        __builtin_nontemporal_store(o, (u32x4*)(d.WT + (size_t)(d.drow0 + n) * d.dK + d.k0 + 8 * c)); }
    LDS_WAIT(); asm volatile("" ::: "memory");
}
__device__ __forceinline__ int win_src(int np) { if (np >= 512 && np < 1536) { const int t = (np - 512) >> 8, i = (np - 512) & 255; return i < 128 ? 512 + 128 * t + i : 1024 + 128 * t + (i - 128); } return np; }
__device__ __forceinline__ int win_dst64(int n0) { if (n0 >= 512 && n0 < 1024) { const int c = n0 - 512; return 512 + 256 * (c >> 7) + (c & 127); } if (n0 >= 1024 && n0 < 1536) { const int c = n0 - 1024; return 512 + 256 * (c >> 7) + 128 + (c & 127); } return n0; }
__device__ __forceinline__ int up_src(int np) { const int t = np >> 8, i = np & 255; return i < 128 ? 128 * t + i : 1024 + 128 * t + (i - 128); }
__device__ __forceinline__ int up_dst64(int n0) { if (n0 < 1024) return 256 * (n0 >> 7) + (n0 & 127); const int c = n0 - 1024; return 256 * (c >> 7) + 128 + (c & 127); }

__device__ __forceinline__ void row_load(const float* xr, int lane, f32x4 (&v)[4]) {
#pragma unroll
    for (int j = 0; j < 4; ++j) v[j] = *(const f32x4*)(xr + 4 * lane + 256 * j);
}
__device__ __forceinline__ void row_store_bf16(bf16_t* o, int lane, const f32x4 (&v)[4], float sc) {
#pragma unroll
    for (int j = 0; j < 4; ++j) { u32x2 w; w.x = pk2(v[j][0] * sc, v[j][1] * sc); w.y = pk2(v[j][2] * sc, v[j][3] * sc); *(u32x2*)(o + 4 * lane + 256 * j) = w; }
}
__device__ __forceinline__ void row_load_bf(const bf16_t* xr, int lane, u32x2 (&p)[4]) {
#pragma unroll
    for (int j = 0; j < 4; ++j) p[j] = *(const u32x2*)(xr + 4 * lane + 256 * j);
}
__device__ __forceinline__ void row_unpack(const u32x2 (&p)[4], f32x4 (&v)[4]) {
#pragma unroll
    for (int j = 0; j < 4; ++j) { v[j][0] = bflo(p[j].x); v[j][1] = bfhi(p[j].x); v[j][2] = bflo(p[j].y); v[j][3] = bfhi(p[j].y); }
}
__device__ __forceinline__ float row_sumsq(const f32x4 (&v)[4]) {
    float s = 0.f;
#pragma unroll
    for (int j = 0; j < 4; ++j) s += (v[j][0] * v[j][0] + v[j][1] * v[j][1]) + (v[j][2] * v[j][2] + v[j][3] * v[j][3]);
    return wave_sum(s);
}
__device__ __forceinline__ void phase_final(Frame& F, const bf16_t* xb, const rs_t* rsf, float* out, const float* g) {
    const int gw = F.vcu * 8 + F.wave, NGW = F.G * 8;
    for (int m = gw; m < T; m += NGW) { u32x2 p[4]; f32x4 v[4]; row_load_bf(xb + (size_t)m * D, F.lane, p); row_unpack(p, v); const float rs = rstd_of(rsf[m]);
#pragma unroll
        for (int j = 0; j < 4; ++j) { const f32x4 gg = *(const f32x4*)(g + 4 * F.lane + 256 * j); *(f32x4*)(out + (size_t)m * D + 4 * F.lane + 256 * j) = v[j] * rs * gg; } }
}

#ifndef TAIL_XF
#define TAIL_XF 12288
#endif
#ifndef TAIL_L1A
#define TAIL_L1A 5120
#endif
#ifndef TAIL_L1B
#define TAIL_L1B 3072
#endif
#ifndef TAIL_XF4
#define TAIL_XF4 4096
#endif
constexpr int I_WIN = 16 * 88, I_BR = 8 * 16, I_SQ = 16 * 16, I_UP = 16 * 32, I_PP = 4 * 16, I_POOL = 4;
constexpr int CONV_PER_LAYER = I_WIN + 3 * I_BR + I_SQ + 32 * I_UP + 32 * I_SQ + I_SQ + I_PP + 4 * I_POOL, CONV_NEXP = 32 * I_UP + 32 * I_SQ;
__device__ __forceinline__ TrDesc conv_desc(Frame& F, int l, int r) {
    if (r < 32 * I_UP) { const int e = r / I_UP, q = r % I_UP, kb = q / 32, nb = q % 32;
        return TrDesc{kin(21) + ((size_t)l * NE + e) * D * 2048, WSP(bf16_t, WS_WUP) + ((size_t)l * NE + e) * 2048 * D, kin(18) + l * D, 2048, D, 64 * kb, 64 * nb, up_dst64(64 * nb)}; } r -= 32 * I_UP;
    if (r < 32 * I_SQ) { const int e = r / I_SQ, q = r % I_SQ, kb = q / 16, nb = q % 16;
        return TrDesc{kin(23) + ((size_t)l * NE + e) * D * D, WSP(bf16_t, WS_WDN) + ((size_t)l * NE + e) * D * D, nullptr, D, D, 64 * kb, 64 * nb, 64 * nb}; } r -= 32 * I_SQ;
    if (r < I_WIN) { const int kb = r / 88, nb = r % 88;
        return TrDesc{kin(3) + (size_t)l * D * NZ, WSP(bf16_t, WS_WIN) + (size_t)l * NZ * D, kin(2) + l * D, NZ, D, 64 * kb, 64 * nb, win_dst64(64 * nb)}; } r -= I_WIN;
    if (r < 3 * I_BR) { const int k = r / I_BR, q = r % I_BR, kb = q / 16, nb = q % 16;
        return TrDesc{kin(15) + ((size_t)l * 3 + k) * 512 * D, WSP(bf16_t, WS_WBR) + ((size_t)l * 3 + k) * D * 512, nullptr, D, 512, 64 * kb, 64 * nb, 64 * nb}; } r -= 3 * I_BR;
    if (r < I_SQ) { const int kb = r / 16, nb = r % 16;
        return TrDesc{kin(17) + (size_t)l * D * D, WSP(bf16_t, WS_WOUT) + (size_t)l * D * D, nullptr, D, D, 64 * kb, 64 * nb, 64 * nb}; } r -= I_SQ;
    if (r < I_SQ) { const int kb = r / 16, nb = r % 16;
        return TrDesc{kin(26) + (size_t)l * D * D, WSP(bf16_t, WS_WPG) + (size_t)l * D * D, kin(25) + l * D, D, D, 64 * kb, 64 * nb, 64 * nb}; } r -= I_SQ;
    if (r < I_PP) { const int kb = r / 16, nb = r % 16;
        return TrDesc{kin(27) + (size_t)l * PLE * D, WSP(bf16_t, WS_WPP) + (size_t)l * D * PLE, nullptr, D, PLE, 64 * kb, 64 * nb, 64 * nb}; } r -= I_PP;
    { const int g = r / I_POOL, q = r % I_POOL, kb = q / 2, nb = q % 2;
        return TrDesc{kin(5) + ((size_t)l * 4 + g) * 128 * 128, WSP(bf16_t, WS_SMALLW + l * SW_LAYER + SW_WPT) + (size_t)g * 128 * 128, nullptr, 128, 128, 64 * kb, 64 * nb, 64 * nb}; }
}
template <class Map> __device__ __forceinline__ void conv_stream(Frame& F, int first, int stride, int count, const Map& map) {
    LAS float* scr = (LAS float*)(F.lds + F.wave * 16640);
    if (first >= count) return;
    f32x4 va[16], vb[16]; float sa[16], sb[16];
    int l, r; map(first, l, r); TrDesc da = conv_desc(F, l, r), db = da;
    tr_load(da, F.lane, va, sa);
    for (int it = first; it < count; it += 2 * stride) {
        const bool hb = it + stride < count;
        if (hb) { map(it + stride, l, r); db = conv_desc(F, l, r); tr_load(db, F.lane, vb, sb); }
        tr_store(da, F.lane, va, sa, scr);
        const bool ha = it + 2 * stride < count;
        if (ha) { map(it + 2 * stride, l, r); da = conv_desc(F, l, r); tr_load(da, F.lane, va, sa); }
        if (hb) tr_store(db, F.lane, vb, sb, scr);
    }
}
__device__ __forceinline__ void phase_weights(Frame& F) {
    const int gw = F.vcu * 8 + F.wave, NGW = F.G * 8;
    conv_stream(F, gw, NGW, I_WIN, [](int it, int& l, int& r) { l = 0; r = CONV_NEXP + it; });
    const size_t gt = (size_t)F.vcu * 512 + F.tid, NGT = (size_t)F.G * 512;
    { const float* sguw = kin(13);
      for (size_t i = gt; i < (size_t)NL * 4 * 128 * 128; i += NGT) { const int l = (int)(i >> 16), r = (int)(i & 65535), t = (r >> 7) & 127, s = r & 127;
        WSP(bf16_t, WS_SMALLW + l * SW_LAYER + SW_WSGU)[r] = (bf16_t)f2bf(s <= t ? sguw[i] : 0.f); } }
    { const float* rw = kin(19); const float* mn = kin(18);
      for (size_t i = gt; i < (size_t)NL * NE * D; i += NGT) { const int l = (int)(i >> 15), r = (int)(i & 32767), e = r >> 10, k = r & 1023;
        const float w = rw[((size_t)l * D + k) * NE + e] * mn[l * D + k]; const unsigned hi = f2bf(w); const float wl = w - __builtin_bit_cast(float, hi << 16);
        WSP(bf16_t, WS_SMALLW + l * SW_LAYER + SW_WRT)[r] = (bf16_t)hi; WSP(bf16_t, WS_SMALLW + l * SW_LAYER + SW_WRT + 65536)[r] = (bf16_t)f2bf(wl); } }
    { const float* bi = kin(4);
      for (size_t i = gt; i < (size_t)NL * NZ; i += NGT) { const int l = (int)(i / NZ), np = (int)(i % NZ);
        WSP(float, WS_SMALLW + l * SW_LAYER + SW_BIN)[np] = bi[l * NZ + win_src(np)]; } }
    { const float* bu = kin(22);
      for (size_t i = gt; i < (size_t)NL * NE * 2048; i += NGT) { const int l = (int)(i >> 16), r = (int)(i & 65535), e = r >> 11, np = r & 2047;
        WSP(float, WS_SMALLW + l * SW_LAYER + SW_BUP)[r] = bu[((size_t)l * NE + e) * 2048 + up_src(np)]; } }
    { rs_t* rsz = WSP(rs_t, WS_RS) + T; for (size_t i = gt; i < (size_t)3 * NL * T; i += NGT) rsz[i] = 0ull; }
    { const float* x = kin(0); bf16_t* X0 = WSP(bf16_t, WS_X0); rs_t* rs0 = WSP(rs_t, WS_RS);
      for (int m = gw; m < T; m += NGW) { f32x4 v[4]; row_load(x + (size_t)m * D, F.lane, v); const float ss = row_sumsq(v); row_store_bf16(X0 + (size_t)m * D, F.lane, v, 1.0f); if (F.lane == 0) rs0[m] = rs_fix(ss); } }
}
__device__ __forceinline__ void phase_convert_rest(Frame& F, int nb0) {
    const int nb = F.G - nb0, gw = ((int)blockIdx.x - nb0) * 8 + F.wave, NGW = nb * 8;
    constexpr int L0REST = CONV_PER_LAYER - CONV_NEXP - I_WIN, L0ALL = L0REST + CONV_NEXP;
    conv_stream(F, gw, NGW, L0ALL + CONV_PER_LAYER - TAIL_XF - TAIL_XF4 - TAIL_L1A - TAIL_L1B, [](int it, int& l, int& r) { if (it < L0REST) { l = 0; r = CONV_NEXP + I_WIN + it; } else if (it < L0ALL) { l = 0; r = it - L0REST; } else { l = 1; r = it - L0ALL + TAIL_XF + TAIL_XF4; if (r >= 32 * I_UP) r += TAIL_L1A + TAIL_L1B; } });
    const size_t gt = (size_t)((int)blockIdx.x - nb0) * 512 + F.tid, NGT = (size_t)nb * 512;
    { const float* pp = kin(1);
      for (size_t i = gt; i < (size_t)NL * T * PLE / 4; i += NGT) { const f32x4 v = *(const f32x4*)(pp + 4 * i); u32x2 w; w.x = pk2(v[0], v[1]); w.y = pk2(v[2], v[3]); *(u32x2*)(WSP(bf16_t, WS_PB) + 4 * i) = w; } }
}
__device__ __forceinline__ void conv_tail(Frame& F, int j, int n, int first, int count) {
    conv_stream(F, j * 8 + F.wave, n * 8, count, [first](int it, int& l, int& r) { l = 1; r = first + it; });
}

__device__ __forceinline__ float reduce_scatter64(float (&v)[64], int lane) {
#pragma unroll
    for (int m = 32, n = 32; m >= 1; m >>= 1, n >>= 1) {
        const bool up = (lane & m) != 0; float rcv[32];
#pragma unroll
        for (int i = 0; i < n; ++i) { const float a = v[i], b = v[i + n]; const float send = up ? a : b; v[i] = up ? b : a; rcv[i] = __shfl_xor(send, m); }
        __builtin_amdgcn_sched_barrier(0);
#pragma unroll
        for (int i = 0; i < n; ++i) v[i] += rcv[i];
    }
    return v[0];
}
__device__ __forceinline__ float reduce_scatter32(float (&v)[32], int lane) {
#pragma unroll
    for (int m = 32, n = 16; m >= 2; m >>= 1, n >>= 1) {
        const bool up = (lane & m) != 0; float rcv[16];
#pragma unroll
        for (int i = 0; i < n; ++i) { const float a = v[i], b = v[i + n]; const float send = up ? a : b; v[i] = up ? b : a; rcv[i] = __shfl_xor(send, m); }
        __builtin_amdgcn_sched_barrier(0);
#pragma unroll
        for (int i = 0; i < n; ++i) v[i] += rcv[i];
    }
    return v[0] + __shfl_xor(v[0], 1);
}
__device__ __forceinline__ void conv_unit(Frame& F, int l, int u) {
    const int t0 = 64 * u, s0 = t0 & (SEQ - 1);
    const bf16_t* ZP = WSP(bf16_t, WS_ZP);
    LAS unsigned char* in = F.lds;
    {
        u32x4 cv[12];
#pragma unroll
        for (int q = 0; q < 12; ++q) { const int idx = F.tid + 512 * q, r = idx >> 6, c16 = idx & 63; const int pos = s0 - 30 + r, rr = pos >= 0 ? t0 - 30 + r : t0 - s0;
            cv[q] = (idx < 94 * 64) ? *(const u32x4*)(ZP + (size_t)rr * ZPW + ZP_GLU + 8 * c16) : (u32x4){0u, 0u, 0u, 0u}; }
        __builtin_amdgcn_sched_barrier(0);
#pragma unroll
        for (int q = 0; q < 12; ++q) { const int idx = F.tid + 512 * q, r = idx >> 6, c16 = idx & 63; const bool ok = (s0 - 30 + r >= 0);
            u32x4 v = cv[q]; v.x = ok ? v.x : 0u; v.y = ok ? v.y : 0u; v.z = ok ? v.z : 0u; v.w = ok ? v.w : 0u;
            if (idx < 94 * 64) *(LAS u32x4*)(in + r * 1024 + c16 * 16) = v; }
    }
    const int cp = F.tid & 255, half = F.tid >> 8;
    f32x2 w[CONVK]; const float* cwp = kin(7);
#pragma unroll
    for (int j = 0; j < CONVK; ++j) w[j] = *(const f32x2*)(cwp + ((size_t)l * CONVK + j) * 512 + 2 * cp);
    const f32x2 cb = *(const f32x2*)(kin(8) + l * 512 + 2 * cp);
    f32x2 acc[32];
#pragma unroll
    for (int o = 0; o < 32; ++o) acc[o] = cb;
    __syncthreads();
    const LAS unsigned char* ip = in + (32 * half) * 1024 + cp * 4;
    unsigned pvl[62];
#pragma unroll
    for (int rr = 0; rr < 62; ++rr) pvl[rr] = *(const LAS unsigned*)(ip + rr * 1024);
    __builtin_amdgcn_sched_barrier(0);
#pragma unroll
    for (int rr = 0; rr < 62; ++rr) { const unsigned pv = pvl[rr]; const f32x2 v = (f32x2){bflo(pv), bfhi(pv)};
#pragma unroll
        for (int o = (rr > 30 ? rr - 30 : 0); o <= (rr < 31 ? rr : 31); ++o) acc[o] = acc[o] + w[rr - o] * v; }
    float st[64];
#pragma unroll
    for (int o = 0; o < 32; ++o) { st[o] = acc[o].x + acc[o].y; st[32 + o] = acc[o].x * acc[o].x + acc[o].y * acc[o].y; }
    const float tot = reduce_scatter64(st, F.lane);
    LAS float* red = (LAS float*)(F.lds + LDS_TAB);
    red[F.wave * 64 + F.lane] = tot;
    __syncthreads();
    if (F.tid < 128) { const int h = F.tid >> 6, i = F.tid & 63; red[512 + F.tid] = (red[(4 * h) * 64 + i] + red[(4 * h + 1) * 64 + i]) + (red[(4 * h + 2) * 64 + i] + red[(4 * h + 3) * 64 + i]); }
    __syncthreads();
    const f32x2 ng = *(const f32x2*)(kin(9) + l * 512 + 2 * cp), nb = *(const f32x2*)(kin(10) + l * 512 + 2 * cp);
    bf16_t* Y = WSP(bf16_t, WS_Y) + (size_t)(t0 + 32 * half) * YW + 512 + 2 * cp;
#pragma unroll
    for (int o = 0; o < 32; ++o) { const float mean = red[512 + half * 64 + o] * (1.0f / 512.0f), var = red[512 + half * 64 + 32 + o] * (1.0f / 512.0f) - mean * mean; const float rs = 1.0f / sqrtf(fmaxf(var, 0.f) + EPS);
        float y0 = (acc[o].x - mean) * rs * ng.x + nb.x, y1 = (acc[o].y - mean) * rs * ng.y + nb.y; y0 = y0 * sigmoidf_(y0); y1 = y1 * sigmoidf_(y1);
        *(unsigned*)(Y + (size_t)o * YW) = pk2(y0, y1); }
    __syncthreads();
}
template <int W> __device__ __forceinline__ void pool_window(const f32x2 (&f)[47], const f32x2 (&pre)[48], int s_first, LAS unsigned char* pa) {
#pragma unroll
    for (int o = 0; o < 32; ++o) { const f32x2 s = pre[o + 16] - pre[o + 16 - W];
        const int pos = s_first + o; const float inv = 1.0f / (float)(pos + 1 < W ? pos + 1 : W);
        const f32x2 p = s * inv - f[o + 15];
        *(LAS unsigned*)(pa + o * 1040) = pk2(p.x, p.y); }
}
__device__ __forceinline__ void pool_unit(Frame& F, int l, int u) {
    const int t0 = 64 * u, s0 = t0 & (SEQ - 1);
    const bf16_t* ZP = WSP(bf16_t, WS_ZP);
    LAS unsigned char* pA = F.lds;
    const int cp = F.tid & 255, half = F.tid >> 8, first = t0 + 32 * half;
    f32x2 f[47]; unsigned pvr[47];
#pragma unroll
    for (int i = 0; i < 47; ++i) { const int pos = s0 + 32 * half - 15 + i; const int rr = pos >= 0 ? first - 15 + i : t0 - s0;
        pvr[i] = *(const unsigned*)(ZP + (size_t)rr * ZPW + ZP_ZA + 2 * cp); }
    __builtin_amdgcn_sched_barrier(0);
#pragma unroll
    for (int i = 0; i < 47; ++i) { const int pos = s0 + 32 * half - 15 + i; const unsigned pv = pos >= 0 ? pvr[i] : 0u; f[i] = (f32x2){bflo(pv), bfhi(pv)}; }
    LAS unsigned char* pa = pA + (32 * half) * 1040 + cp * 4;
    const int g = (F.wave & 3);
    f32x2 pre[48]; pre[0] = (f32x2){0.f, 0.f};
#pragma unroll
    for (int i = 0; i < 47; ++i) pre[i + 1] = pre[i] + f[i];
    if (g == 0) pool_window<2>(f, pre, s0 + 32 * half, pa); else if (g == 1) pool_window<4>(f, pre, s0 + 32 * half, pa); else if (g == 2) pool_window<8>(f, pre, s0 + 32 * half, pa); else pool_window<16>(f, pre, s0 + 32 * half, pa);
    __syncthreads();
    const int gg = F.wave >> 1, dh = F.wave & 1, r = F.lane & 31, h = F.lane >> 5;
    const bf16_t* WPT = WSP(bf16_t, WS_SMALLW + l * SW_LAYER + SW_WPT) + (size_t)gg * 128 * 128;
    f32x16 acc[2][2];
#pragma unroll
    for (int mi = 0; mi < 2; ++mi)
#pragma unroll
        for (int ni = 0; ni < 2; ++ni)
#pragma unroll
            for (int q = 0; q < 16; ++q) acc[mi][ni][q] = 0.f;
    bf16x8 bw[8][2];
#pragma unroll
    for (int s = 0; s < 8; ++s)
#pragma unroll
        for (int ni = 0; ni < 2; ++ni) bw[s][ni] = *(const bf16x8*)(WPT + (size_t)(64 * dh + 32 * ni + r) * 128 + 16 * s + 8 * h);
#pragma unroll
    for (int s = 0; s < 8; ++s) { bf16x8 a[2];
#pragma unroll
        for (int mi = 0; mi < 2; ++mi) a[mi] = *(const LAS bf16x8*)(pA + (32 * mi + r) * 1040 + (128 * gg + 16 * s + 8 * h) * 2);
#pragma unroll
        for (int mi = 0; mi < 2; ++mi)
#pragma unroll
            for (int ni = 0; ni < 2; ++ni) acc[mi][ni] = __builtin_amdgcn_mfma_f32_32x32x16_bf16(bw[s][ni], a[mi], acc[mi][ni], 0, 0, 0); }
    bf16_t* Y = WSP(bf16_t, WS_Y); const float* psc = kin(6);
#pragma unroll
    for (int ni = 0; ni < 2; ++ni)
#pragma unroll
        for (int g = 0; g < 4; ++g) { const int d = 128 * gg + 64 * dh + 32 * ni + 8 * g + 4 * h; const f32x4 sc = *(const f32x4*)(psc + l * 512 + d);
#pragma unroll
            for (int mi = 0; mi < 2; ++mi) { u32x2 o; o.x = pk2(acc[mi][ni][4 * g + 0] * sc[0], acc[mi][ni][4 * g + 1] * sc[1]); o.y = pk2(acc[mi][ni][4 * g + 2] * sc[2], acc[mi][ni][4 * g + 3] * sc[3]);
                *(u32x2*)(Y + (size_t)(t0 + 32 * mi + r) * YW + d) = o; } }
    __syncthreads();
}
__device__ __forceinline__ void sgu_unit(Frame& F, int l, int u) {
    const int chunk = u >> 1, hp = u & 1, t0 = 128 * chunk;
    const bf16_t* ZP = WSP(bf16_t, WS_ZP);
    LAS unsigned char* vT = F.lds;
    {
        const float* lng = kin(11) + l * 512 + 8 * F.lane; const float* lnb = kin(12) + l * 512 + 8 * F.lane;
        const f32x4 g0 = *(const f32x4*)lng, g1 = *(const f32x4*)(lng + 4);
        const f32x4 b0 = *(const f32x4*)lnb, b1 = *(const f32x4*)(lnb + 4);
        u32x4 pvv[16];
#pragma unroll
        for (int i = 0; i < 16; ++i) pvv[i] = *(const u32x4*)(ZP + (size_t)(t0 + 16 * F.wave + i) * ZPW + ZP_ZV + 8 * F.lane);
        float st[32];
#pragma unroll
        for (int i = 0; i < 16; ++i) { const u32x4 pv = pvv[i]; const float x0 = bflo(pv.x), x1 = bfhi(pv.x), x2 = bflo(pv.y), x3 = bfhi(pv.y), x4 = bflo(pv.z), x5 = bfhi(pv.z), x6 = bflo(pv.w), x7 = bfhi(pv.w);
            st[i] = ((x0 + x1) + (x2 + x3)) + ((x4 + x5) + (x6 + x7)); st[16 + i] = ((x0 * x0 + x1 * x1) + (x2 * x2 + x3 * x3)) + ((x4 * x4 + x5 * x5) + (x6 * x6 + x7 * x7)); }
        const float tot = reduce_scatter32(st, F.lane);
        LAS float* wst = (LAS float*)(F.lds + LDS_TAB) + 32 * F.wave;
        if ((F.lane & 1) == 0) wst[F.lane >> 1] = tot;
        LDS_WAIT(); asm volatile("" ::: "memory");
        if ((F.lane >> 5) == hp) { const int cl = 8 * (F.lane & 31);
            float mu[16], rsd[16];
#pragma unroll
            for (int i = 0; i < 16; ++i) { const float mean = wst[i] * (1.0f / 512.0f), var = wst[16 + i] * (1.0f / 512.0f) - mean * mean; mu[i] = mean; rsd[i] = 1.0f / sqrtf(fmaxf(var, 0.f) + EPS); }
#pragma unroll
            for (int j = 0; j < 8; ++j) { const float gg = j < 4 ? g0[j & 3] : g1[j & 3], bb = j < 4 ? b0[j & 3] : b1[j & 3]; unsigned w[8];
#pragma unroll
                for (int i2 = 0; i2 < 8; ++i2) { const unsigned pa = pvv[2 * i2][j >> 1], pb = pvv[2 * i2 + 1][j >> 1];
                    const float xa = (j & 1) ? bfhi(pa) : bflo(pa), xb = (j & 1) ? bfhi(pb) : bflo(pb);
                    w[i2] = pk2((xa - mu[2 * i2]) * rsd[2 * i2] * gg + bb, (xb - mu[2 * i2 + 1]) * rsd[2 * i2 + 1] * gg + bb); }
                LAS unsigned char* dst = vT + (cl + j) * 272 + (16 * F.wave) * 2;
                *(LAS u32x4*)dst = (u32x4){w[0], w[1], w[2], w[3]}; *(LAS u32x4*)(dst + 16) = (u32x4){w[4], w[5], w[6], w[7]}; }
        }
    }
    const int hl = F.wave >> 2, ti = F.wave & 3, hh = 2 * hp + hl, r = F.lane & 31, h = F.lane >> 5;
    const bf16_t* WS_ = WSP(bf16_t, WS_SMALLW + l * SW_LAYER + SW_WSGU) + (size_t)hh * 128 * 128;
    bf16x8 af[8];
#pragma unroll
    for (int k = 0; k < 8; ++k) if (k < 2 * (ti + 1)) af[k] = *(const bf16x8*)(WS_ + (size_t)(32 * ti + r) * 128 + 16 * k + 8 * h);
    __syncthreads();
    f32x16 acc[4];
#pragma unroll
    for (int ci = 0; ci < 4; ++ci)
#pragma unroll
        for (int q = 0; q < 16; ++q) acc[ci][q] = 0.f;
#pragma unroll
    for (int k = 0; k < 8; ++k) if (k < 2 * (ti + 1)) {
#pragma unroll
        for (int ci = 0; ci < 4; ++ci) { const bf16x8 b = *(const LAS bf16x8*)(vT + (128 * hl + 32 * ci + r) * 272 + (16 * k + 8 * h) * 2);
            acc[ci] = __builtin_amdgcn_mfma_f32_32x32x16_bf16(b, af[k], acc[ci], 0, 0, 0); }
    }
    bf16_t* Y = WSP(bf16_t, WS_Y);
    { const int tl = 32 * ti + r; const float sb = kin(14)[((size_t)l * 4 + hh) * 128 + tl];
      const bf16_t* zr = ZP + (size_t)(t0 + tl) * ZPW + ZP_ZU + 128 * hh + 4 * h; bf16_t* yr = Y + (size_t)(t0 + tl) * YW + 1024 + 128 * hh + 4 * h;
      u32x2 zu[4][4];
#pragma unroll
      for (int ci = 0; ci < 4; ++ci)
#pragma unroll
          for (int g = 0; g < 4; ++g) zu[ci][g] = *(const u32x2*)(zr + 32 * ci + 8 * g);
#pragma unroll
      for (int ci = 0; ci < 4; ++ci)
#pragma unroll
          for (int g = 0; g < 4; ++g) { const u32x2 z = zu[ci][g]; u32x2 o;
              o.x = pk2(bflo(z.x) * (acc[ci][4 * g + 0] + sb), bfhi(z.x) * (acc[ci][4 * g + 1] + sb)); o.y = pk2(bflo(z.y) * (acc[ci][4 * g + 2] + sb), bfhi(z.y) * (acc[ci][4 * g + 3] + sb));
              *(u32x2*)(yr + 32 * ci + 8 * g) = o; } }
    __syncthreads();
}
#ifndef MIX_DUP
#define MIX_DUP 0
#endif
__device__ __forceinline__ void phase_mix(Frame& F, int l) {
    for (int rep = 0; rep < ((MIX_DUP & 1) ? 2 : 1); ++rep) for (int u = F.vcu; u < 256; u += F.G) sgu_unit(F, l, u);
    for (int rep = 0; rep < ((MIX_DUP & 2) ? 2 : 1); ++rep) for (int u = F.vcu; u < 256; u += F.G) conv_unit(F, l, u);
    for (int rep = 0; rep < ((MIX_DUP & 4) ? 2 : 1); ++rep) for (int u = F.vcu; u < 256; u += F.G) pool_unit(F, l, u);
}

__device__ __forceinline__ void phase_router(Frame& F, int l, const bf16_t* x, const rs_t* rs) {
    LAS float* P = (LAS float*)F.lds;
    LAS int* hist = (LAS int*)(F.lds + LDS_TAB);
    const bf16_t* WH = WSP(bf16_t, WS_SMALLW + l * SW_LAYER + SW_WRT); const bf16_t* WL = WH + 32768;
    float* TW = WSP(float, WS_TOPW); int* TOKL = WSP(int, WS_TOKL); int* SO = WSP(int, WS_SLOTOF);
    unsigned* gcnt = (unsigned*)(F.ws + WS_CTL) + CW_GCNT + 32 * l;
    const float* rbias = kin(20) + l * NE;
    if (F.tid < 32) hist[F.tid] = 0;
    const int rb = F.wave & 1, kq = F.wave >> 1, r = F.lane & 31, h = F.lane >> 5;
    for (int blk = F.vcu; blk < 256; blk += F.G) {
        const bf16_t* xr = x + (size_t)(64 * blk + 32 * rb + r) * D + 256 * kq + 8 * h;
        const bf16_t* whp = WH + (size_t)r * D + 256 * kq + 8 * h; const bf16_t* wlp = WL + (size_t)r * D + 256 * kq + 8 * h;
        bf16x8 xa[16];
#pragma unroll
        for (int s2 = 0; s2 < 16; ++s2) xa[s2] = *(const bf16x8*)(xr + 16 * s2);
        f32x16 acc;
#pragma unroll
        for (int q = 0; q < 16; ++q) acc[q] = 0.f;
#pragma unroll
        for (int sb = 0; sb < 4; ++sb) { bf16x8 ha[4], la[4];
#pragma unroll
            for (int s2 = 0; s2 < 4; ++s2) { ha[s2] = *(const bf16x8*)(whp + 16 * (4 * sb + s2)); la[s2] = *(const bf16x8*)(wlp + 16 * (4 * sb + s2)); }
#pragma unroll
            for (int s2 = 0; s2 < 4; ++s2) { acc = __builtin_amdgcn_mfma_f32_32x32x16_bf16(xa[4 * sb + s2], ha[s2], acc, 0, 0, 0); acc = __builtin_amdgcn_mfma_f32_32x32x16_bf16(xa[4 * sb + s2], la[s2], acc, 0, 0, 0); } }
#pragma unroll
        for (int q = 0; q < 16; ++q) P[(kq * 64 + 32 * rb + (q & 3) + 8 * (q >> 2) + 4 * h) * 33 + r] = acc[q];
        __syncthreads();
        if (F.lane < 8) {
            const int rl = 8 * F.wave + F.lane, row = 64 * blk + rl; const float rstd = rstd_of(rs[row]);
            float v0 = -3.0e38f, v1 = -3.0e38f, v2 = -3.0e38f, v3 = -3.0e38f; int i0 = 0, i1 = 0, i2 = 0, i3 = 0;
#pragma unroll
            for (int e = 0; e < 32; ++e) { const float v = ((P[(0 * 64 + rl) * 33 + e] + P[(1 * 64 + rl) * 33 + e]) + (P[(2 * 64 + rl) * 33 + e] + P[(3 * 64 + rl) * 33 + e])) * rstd + rbias[e];
                const bool c0 = v > v0, c1 = v > v1, c2 = v > v2, c3 = v > v3;
                v3 = c2 ? v2 : (c3 ? v : v3); i3 = c2 ? i2 : (c3 ? e : i3);
                v2 = c1 ? v1 : (c2 ? v : v2); i2 = c1 ? i1 : (c2 ? e : i2);
                v1 = c0 ? v0 : (c1 ? v : v1); i1 = c0 ? i0 : (c1 ? e : i1);
                v0 = c0 ? v : v0;             i0 = c0 ? e : i0; }
            const f32x4 tw = (f32x4){1.0f, __expf(v1 - v0), __expf(v2 - v0), __expf(v3 - v0)};
            *(f32x4*)(TW + row * 4) = tw;
            const int ie[4] = {i0, i1, i2, i3};
#pragma unroll
            for (int k = 0; k < 4; ++k) { const int rk = __hip_atomic_fetch_add((int*)(hist + ie[k]), 1, __ATOMIC_RELAXED, __HIP_MEMORY_SCOPE_WORKGROUP);
                hist[64 + rl * 4 + k] = ie[k] | (rk << 8); }
        }
        __syncthreads();
        if (F.tid < 32) { hist[32 + F.tid] = (int)__hip_atomic_fetch_add(gcnt + F.tid, (unsigned)hist[F.tid], __ATOMIC_RELAXED, __HIP_MEMORY_SCOPE_AGENT); hist[F.tid] = 0; }
        __syncthreads();
        if (F.tid < 256) { const int pk = hist[64 + F.tid], e = pk & 255, pos = hist[32 + e] + (pk >> 8), tok = 64 * blk + (F.tid >> 2);
            TOKL[e * T + pos] = tok; SO[tok * 4 + (F.tid & 3)] = e | (pos << 5); }
        __syncthreads();
    }
}
__device__ __forceinline__ void moe_tables(Frame& F, int l, bool split_tail = false) {
    LAS int* tab = (LAS int*)(F.lds + LDS_TAB);
    const unsigned* gcnt = (const unsigned*)(F.ws + WS_CTL) + CW_GCNT + 32 * l;
    if (F.tid < 64) { const int e = F.lane & 31; const int c = (int)gcnt[e]; const int pt = (c + 255) >> 8; int incl = pt;
#pragma unroll
        for (int o = 1; o < 32; o <<= 1) { const int v = __shfl_up(incl, o, 32); if (e >= o) incl += v; }
        if (F.lane < 32) { tab[MT_CNT + e] = c; tab[MT_TSTART + e] = incl - pt;
            if (e == 31) { tab[MT_NTILE] = incl;
                const int nu = incl * 4, nf = (nu / F.G) * F.G, rem = nu - nf; const int sp = (!split_tail || rem == 0) ? 1 : (rem * 4 <= F.G ? 4 : (rem * 2 <= F.G ? 2 : 1));
                tab[MT_SPLIT] = sp; tab[MT_NFULL] = nf; tab[MT_TAILROW] = (nf / 4) * 256; } } }
    __syncthreads();
    if (F.tid <= MAXTILES) { int e = 0;
#pragma unroll
        for (int q = 0; q < 31; ++q) e += (int)(((unsigned)(F.tid - tab[MT_TSTART + q + 1])) >> 31) ^ 1;
        tab[MT_TE + F.tid] = e; }
    __syncthreads();
}
__device__ __forceinline__ void phase_combine(Frame& F, int l, const bf16_t* xin, bf16_t* xout, rs_t* rsout) {
    moe_tables(F, l, SPLITK_TAIL && l == NL - 1);
    const int gw = F.vcu * 8 + F.wave, NGW = F.G * 8;
    const int* SO = WSP(int, WS_SLOTOF); const float* TW = WSP(float, WS_TOPW); const bf16_t* YE = WSP(bf16_t, WS_YE);
    const LAS int* tab = (const LAS int*)(F.lds + LDS_TAB); const int sp = tab[MT_SPLIT], trow = tab[MT_TAILROW]; const bf16_t* YEX = WSP(bf16_t, WS_YEX);
    for (int m = gw; m < T; m += NGW) {
        u32x2 p[4]; f32x4 v[4]; row_load_bf(xin + (size_t)m * D, F.lane, p);
        const f32x4 tw = *(const f32x4*)(TW + m * 4); const float twi = 1.0f / ((tw[0] + tw[1]) + (tw[2] + tw[3]));
        u32x2 y[4][4]; int slots[4];
#pragma unroll
        for (int k = 0; k < 4; ++k) { const int pk = SO[m * 4 + k]; slots[k] = tab[MT_TSTART + (pk & 31)] * 256 + (pk >> 5); row_load_bf(YE + (size_t)slots[k] * D, F.lane, y[k]); }
        row_unpack(p, v);
        if (sp > 1) {
#pragma unroll
            for (int k = 0; k < 4; ++k) if (slots[k] >= trow) { const float w = tw[k] * twi;
                for (int q = 1; q < sp; ++q) { u32x2 z[4]; row_load_bf(YEX + ((size_t)(q - 1) * YEX_ROWS + (size_t)(slots[k] - trow)) * D, F.lane, z);
#pragma unroll
                    for (int j = 0; j < 4; ++j) { v[j][0] += w * bflo(z[j].x); v[j][1] += w * bfhi(z[j].x); v[j][2] += w * bflo(z[j].y); v[j][3] += w * bfhi(z[j].y); } } } }
#pragma unroll
        for (int k = 0; k < 4; ++k) { const float w = tw[k] * twi;
#pragma unroll
            for (int j = 0; j < 4; ++j) { v[j][0] += w * bflo(y[k][j].x); v[j][1] += w * bfhi(y[k][j].x); v[j][2] += w * bflo(y[k][j].y); v[j][3] += w * bfhi(y[k][j].y); } }
        const float ss = row_sumsq(v); row_store_bf16(xout + (size_t)m * D, F.lane, v, 1.0f); if (F.lane == 0) rsout[m] = rs_fix(ss);
    }
}

__device__ __forceinline__ void idle_set(int n_units, int G, int c, int& j, int& n) {
    const int rem = n_units % G; if (rem == 0 || G - rem < 32) { j = c; n = G; } else { j = c - rem; n = G - rem; }
}
constexpr int PH_PER_LAYER = 9, N_PHASES = 1 + NL * PH_PER_LAYER + 1;
__global__ void __launch_bounds__(512, 2) mega_fwd(Args args) {
    extern __shared__ __attribute__((aligned(16))) unsigned char lds_raw[];
    Frame F;
    F.lds = (LAS unsigned char*)lds_raw; F.tid = threadIdx.x; F.lane = F.tid & 63; F.wave = __builtin_amdgcn_readfirstlane(F.tid >> 6);
    F.G = gridDim.x; { const int bx = blockIdx.x; F.vcu = (F.G % 8 == 0) ? (bx % 8) * (F.G / 8) + bx / 8 : bx; }
    F.out = args.out; F.ws = args.ws;
    volatile LAS unsigned* MISC = (volatile LAS unsigned*)(F.lds + LDS_MISC);
    if (F.tid < 64) MISC[F.tid] = 0u;
    __syncthreads();
    XcdBarrier bar; bar.bar = (unsigned*)(F.ws + WS_CTL) + CW_BAR; bar.x = 0; bar.st = nullptr;
    const int lo = args.ph_lo, hi = args.ph_hi;
    if (hi - lo > 1 && !args.use_cg) bar = xcd_barrier_post((unsigned*)(F.ws + WS_CTL) + CW_BAR, MISC + 8);
#ifndef BAR_DUP
#define BAR_DUP 0
#endif
#define SEAM(ph) do { if ((ph) + 1 < hi) { if (args.use_cg) cg::this_grid().sync(); else { xcd_barrier(bar); if (BAR_DUP) xcd_barrier(bar); } } } while (0)
#ifndef PH_MASK
#define PH_MASK 0xffff
#endif
#define PHT(k) ((k) == 0 ? 11 : (k) == N_PHASES - 1 ? 12 : ((k) - 1) % PH_PER_LAYER)
#define IN(k) (((PH_MASK >> PHT(k)) & 1) && lo <= (k) && (k) < hi)
#ifndef KDUP_MASK
#define KDUP_MASK 0
#endif
#ifndef SPLIT_GC
#define SPLIT_GC 160
#endif
#ifndef DUP_MASK
#define DUP_MASK 0
#endif
#define REPEAT(k) for (int rep_ = 0, nrep_ = (((DUP_MASK >> PHT(k)) & 1) ? 2 : 1); rep_ < nrep_; ++rep_, (rep_ < nrep_ ? xcd_barrier(bar) : (void)0))
    if (IN(0)) { REPEAT(0) { F.refresh(); phase_weights(F); } SEAM(0); }
    bf16_t* const X0 = WSP(bf16_t, WS_X0); bf16_t* const X1 = WSP(bf16_t, WS_X1); bf16_t* const X2 = WSP(bf16_t, WS_X2);
    for (int l = 0; l < NL; ++l) {
        const int pb = 1 + l * PH_PER_LAYER;
        const unsigned char* sw = F.ws + WS_SMALLW + l * SW_LAYER;
        rs_t* const rs0 = WSP(rs_t, WS_RS) + (size_t)(3 * l) * T;
        if (IN(pb + 0)) { REPEAT(pb + 0) { F.refresh();
            const int gc = (l == 0 && F.G > SPLIT_GC) ? SPLIT_GC : F.G;
            if ((int)blockIdx.x < gc) {
                DenseOrder S{(const char*)X0, (const char*)(WSP(bf16_t, WS_WIN) + (size_t)l * NZ * D), 64, 22, gc, (int)blockIdx.x, (size_t)256 * D * 2, (size_t)256 * D * 2, (KDUP_MASK >> 0) & 1};
                EpiIn E{WSP(bf16_t, WS_ZP), (const float*)(sw + SW_BIN), rs0};
                pg8::gemm_phase(F.lds, D, D, D, S, E);
                if (l == 0 && gc == F.G) { F.refresh(); phase_convert_rest(F, 0); }
                if (l == 1 && TAIL_L1A > 0) { int j, n; idle_set(64 * 22, F.G, (int)blockIdx.x, j, n); if (j >= 0) { F.refresh(); conv_tail(F, j, n, 32 * I_UP, TAIL_L1A); } }
            } else phase_convert_rest(F, gc); } SEAM(pb + 0); }
        if (IN(pb + 1)) { REPEAT(pb + 1) { F.refresh(); phase_mix(F, l); } SEAM(pb + 1); }
        if (IN(pb + 2)) { REPEAT(pb + 2) { F.refresh();
            BranchOrder S{(const char*)WSP(bf16_t, WS_Y), (const char*)(WSP(bf16_t, WS_WBR) + (size_t)l * 3 * D * 512), F.G, (int)blockIdx.x};
            EpiBranch E{WSP(bf16_t, WS_ZP), kin(16) + (size_t)l * 3 * D, WSP(bf16_t, WS_MG)};
            pg8::gemm_phase(F.lds, 512, YW, 512, S, E); } SEAM(pb + 2); }
        if (IN(pb + 3)) { F.refresh();
            DenseOrder S{(const char*)WSP(bf16_t, WS_MG), (const char*)(WSP(bf16_t, WS_WOUT) + (size_t)l * D * D), 64, 4, F.G, (int)blockIdx.x, (size_t)256 * D * 2, (size_t)256 * D * 2, 0};
            EpiRes E{X0, X1, rs0 + T};
            pg8::gemm_phase(F.lds, D, D, D, S, E); SEAM(pb + 3); }
        if (IN(pb + 4)) { F.refresh(); phase_router(F, l, X1, rs0 + T); SEAM(pb + 4); }
        if (IN(pb + 5)) { REPEAT(pb + 5) { F.refresh();
            moe_tables(F, l);
            LAS int* tab = (LAS int*)(F.lds + LDS_TAB); const int ntile = tab[MT_NTILE]; const int* TOKL = WSP(int, WS_TOKL);
            { int tk[5]; bool ok[5];
#pragma unroll
              for (int i = 0; i < 5; ++i) { const int q = F.tid + 512 * i, ui = q >> 8, r = q & 255, L = ui * F.G + F.vcu; const bool in = (q < MAX_UNITS_PER_WG * 256) && (L < ntile * 8);
                  const int tile = in ? (L >> 3) : 0, e = tab[MT_TE + tile], lr = (tile - tab[MT_TSTART + e]) * 256 + r; ok[i] = in && lr < tab[MT_CNT + e];
                  tk[i] = TOKL[e * T + (ok[i] ? lr : 0)]; }
#pragma unroll
              for (int i = 0; i < 5; ++i) { const int q = F.tid + 512 * i; if (q < MAX_UNITS_PER_WG * 256) ((LAS unsigned*)tab)[MT_TOKOFF + q] = ok[i] ? (unsigned)tk[i] * (unsigned)(D * 2) : 0u; } }
            __syncthreads();
            MoeOrder S{(const char*)X1, (const char*)(WSP(bf16_t, WS_WUP) + (size_t)l * NE * 2048 * D), tab + MT_TE, ntile * 8, 8, F.G, F.vcu, (size_t)2048 * D * 2, (size_t)256 * D * 2, 0, ntile * 8, 1};
            EpiUp E{WSP(bf16_t, WS_ACT), (const float*)(sw + SW_BUP), rs0 + T, (const LAS unsigned*)tab + MT_TOKOFF};
            pg8::gemm_phase<EpiUp, MoeOrder, true>(F.lds, D, D, D, S, E, (const LAS unsigned*)tab + MT_TOKOFF);
            { int j, n; idle_set(ntile * 8, F.G, F.vcu, j, n); F.refresh();
              DenseOrder S6{(const char*)(WSP(bf16_t, WS_PB) + (size_t)l * T * PLE), (const char*)(WSP(bf16_t, WS_WPP) + (size_t)l * D * PLE), 64, 4, n, j < 0 ? 256 : j, (size_t)256 * PLE * 2, (size_t)256 * PLE * 2, 0};
              EpiBf E6{WSP(bf16_t, WS_PP), nullptr, nullptr, 0};
              pg8::gemm_phase(F.lds, PLE, PLE, PLE, S6, E6);
              if (l == 0 && TAIL_XF4 > 0 && j >= 0) { F.refresh(); conv_tail(F, j, n, TAIL_XF, TAIL_XF4); }
              if (l == 1 && TAIL_L1B > 0 && j >= 0) { F.refresh(); conv_tail(F, j, n, 32 * I_UP + TAIL_L1A, TAIL_L1B); } } } SEAM(pb + 5); }
        if (IN(pb + 6)) { REPEAT(pb + 6) { F.refresh();
            moe_tables(F, l, SPLITK_TAIL && l == NL - 1);
            LAS int* tab = (LAS int*)(F.lds + LDS_TAB); const int ntile = tab[MT_NTILE];
            MoeOrder S{(const char*)WSP(bf16_t, WS_ACT), (const char*)(WSP(bf16_t, WS_WDN) + (size_t)l * NE * D * D), tab + MT_TE, ntile * 4, 4, F.G, F.vcu, (size_t)D * D * 2, (size_t)256 * D * 2, (size_t)256 * D * 2, tab[MT_NFULL], tab[MT_SPLIT]};
            EpiBf E{WSP(bf16_t, WS_YE), kin(24) + (size_t)l * NE * D, WSP(bf16_t, WS_YEX), tab[MT_TAILROW]};
            pg8::gemm_phase(F.lds, D, D, D, S, E);
            if (l == 0 && TAIL_XF > 0) { int j, n; idle_set(ntile * 4, F.G, F.vcu, j, n); if (j >= 0) { F.refresh(); conv_tail(F, j, n, 0, TAIL_XF); } } } SEAM(pb + 6); }
        if (IN(pb + 7)) { REPEAT(pb + 7) { F.refresh(); phase_combine(F, l, X1, X2, rs0 + 2 * T); } SEAM(pb + 7); }
        if (IN(pb + 8)) { F.refresh();
            DenseOrder S{(const char*)X2, (const char*)(WSP(bf16_t, WS_WPG) + (size_t)l * D * D), 64, 4, F.G, (int)blockIdx.x, (size_t)256 * D * 2, (size_t)256 * D * 2, 0};
            EpiPle E{X2, X0, WSP(bf16_t, WS_PP), rs0 + 2 * T, rs0 + 3 * T};
            pg8::gemm_phase(F.lds, D, D, D, S, E); SEAM(pb + 8); }
    }
    if (IN(N_PHASES - 1)) { F.refresh(); phase_final(F, X0, WSP(rs_t, WS_RS) + (size_t)(3 * NL) * T, F.out, kin(28)); }
#undef REPEAT
#undef IN
#undef SEAM
}

extern "C" void kernel_launch(void* const* d_in, const int* in_sizes, int n_in, void* d_out, int out_size, void* d_ws, size_t ws_size, hipStream_t stream) {
    static int grid = 0;
    if (grid == 0) {
        if (n_in != 29 || out_size != T * D || ws_size < WS_END) { fprintf(stderr, "kernel_launch: unexpected shapes (n_in %d out %d ws %zu)\n", n_in, out_size, ws_size); grid = -1; return; }
        int dev = 0, cus = 0, per_cu = 0;
        hipGetDevice(&dev); hipDeviceGetAttribute(&cus, hipDeviceAttributeMultiprocessorCount, dev);
        if (hipFuncSetAttribute((const void*)mega_fwd, hipFuncAttributeMaxDynamicSharedMemorySize, LDS_BYTES) != hipSuccess) { fprintf(stderr, "kernel_launch: hipFuncSetAttribute failed\n"); grid = -1; return; }
        if (hipOccupancyMaxActiveBlocksPerMultiprocessor(&per_cu, (const void*)mega_fwd, 512, LDS_BYTES) != hipSuccess || per_cu < 1) { fprintf(stderr, "kernel_launch: occupancy query says %d\n", per_cu); per_cu = 1; }
        (void)hipGetLastError();
        grid = cus;
    }
    if (grid < 0) return;
    hipMemsetAsync((char*)d_ws + WS_CTL, 0, CTL_ZERO_BYTES, stream);
    Args a{};
    for (int i = 0; i < 29; ++i) a.in[i] = (const float*)d_in[i];
    a.out = (float*)d_out; a.ws = (unsigned char*)d_ws;
#if MK_N_LAUNCHES == 1
    a.ph_lo = 0; a.ph_hi = N_PHASES; a.use_cg = 0;
    void* kargs[] = {&a};
    hipError_t e = hipLaunchCooperativeKernel((const void*)mega_fwd, dim3(grid), dim3(512), kargs, LDS_BYTES, stream);
    if (e != hipSuccess) fprintf(stderr, "cooperative launch failed: %s (grid %d)\n", hipGetErrorString(e), grid);
#else
    for (int ph = 0; ph < N_PHASES; ++ph) { a.ph_lo = ph; a.ph_hi = ph + 1; a.use_cg = 0;
        hipLaunchKernelGGL(mega_fwd, dim3(grid), dim3(512), LDS_BYTES, stream, a); }
#endif
}
```

```cpp
#include <hip/hip_runtime.h>
#include <hip/hip_cooperative_groups.h>
#include <cstdio>
#include <cstdint>
namespace cg = cooperative_groups;

#ifndef MK_N_LAUNCHES
#define MK_N_LAUNCHES 1
#endif

#define LAS __attribute__((address_space(3)))
#define GAS __attribute__((address_space(1)))
typedef unsigned short bf16_t;
typedef short bf16x8 __attribute__((ext_vector_type(8)));
typedef float f32x4 __attribute__((ext_vector_type(4)));
typedef float f32x16 __attribute__((ext_vector_type(16)));
typedef float f32x2 __attribute__((ext_vector_type(2)));
typedef unsigned u32x4 __attribute__((ext_vector_type(4)));
typedef unsigned u32x2 __attribute__((ext_vector_type(2)));

#ifndef SPLITK_TAIL
#define SPLITK_TAIL 1
#endif
constexpr int T = 16384, D = 1024, SEQ = 8192, NL = 2;
constexpr int NZ = 5632;
constexpr int ZPW = 5120;
constexpr int ZP_ZA = 0, ZP_GLU = 512, ZP_ZU = 1024, ZP_ZV = 1536, ZP_G = 2048;
constexpr int YW = 1536;
constexpr int NE = 32, TOPK = 4, PLE = 256, CONVK = 31;
constexpr int MAXTILES = 288, MAXROWS = MAXTILES * 256;
constexpr float EPS = 1e-6f;

constexpr size_t MiB = 1u << 20;
constexpr size_t WS_CTL = 0;
constexpr size_t WS_META = 1 * MiB;
constexpr size_t WS_TOPE = 2 * MiB;
constexpr size_t WS_TOPW = 3 * MiB;
constexpr size_t WS_SLOTOF = 4 * MiB;
constexpr size_t WS_SMALLW = 5 * MiB;
constexpr size_t SW_LAYER = 1 * MiB, SW_WPT = 0, SW_WSGU = 128 * 1024, SW_WRT = 256 * 1024, SW_BIN = 384 * 1024, SW_BUP = 512 * 1024;
constexpr size_t WS_WIN = 8 * MiB;
constexpr size_t WS_WBR = 32 * MiB;
constexpr size_t WS_WOUT = 40 * MiB;
constexpr size_t WS_WPG = 44 * MiB;
constexpr size_t WS_WPP = 48 * MiB;
constexpr size_t WS_PB = 50 * MiB;
constexpr size_t WS_WUP = 72 * MiB;
constexpr size_t WS_WDN = 328 * MiB;
constexpr size_t WS_XN = 456 * MiB;
constexpr size_t WS_ZP = 488 * MiB;
constexpr size_t WS_Y = 648 * MiB;
constexpr size_t WS_MG = 696 * MiB;
constexpr size_t WS_XG = 728 * MiB;
constexpr size_t WS_ACT = 872 * MiB;
constexpr size_t WS_YE = 1016 * MiB;
constexpr size_t WS_PP = 1160 * MiB;
constexpr size_t WS_YEX = 1192 * MiB;
constexpr size_t WS_END = 1288 * MiB;
constexpr size_t CTL_ZERO_BYTES = 32768;
constexpr int CW_BAR = 4096;
constexpr int CW_GCNT = 128;
constexpr size_t WS_TOKL = WS_XG;
constexpr size_t WS_X0 = WS_XN, WS_X1 = WS_XG + 16 * MiB, WS_X2 = WS_XG + 48 * MiB;
constexpr size_t WS_RS = WS_TOPE;

constexpr int RING_BYTES = 131072;
constexpr int LDS_TAB = RING_BYTES;
constexpr int LDS_BYTES = 147456;
constexpr int LDS_MISC = LDS_BYTES - 256;
constexpr int MT_CNT = 0, MT_TSTART = 32, MT_NTILE = 96, MT_SPLIT = 97, MT_TAILROW = 98, MT_NFULL = 99, MT_TE = 128, MT_TOKOFF = 512, MAX_UNITS_PER_WG = 9;
constexpr int YEX_ROWS = 16384;

__device__ __forceinline__ unsigned f2bf(float f) { unsigned u = __builtin_bit_cast(unsigned, f); return (u + 0x7fffu + ((u >> 16) & 1u)) >> 16; }
__device__ __forceinline__ unsigned pk2(float lo, float hi) { unsigned r; asm("v_cvt_pk_bf16_f32 %0, %1, %2" : "=v"(r) : "v"(lo), "v"(hi)); return r; }
__device__ __forceinline__ float bflo(unsigned u) { return __builtin_bit_cast(float, u << 16); }
__device__ __forceinline__ float bfhi(unsigned u) { return __builtin_bit_cast(float, u & 0xffff0000u); }
typedef unsigned long long rs_t;
__device__ __forceinline__ rs_t rs_fix(float ss) { return (rs_t)(ss * 1048576.0f + 0.5f); }
__device__ __forceinline__ float rstd_of(rs_t q) { return __builtin_amdgcn_rsqf((float)q * (1.0f / (1048576.0f * 1024.0f)) + 1e-6f); }
__device__ __forceinline__ float sigmoidf_(float v) { return __builtin_amdgcn_rcpf(1.0f + __builtin_amdgcn_exp2f(-1.44269504089f * v)); }
__device__ __forceinline__ float sig_t(float t) { return __builtin_amdgcn_rcpf(1.0f + __builtin_amdgcn_exp2f(t)); }
__device__ __forceinline__ float wave_sum(float v) {
#pragma unroll
    for (int o = 1; o < 64; o <<= 1) v += __shfl_xor(v, o);
    return v;
}
#ifndef WT_STORES
#define WT_STORES 0
#endif
__device__ __forceinline__ void st16(void* p, u32x4 v) {
#if WT_STORES
    asm volatile("global_store_dwordx4 %0, %1, off sc1\n\ts_nop 1" :: "v"(p), "v"(v) : "memory");
#else
    *(u32x4*)p = v;
#endif
}
#define LDS_WAIT() asm volatile("s_waitcnt lgkmcnt(0)" ::: "memory")
#define VM_WAIT() asm volatile("s_waitcnt vmcnt(0)" ::: "memory")

namespace pg8 {
constexpr int BM = 256, BK = 64, HALF = 128, HTB = HALF * BK * 2, NXCD = 8, WGM = 8;
__host__ __device__ __forceinline__ int lds_byte(int r, int c) { const int st = (r >> 4) * 2 + (c >> 5), rr = r & 15, cc = c & 31, ob = rr * 64 + cc * 2; return st * 1024 + (ob ^ (((ob >> 9) & 1) << 5)); }
__host__ __device__ __forceinline__ void stage_rc(int b, int& R, int& C) { const int st = b / 1024, sb = b % 1024, swz = sb ^ (((sb >> 9) & 1) << 5); R = (st >> 1) * 16 + swz / 64; C = (st & 1) * 32 + (swz % 64) / 2; }
__host__ __device__ __forceinline__ int perm32(int rho) { const int n = rho >> 4, i = rho & 15; return 8 * (i >> 2) + 4 * n + (i & 3); }

struct Unit { const char* A; const char* B; int pm, pn, aux, ord, nt; };

__device__ __forceinline__ void static_tile(int L, int nM, int nN, int& pm, int& pn) {
    const int nwg = nM * nN; int wgid = L;
    { const int q = nwg / NXCD, r = nwg % NXCD, xcd = wgid % NXCD, off = wgid / NXCD; wgid = (xcd < r ? xcd * (q + 1) : r * (q + 1) + (xcd - r) * q) + off; }
    const int nig = WGM * nN, gid = wgid / nig, fm = gid * WGM, gsz = (nM - fm) < WGM ? (nM - fm) : WGM;
    pm = fm + ((wgid % nig) % gsz); pn = (wgid % nig) / gsz;
}

template <class Epi, class Sched, bool GATHER = false>
__device__ __forceinline__ void gemm_phase(LAS unsigned char* lds, const int K_, const int lda, const int ldb, const Sched& S, const Epi& E, const LAS unsigned* gtab = nullptr) {
    int K = K_; asm volatile("" : "+s"(K));
    int tid_ = threadIdx.x; asm volatile("" : "+v"(tid_));
    const int tid = tid_, wid = __builtin_amdgcn_readfirstlane(tid >> 6), lane = tid & 63, wr = wid >> 2, wc = wid & 3, fr = lane & 15, fq = lane >> 4;
    const int nt0 = K / BK;
    unsigned voffA[2], voffB[2], gR[2], gC[2], vC[2][2], vN[2][2], vs[2][2];
#pragma unroll
    for (int i = 0; i < 2; ++i) { int R, C; stage_rc(tid * 16 + i * 8192, R, C); const int Rb = Epi::PERM ? ((R & ~31) + perm32(R & 31)) : R;
        voffA[i] = (unsigned)(R * lda + C) * 2u; voffB[i] = (unsigned)(Rb * ldb + C) * 2u; gR[i] = (unsigned)R; gC[i] = (unsigned)C * 2u; }
#define PG8_GLOAD(dst, u) do { _Pragma("unroll") for (int _h = 0; _h < 2; ++_h) _Pragma("unroll") for (int _i = 0; _i < 2; ++_i) dst[_h][_i] = gtab[(u) * 256 + _h * 128 + gR[_i]] + gC[_i]; } while (0)
#define PG8_STAGE_A(bufoff, h, gbase, VO) do { if constexpr (GATHER) { PG8_STAGE(bufoff, gbase, VO[h]); } else { PG8_STAGE(bufoff, (gbase) + (h) * hstepA, voffA); } } while (0)
    const size_t kstep = (size_t)(BK * 2);
    const size_t hstepA = (size_t)HALF * lda * 2, hstepB = (size_t)HALF * ldb * 2;
    const unsigned ldsw = (unsigned)wid * 1024u;
    const int aoff = lds_byte(wr * 64 + fr, fq * 8), boff = lds_byte(wc * 32 + fr, fq * 8);
#define PG8_SA(b, h) (((b) * 2 + (h)) * HTB)
#define PG8_SB(b, h) ((4 + (b) * 2 + (h)) * HTB)
#define PG8_STAGE(bufoff, gbase, voff) do { _Pragma("unroll") for (int _i = 0; _i < 2; ++_i) \
        __builtin_amdgcn_global_load_lds((const unsigned*)((const char*)(gbase) + (voff)[_i]), (LAS unsigned*)(lds + (bufoff) + ldsw + _i * 8192), 16, 0, 0); } while (0)
#define PG8_LDA(dst, b, h) do { _Pragma("unroll") for (int m = 0; m < 4; ++m) _Pragma("unroll") for (int k = 0; k < 2; ++k) dst[m][k] = *(const LAS bf16x8*)(lds + PG8_SA(b, h) + aoff + m * 2048 + k * 1024); } while (0)
#define PG8_LDB(dst, b, h) do { _Pragma("unroll") for (int n = 0; n < 2; ++n) _Pragma("unroll") for (int k = 0; k < 2; ++k) dst[n][k] = *(const LAS bf16x8*)(lds + PG8_SB(b, h) + boff + n * 2048 + k * 1024); } while (0)
#define PG8_MMA(ai, bj, At, Bt) do { __builtin_amdgcn_s_setprio(1); _Pragma("unroll") for (int m = 0; m < 4; ++m) _Pragma("unroll") for (int n = 0; n < 2; ++n) _Pragma("unroll") for (int k = 0; k < 2; ++k) \
        acc[ai][bj][m][n] = __builtin_amdgcn_mfma_f32_16x16x32_bf16(Bt[n][k], At[m][k], acc[ai][bj][m][n], 0, 0, 0); __builtin_amdgcn_s_setprio(0); } while (0)
#define PG8_WAIT_V(n) asm volatile("s_waitcnt vmcnt(" #n ")" ::: "memory")
#define PG8_WAIT_L(n) asm volatile("s_waitcnt lgkmcnt(" #n ")" ::: "memory")
#define PG8_BAR __builtin_amdgcn_s_barrier()
#define PG8_SCHED __builtin_amdgcn_sched_barrier(0)
    Unit cur, nxt; int ui = 0;
    if (!S.next(0, cur)) return;
    f32x4 acc[2][2][4][2];
#pragma unroll
    for (int a = 0; a < 2; ++a)
#pragma unroll
        for (int b = 0; b < 2; ++b)
#pragma unroll
            for (int m = 0; m < 4; ++m)
#pragma unroll
                for (int n = 0; n < 2; ++n) acc[a][b][m][n] = (f32x4){0.f, 0.f, 0.f, 0.f};
    bf16x8 At[4][2], B0[2][2], B1[2][2];
    const char* cA = cur.A; const char* cB = cur.B;
    if constexpr (GATHER) PG8_GLOAD(vC, 0);
    PG8_STAGE(PG8_SB(0, 0), cB, voffB); PG8_STAGE(PG8_SB(0, 1), cB + hstepB, voffB); PG8_STAGE_A(PG8_SA(0, 0), 0, cA, vC); PG8_STAGE_A(PG8_SA(0, 1), 1, cA, vC);
    if (wr == 1) PG8_BAR;
    PG8_WAIT_V(2); PG8_BAR;
    PG8_STAGE(PG8_SB(1, 0), cB + kstep, voffB); PG8_STAGE_A(PG8_SA(1, 0), 0, cA + kstep, vC); PG8_STAGE(PG8_SB(1, 1), cB + hstepB + kstep, voffB);
    PG8_WAIT_V(6); PG8_BAR;
    for (;;) {
        const bool has_next = S.next(ui + 1, nxt);
        const char* nA = has_next ? nxt.A : cA; const char* nB = has_next ? nxt.B : cB;
        if constexpr (GATHER) { if (has_next) PG8_GLOAD(vN, ui + 1); else {
#pragma unroll
            for (int _h = 0; _h < 2; ++_h)
#pragma unroll
                for (int _i = 0; _i < 2; ++_i) vN[_h][_i] = vC[_h][_i]; } }
        const int nt = cur.nt > 0 ? cur.nt : nt0;
        for (int t = 0; t < nt; t += 2) {
            const bool last = (t == nt - 2);
            if constexpr (GATHER) {
#pragma unroll
                for (int _h = 0; _h < 2; ++_h)
#pragma unroll
                    for (int _i = 0; _i < 2; ++_i) vs[_h][_i] = last ? vN[_h][_i] : vC[_h][_i]; }
            const char* a1 = cA + (size_t)(t + 1) * kstep;
            const char* a2 = last ? nA : cA + (size_t)(t + 2) * kstep; const char* b2 = last ? nB : cB + (size_t)(t + 2) * kstep;
            const char* a3 = a2 + kstep; const char* b3 = b2 + kstep;
            PG8_LDB(B0, 0, 0); PG8_LDB(B1, 0, 1); PG8_SCHED; PG8_LDA(At, 0, 0); PG8_STAGE_A(PG8_SA(1, 1), 1, a1, vC);
            PG8_WAIT_V(8); PG8_WAIT_L(0); PG8_BAR; PG8_MMA(0, 0, At, B0); PG8_MMA(0, 1, At, B1); PG8_BAR; PG8_SCHED;
            PG8_LDA(At, 0, 1); PG8_STAGE(PG8_SB(0, 0), b2, voffB); PG8_STAGE(PG8_SB(0, 1), b2 + hstepB, voffB); PG8_STAGE_A(PG8_SA(0, 0), 0, a2, vs);
            PG8_WAIT_V(8); PG8_WAIT_L(0); PG8_BAR; PG8_MMA(1, 0, At, B0); PG8_MMA(1, 1, At, B1); PG8_BAR; PG8_SCHED;
            PG8_LDB(B0, 1, 0); PG8_LDB(B1, 1, 1); PG8_SCHED; PG8_LDA(At, 1, 0); PG8_STAGE_A(PG8_SA(0, 1), 1, a2, vs);
            PG8_WAIT_V(8); PG8_WAIT_L(0); PG8_BAR; PG8_MMA(0, 0, At, B0); PG8_MMA(0, 1, At, B1); PG8_BAR; PG8_SCHED;
            PG8_LDA(At, 1, 1); PG8_STAGE(PG8_SB(1, 0), b3, voffB); PG8_STAGE(PG8_SB(1, 1), b3 + hstepB, voffB); PG8_STAGE_A(PG8_SA(1, 0), 0, a3, vs);
            PG8_WAIT_V(8); PG8_WAIT_L(0); PG8_BAR; PG8_MMA(1, 0, At, B0); PG8_MMA(1, 1, At, B1); PG8_BAR; PG8_SCHED;
        }
        if (wr == 0) PG8_BAR;
        bool zero = true; if (cur.aux >= 0) { if constexpr (Epi::EDUP) { (void)E(acc, cur, wr, wc, fr, fq); asm volatile("" ::: "memory"); } zero = E(acc, cur, wr, wc, fr, fq); }
        if constexpr (Epi::DRAIN) __builtin_amdgcn_s_waitcnt(0x0F70);
        if (!has_next) break;
        if (zero) {
#pragma unroll
            for (int a = 0; a < 2; ++a)
#pragma unroll
                for (int b = 0; b < 2; ++b)
#pragma unroll
                    for (int m = 0; m < 4; ++m)
#pragma unroll
                        for (int n = 0; n < 2; ++n) acc[a][b][m][n] = (f32x4){0.f, 0.f, 0.f, 0.f};
        }
        cur = nxt; cA = nA; cB = nB; ++ui;
        if constexpr (GATHER) {
#pragma unroll
            for (int _h = 0; _h < 2; ++_h)
#pragma unroll
                for (int _i = 0; _i < 2; ++_i) vC[_h][_i] = vN[_h][_i]; }
        if (wr == 1) PG8_BAR;
    }
    PG8_WAIT_V(0);
    PG8_BAR;
#undef PG8_SA
#undef PG8_SB
#undef PG8_STAGE
#undef PG8_STAGE_A
#undef PG8_GLOAD
#undef PG8_LDA
#undef PG8_LDB
#undef PG8_MMA
#undef PG8_WAIT_V
#undef PG8_WAIT_L
#undef PG8_BAR
#undef PG8_SCHED
}
}
using pg8::Unit;


struct DenseOrder {
    const char* A; const char* B; int nM, nN, G, c; size_t astep, bstep; int dup;
    __device__ __forceinline__ bool next(int i, Unit& u) const {
        const int L = (dup ? (i >> 1) : i) * G + c; if (L >= nM * nN) return false;
        int pm, pn; pg8::static_tile(L, nM, nN, pm, pn);
        u.pm = pm; u.pn = pn; u.ord = i; u.nt = 0; u.aux = (dup && !(i & 1)) ? -1 : 0; u.A = A + (size_t)pm * astep; u.B = B + (size_t)pn * bstep; return true;
    }
};
struct BranchOrder {
    const char* Y; const char* W; int G, c;
    __device__ __forceinline__ bool next(int i, Unit& u) const {
        const int tl = (i / 3) * G + c; if (tl >= 256) return false;
        int pm, pn; pg8::static_tile(tl, 64, 4, pm, pn); const int br = i % 3;
        u.pm = pm; u.pn = pn; u.ord = i; u.nt = 0; u.aux = br; u.A = Y + ((size_t)pm * 256 * YW + (size_t)br * 512) * 2; u.B = W + ((size_t)br * 1024 * 512 + (size_t)pn * 256 * 512) * 2; return true;
    }
};
struct MoeOrder {
    const char* A; const char* W; const LAS int* tile_e; int n_units, NP, G, c; size_t wstride, bstep, astep;
    int n_full, split;
    __device__ __forceinline__ bool next(int i, Unit& u) const {
        int L = i * G + c, q = 0, nq = 1;
        if (L >= n_full && split > 1) { const int j = L - n_full; L = n_full + j / split; q = j % split; nq = split; }
        if (L >= n_units) return false;
        const int tile = L / NP, pn = L - tile * NP; const int e = tile_e[tile];
        const size_t koff = (size_t)q * (1024 / nq) * 2;
        u.pm = tile; u.pn = pn; u.ord = i; u.aux = e | (q << 8); u.nt = 16 / nq; u.A = A + (size_t)tile * astep + koff; u.B = W + (size_t)e * wstride + (size_t)pn * bstep + koff; return true;
    }
};

typedef f32x4 Acc[2][2][4][2];
#ifndef EDUP_IN
#define EDUP_IN 0
#endif
#ifndef EDUP_UP
#define EDUP_UP 0
#endif
struct EpiIn {
    static constexpr bool PERM = true, DRAIN = false, EDUP = (EDUP_IN != 0);
    bf16_t* ZP; const float* bias; const rs_t* rs;
    __device__ __forceinline__ bool operator()(Acc& acc, const Unit& u, int wr, int wc, int fr, int fq) const {
        const int row0 = u.pm * 256 + wr * 64 + fr, pn = u.pn, cl = wc * 32 + 8 * fq;
        float rsv[2][4];
#pragma unroll
        for (int ai = 0; ai < 2; ++ai)
#pragma unroll
            for (int m = 0; m < 4; ++m) rsv[ai][m] = rstd_of(rs[row0 + ai * 128 + m * 16]);
        const float* bp = bias + pn * 256 + cl;
        f32x4 bv[2][2];
#pragma unroll
        for (int bj = 0; bj < 2; ++bj)
#pragma unroll
            for (int n = 0; n < 2; ++n) bv[bj][n] = *(const f32x4*)(bp + bj * 128 + 4 * n);
        constexpr float NL2E = -1.44269504089f;
        if (pn >= 2 && pn < 6) {
            bf16_t* base = ZP + ZP_GLU + (pn - 2) * 128 + cl;
            const f32x4 bg0 = bv[1][0] * NL2E, bg1 = bv[1][1] * NL2E;
#pragma unroll
            for (int ai = 0; ai < 2; ++ai)
#pragma unroll
                for (int m = 0; m < 4; ++m) { float o[8]; const float rc = rsv[ai][m] * NL2E;
#pragma unroll
                    for (int n = 0; n < 2; ++n) { const f32x4 a = acc[ai][0][m][n] * rsv[ai][m] + bv[0][n], t = acc[ai][1][m][n] * rc + (n ? bg1 : bg0);
#pragma unroll
                        for (int j = 0; j < 4; ++j) o[4 * n + j] = a[j] * __builtin_amdgcn_rcpf(1.0f + __builtin_amdgcn_exp2f(t[j])); }
                    u32x4 w; w.x = pk2(o[0], o[1]); w.y = pk2(o[2], o[3]); w.z = pk2(o[4], o[5]); w.w = pk2(o[6], o[7]);
                    st16(base + (size_t)(row0 + ai * 128 + m * 16) * ZPW, w); }
        } else if (pn >= 10) {
            bf16_t* base = ZP + (pn - 2) * 256 + cl;
            f32x4 bq[2][2];
#pragma unroll
            for (int bj = 0; bj < 2; ++bj)
#pragma unroll
                for (int n = 0; n < 2; ++n) bq[bj][n] = bv[bj][n] * NL2E;
#pragma unroll
            for (int ai = 0; ai < 2; ++ai)
#pragma unroll
                for (int m = 0; m < 4; ++m) { const float rc = rsv[ai][m] * NL2E;
#pragma unroll
                    for (int bj = 0; bj < 2; ++bj) { const f32x4 t0 = acc[ai][bj][m][0] * rc + bq[bj][0], t1 = acc[ai][bj][m][1] * rc + bq[bj][1]; f32x4 v0, v1;
#pragma unroll
                        for (int j = 0; j < 4; ++j) { v0[j] = __builtin_amdgcn_exp2f(t0[j]); v1[j] = __builtin_amdgcn_exp2f(t1[j]); }
                        v0 = v0 + 1.0f; v1 = v1 + 1.0f;
                        u32x4 w; w.x = pk2(v0[0], v0[1]); w.y = pk2(v0[2], v0[3]); w.z = pk2(v1[0], v1[1]); w.w = pk2(v1[2], v1[3]);
                        st16(base + (size_t)(row0 + ai * 128 + m * 16) * ZPW + bj * 128, w); } }
        } else {
            const int dc = (pn < 2 ? pn * 256 : (pn - 2) * 256 + 0) ;
            bf16_t* base = ZP + dc + cl;
#pragma unroll
            for (int ai = 0; ai < 2; ++ai)
#pragma unroll
                for (int m = 0; m < 4; ++m)
#pragma unroll
                    for (int bj = 0; bj < 2; ++bj) { const f32x4 v0 = acc[ai][bj][m][0] * rsv[ai][m] + bv[bj][0], v1 = acc[ai][bj][m][1] * rsv[ai][m] + bv[bj][1];
                        u32x4 w; w.x = pk2(v0[0], v0[1]); w.y = pk2(v0[2], v0[3]); w.z = pk2(v1[0], v1[1]); w.w = pk2(v1[2], v1[3]);
                        st16(base + (size_t)(row0 + ai * 128 + m * 16) * ZPW + bj * 128, w); }
        }
        return true;
    }
};
#ifndef GRND
#define GRND 3
#endif
struct EpiBranch {
    static constexpr bool PERM = true, DRAIN = false, EDUP = false;
    const bf16_t* ZP; const float* bb; bf16_t* MG;
    __device__ __forceinline__ bool operator()(Acc& acc, const Unit& u, int wr, int wc, int fr, int fq) const {
        const int row0 = u.pm * 256 + wr * 64 + fr, c0 = u.pn * 256 + wc * 32 + 8 * fq, br = u.aux;
        f32x4 bv[2][2];
#pragma unroll
        for (int bj = 0; bj < 2; ++bj)
#pragma unroll
            for (int n = 0; n < 2; ++n) bv[bj][n] = *(const f32x4*)(bb + br * 1024 + c0 + bj * 128 + 4 * n);
        const bf16_t* gp = ZP + ZP_G + br * 1024 + c0;
#pragma unroll
        for (int r0 = 0; r0 < 8; r0 += GRND) {
            u32x4 ga[GRND][2], gb[GRND][2];
#pragma unroll
            for (int rr = 0; rr < GRND; ++rr) if (r0 + rr < 8)
#pragma unroll
                for (int bj = 0; bj < 2; ++bj) { const size_t go = (size_t)(row0 + ((r0 + rr) >> 2) * 128 + ((r0 + rr) & 3) * 16) * ZPW + bj * 128;
                    ga[rr][bj] = *(const u32x4*)(gp + go); gb[rr][bj] = *(const u32x4*)(gp + (br < 2 ? 1024 : 0) + go); }
            __builtin_amdgcn_sched_barrier(0);
#pragma unroll
            for (int rr = 0; rr < GRND; ++rr) if (r0 + rr < 8) { const int ai = (r0 + rr) >> 2, m = (r0 + rr) & 3;
                const size_t ro = (size_t)(row0 + ai * 128 + m * 16);
#pragma unroll
                for (int bj = 0; bj < 2; ++bj) {
                    float f[8];
                    if (br < 2) {
#pragma unroll
                        for (int q = 0; q < 4; ++q) { f[2 * q] = fminf(bflo(gb[rr][bj][q]), 1e30f) * __builtin_amdgcn_rcpf(bflo(ga[rr][bj][q])); f[2 * q + 1] = fminf(bfhi(gb[rr][bj][q]), 1e30f) * __builtin_amdgcn_rcpf(bfhi(ga[rr][bj][q])); }
                    } else {
#pragma unroll
                        for (int q = 0; q < 4; ++q) { f[2 * q] = __builtin_amdgcn_rcpf(bflo(ga[rr][bj][q])); f[2 * q + 1] = __builtin_amdgcn_rcpf(bfhi(ga[rr][bj][q])); } }
#pragma unroll
                    for (int n = 0; n < 2; ++n)
#pragma unroll
                        for (int j = 0; j < 4; ++j) acc[ai][bj][m][n][j] = (acc[ai][bj][m][n][j] + bv[bj][n][j]) * f[4 * n + j];
                    if (br == 2) { const f32x4 v0 = acc[ai][bj][m][0], v1 = acc[ai][bj][m][1];
                        u32x4 w; w.x = pk2(v0[0], v0[1]); w.y = pk2(v0[2], v0[3]); w.z = pk2(v1[0], v1[1]); w.w = pk2(v1[2], v1[3]);
                        st16(MG + ro * D + c0 + bj * 128, w); }
                }
            }
            asm volatile("" ::: "memory");
        }
        return br == 2;
    }
};
struct EpiRes {
    static constexpr bool PERM = true, DRAIN = false, EDUP = false;
    const bf16_t* xin; bf16_t* xout; rs_t* rsout;
    __device__ __forceinline__ bool operator()(Acc& acc, const Unit& u, int wr, int wc, int fr, int fq) const {
        const int row0 = u.pm * 256 + wr * 64 + fr, c0 = u.pn * 256 + wc * 32 + 8 * fq;
#pragma unroll
        for (int ai = 0; ai < 2; ++ai) {
            u32x4 xv[4][2];
#pragma unroll
            for (int m = 0; m < 4; ++m)
#pragma unroll
                for (int bj = 0; bj < 2; ++bj) xv[m][bj] = *(const u32x4*)(xin + (size_t)(row0 + ai * 128 + m * 16) * D + c0 + bj * 128);
            __builtin_amdgcn_sched_barrier(0);
#pragma unroll
            for (int m = 0; m < 4; ++m) { const int r = row0 + ai * 128 + m * 16; float ss = 0.f;
#pragma unroll
                for (int bj = 0; bj < 2; ++bj) { const u32x4 x = xv[m][bj]; f32x4 v0 = acc[ai][bj][m][0], v1 = acc[ai][bj][m][1];
                    v0[0] += bflo(x.x); v0[1] += bfhi(x.x); v0[2] += bflo(x.y); v0[3] += bfhi(x.y); v1[0] += bflo(x.z); v1[1] += bfhi(x.z); v1[2] += bflo(x.w); v1[3] += bfhi(x.w);
                    ss += ((v0[0] * v0[0] + v0[1] * v0[1]) + (v0[2] * v0[2] + v0[3] * v0[3])) + ((v1[0] * v1[0] + v1[1] * v1[1]) + (v1[2] * v1[2] + v1[3] * v1[3]));
                    u32x4 w; w.x = pk2(v0[0], v0[1]); w.y = pk2(v0[2], v0[3]); w.z = pk2(v1[0], v1[1]); w.w = pk2(v1[2], v1[3]);
                    st16(xout + (size_t)r * D + c0 + bj * 128, w); }
                ss += __shfl_xor(ss, 16); ss += __shfl_xor(ss, 32);
                if (fq == 0) atomicAdd(rsout + r, rs_fix(ss)); }
            asm volatile("" ::: "memory"); }
        return true;
    }
};
struct EpiUp {
    static constexpr bool PERM = true, DRAIN = false, EDUP = (EDUP_UP != 0);
    bf16_t* ACT; const float* bup; const rs_t* rs; const LAS unsigned* tokoff;
    __device__ __forceinline__ bool operator()(Acc& acc, const Unit& u, int wr, int wc, int fr, int fq) const {
        const int row0 = u.pm * 256 + wr * 64 + fr, cl = wc * 32 + 8 * fq;
        float rsv[2][4];
#pragma unroll
        for (int ai = 0; ai < 2; ++ai)
#pragma unroll
            for (int m = 0; m < 4; ++m) rsv[ai][m] = rstd_of(rs[tokoff[u.ord * 256 + ai * 128 + wr * 64 + m * 16 + fr] >> 11]);
        const float* bp = bup + (u.aux & 255) * 2048 + u.pn * 256 + cl;
        f32x4 bg[2], bl[2];
#pragma unroll
        for (int n = 0; n < 2; ++n) { bg[n] = *(const f32x4*)(bp + 4 * n); bl[n] = *(const f32x4*)(bp + 128 + 4 * n); }
        bf16_t* base = ACT + u.pn * 128 + cl;
#pragma unroll
        for (int ai = 0; ai < 2; ++ai)
#pragma unroll
            for (int m = 0; m < 4; ++m) { unsigned o[4]; const f32x2 r2 = {rsv[ai][m], rsv[ai][m]};
#pragma unroll
                for (int n = 0; n < 2; ++n)
#pragma unroll
                    for (int h = 0; h < 2; ++h) {
                        const f32x2 a0 = {acc[ai][0][m][n][2 * h], acc[ai][0][m][n][2 * h + 1]}, a1 = {acc[ai][1][m][n][2 * h], acc[ai][1][m][n][2 * h + 1]};
                        const f32x2 b0 = {bg[n][2 * h], bg[n][2 * h + 1]}, b1 = {bl[n][2 * h], bl[n][2 * h + 1]};
                        f32x2 g = a0 * r2 + b0, l = a1 * r2 + b1;
                        g.x = fminf(g.x, 7.0f); g.y = fminf(g.y, 7.0f);
                        l.x = __builtin_amdgcn_fmed3f(l.x, -7.0f, 7.0f); l.y = __builtin_amdgcn_fmed3f(l.y, -7.0f, 7.0f);
                        const f32x2 t = g * (f32x2){-1.702f * 1.44269504089f, -1.702f * 1.44269504089f};
                        f32x2 d = {__builtin_amdgcn_exp2f(t.x), __builtin_amdgcn_exp2f(t.y)};
                        d = d + (f32x2){1.0f, 1.0f};
                        const f32x2 sg = {__builtin_amdgcn_rcpf(d.x), __builtin_amdgcn_rcpf(d.y)};
                        const f32x2 a = g * sg, ov = a * l + a;
                        o[2 * n + h] = pk2(ov.x, ov.y); }
                u32x4 w; w.x = o[0]; w.y = o[1]; w.z = o[2]; w.w = o[3];
                st16(base + (size_t)(row0 + ai * 128 + m * 16) * D, w); }
        return true;
    }
};
struct EpiBf {
    static constexpr bool PERM = true, DRAIN = false, EDUP = false;
    bf16_t* O; const float* bias; bf16_t* OX; int tail_row0;
    __device__ __forceinline__ bool operator()(Acc& acc, const Unit& u, int wr, int wc, int fr, int fq) const {
        const int row0 = u.pm * 256 + wr * 64 + fr, c0 = u.pn * 256 + wc * 32 + 8 * fq, e = u.aux & 255, q = (u.aux >> 8) & 3;
        f32x4 bv[2][2];
#pragma unroll
        for (int bj = 0; bj < 2; ++bj)
#pragma unroll
            for (int n = 0; n < 2; ++n) bv[bj][n] = (bias && q == 0) ? *(const f32x4*)(bias + e * 1024 + c0 + bj * 128 + 4 * n) : (f32x4){0.f, 0.f, 0.f, 0.f};
        bf16_t* ob = (q == 0) ? O + (size_t)row0 * D : OX + ((size_t)(q - 1) * YEX_ROWS + (size_t)(row0 - tail_row0)) * D;
#pragma unroll
        for (int ai = 0; ai < 2; ++ai)
#pragma unroll
            for (int m = 0; m < 4; ++m)
#pragma unroll
                for (int bj = 0; bj < 2; ++bj) { const f32x4 v0 = acc[ai][bj][m][0] + bv[bj][0], v1 = acc[ai][bj][m][1] + bv[bj][1];
                    u32x4 w; w.x = pk2(v0[0], v0[1]); w.y = pk2(v0[2], v0[3]); w.z = pk2(v1[0], v1[1]); w.w = pk2(v1[2], v1[3]);
                    st16(ob + (size_t)(ai * 128 + m * 16) * D + c0 + bj * 128, w); }
        return true;
    }
};
struct EpiPle {
    static constexpr bool PERM = true, DRAIN = false, EDUP = false;
    const bf16_t* xin; bf16_t* xout; const bf16_t* PP; const rs_t* rs; rs_t* rsout;
    __device__ __forceinline__ bool operator()(Acc& acc, const Unit& u, int wr, int wc, int fr, int fq) const {
        const int row0 = u.pm * 256 + wr * 64 + fr, c0 = u.pn * 256 + wc * 32 + 8 * fq;
#pragma unroll
        for (int am = 0; am < 4; ++am) { const int ai = am >> 1, m0 = (am & 1) * 2;
            u32x4 xv[2][2], pv[2][2]; float rsv[2];
#pragma unroll
            for (int mm = 0; mm < 2; ++mm) { const int r = row0 + ai * 128 + (m0 + mm) * 16; rsv[mm] = rstd_of(rs[r]) * -1.44269504089f;
#pragma unroll
                for (int bj = 0; bj < 2; ++bj) { xv[mm][bj] = *(const u32x4*)(xin + (size_t)r * D + c0 + bj * 128); pv[mm][bj] = *(const u32x4*)(PP + (size_t)r * D + c0 + bj * 128); } }
            __builtin_amdgcn_sched_barrier(0);
#pragma unroll
            for (int mm = 0; mm < 2; ++mm) { const int m = m0 + mm, r = row0 + ai * 128 + m * 16; float ss = 0.f;
#pragma unroll
                for (int bj = 0; bj < 2; ++bj) { const u32x4 x = xv[mm][bj], p = pv[mm][bj]; const f32x4 a0 = acc[ai][bj][m][0] * rsv[mm], a1 = acc[ai][bj][m][1] * rsv[mm]; float v[8];
                    v[0] = bflo(x.x) + sig_t(a0[0]) * bflo(p.x); v[1] = bfhi(x.x) + sig_t(a0[1]) * bfhi(p.x); v[2] = bflo(x.y) + sig_t(a0[2]) * bflo(p.y); v[3] = bfhi(x.y) + sig_t(a0[3]) * bfhi(p.y);
                    v[4] = bflo(x.z) + sig_t(a1[0]) * bflo(p.z); v[5] = bfhi(x.z) + sig_t(a1[1]) * bfhi(p.z); v[6] = bflo(x.w) + sig_t(a1[2]) * bflo(p.w); v[7] = bfhi(x.w) + sig_t(a1[3]) * bfhi(p.w);
                    ss += ((v[0] * v[0] + v[1] * v[1]) + (v[2] * v[2] + v[3] * v[3])) + ((v[4] * v[4] + v[5] * v[5]) + (v[6] * v[6] + v[7] * v[7]));
                    u32x4 w; w.x = pk2(v[0], v[1]); w.y = pk2(v[2], v[3]); w.z = pk2(v[4], v[5]); w.w = pk2(v[6], v[7]);
                    st16(xout + (size_t)r * D + c0 + bj * 128, w); }
                ss += __shfl_xor(ss, 16); ss += __shfl_xor(ss, 32);
                if (fq == 0) atomicAdd(rsout + r, rs_fix(ss)); }
            asm volatile("" ::: "memory"); }
        return true;
    }
};

#define XB_TMO      128
#define XB_XCNT(j)  (256  + 64 * (j))
#define XB_XSUB(j)  (1280 + 64 * (j))
#define XB_XGEN(j)  (2304 + 64 * (j))
#define XB_TOP      3328
#define XB_TOPGEN   3392
#define XCD_BAR_WORDS 3456
#define XB_SPIN_CAP (1u << 22)
__device__ __forceinline__ unsigned xb_ld(unsigned* p)              { return __hip_atomic_load(p, __ATOMIC_RELAXED, __HIP_MEMORY_SCOPE_AGENT); }
__device__ __forceinline__ unsigned xb_add(unsigned* p, unsigned v) { return __hip_atomic_fetch_add(p, v, __ATOMIC_RELAXED, __HIP_MEMORY_SCOPE_AGENT); }
__device__ __forceinline__ unsigned xb_xcc_id() { return (unsigned)__builtin_amdgcn_s_getreg((3 << 11) | 20) & 0xFu; }
#define XB_SPIN(cond, bar) do { unsigned _sp = 0; while (cond) { __builtin_amdgcn_s_sleep(1); \
    if ((++_sp & 255u) == 0u) { if (xb_ld(&(bar)[XB_TMO])) break; if (_sp > XB_SPIN_CAP) { atomicAdd(&(bar)[XB_TMO], 1u); break; } } } } while (0)
struct XcdBarrier { unsigned* bar; unsigned x; volatile LAS unsigned* st; };
__device__ __forceinline__ XcdBarrier xcd_barrier_post(unsigned* bar, volatile LAS unsigned* st) {
    XcdBarrier b; b.bar = bar; b.x = xb_xcc_id(); b.st = st;
    if (threadIdx.x == 0) (void)xb_add(&bar[XB_XCNT(b.x)], 1u);
    return b;
}
__device__ __forceinline__ void xcd_barrier_complete(unsigned* bar, unsigned x, unsigned& nloc, unsigned& nx) {
    const unsigned G = gridDim.x * gridDim.y * gridDim.z;
    unsigned sum, cnt, mine, sp = 0u;
    for (;;) {
        sum = 0u; cnt = 0u; mine = 0u;
#pragma unroll
        for (unsigned j = 0; j < 16; ++j) { const unsigned c = xb_ld(&bar[XB_XCNT(j)]); sum += c; cnt += (c > 0u) ? 1u : 0u; mine = (j == x) ? c : mine; }
        if (sum == G) break;
        __builtin_amdgcn_s_sleep(1);
        if ((++sp & 255u) == 0u) { if (xb_ld(&bar[XB_TMO])) break; if (sp > XB_SPIN_CAP) { atomicAdd(&bar[XB_TMO], 1u); break; } }
    }
    nloc = mine > 0u ? mine : 1u; nx = cnt > 0u ? cnt : 1u;
}
__device__ __forceinline__ void xcd_barrier(const XcdBarrier& b) {
    asm volatile("s_waitcnt vmcnt(0)" ::: "memory");
    __syncthreads();
    if (threadIdx.x == 0) {
        unsigned* bar = b.bar;
        __builtin_amdgcn_s_waitcnt(0);
        unsigned nloc = b.st[0], nx = b.st[1];
        if (nloc == 0u) { xcd_barrier_complete(bar, b.x, nloc, nx); b.st[0] = nloc; b.st[1] = nx; }
        const unsigned old = xb_add(&bar[XB_XSUB(b.x)], 1u);
        const unsigned gen = old / nloc;
        if (old + 1u == (gen + 1u) * nloc) {
            __builtin_amdgcn_fence(__ATOMIC_RELEASE, "agent");
            asm volatile("s_waitcnt vmcnt(0)" ::: "memory");
            const unsigned og = xb_add(&bar[XB_TOP], 1u);
            const unsigned tg = og / nx;
            if (og + 1u == (tg + 1u) * nx) xb_add(&bar[XB_TOPGEN], 1u);
            else XB_SPIN(xb_ld(&bar[XB_TOPGEN]) == tg, bar);
            __builtin_amdgcn_fence(__ATOMIC_ACQUIRE, "agent");
            xb_add(&bar[XB_XGEN(b.x)], 1u);
            asm volatile("s_waitcnt vmcnt(0)" ::: "memory");
        } else {
            XB_SPIN(xb_ld(&bar[XB_XGEN(b.x)]) == gen, bar);
            __builtin_amdgcn_fence(__ATOMIC_ACQUIRE, "agent");
            asm volatile("s_waitcnt vmcnt(0)" ::: "memory");
        }
    }
    __syncthreads();
}

struct Args { const float* in[29]; float* out; unsigned char* ws; int ph_lo, ph_hi, use_cg, pad; };
struct Frame {
    LAS unsigned char* lds; int tid, lane, wave, G, vcu;
    float* out; unsigned char* ws;
    __device__ __forceinline__ void refresh() { int t = threadIdx.x; asm volatile("" : "+v"(t)); tid = t; lane = t & 63; wave = __builtin_amdgcn_readfirstlane(t >> 6); }
};
__device__ __forceinline__ const float* kin(int i) {
    const char __attribute__((address_space(4)))* p = (const char __attribute__((address_space(4)))*)__builtin_amdgcn_kernarg_segment_ptr();
    asm volatile("" : "+s"(p));
    return *(const float* const __attribute__((address_space(4)))*)(p + 8 * i);
}
#define WSP(T_, off) ((T_*)(F.ws + (off)))

struct TrDesc { const float* W; bf16_t* WT; const float* scale; int N, dK, k0, n0, drow0; };
__device__ __forceinline__ void tr_load(const TrDesc& d, int lane, f32x4 (&v)[16], float (&sc)[16]) {
    const int kr = lane >> 4, nc = 4 * (lane & 15);
#pragma unroll
    for (int i = 0; i < 16; ++i) v[i] = __builtin_nontemporal_load((const f32x4*)(d.W + (size_t)(d.k0 + 4 * i + kr) * d.N + d.n0 + nc));
#pragma unroll
    for (int i = 0; i < 16; ++i) sc[i] = d.scale ? d.scale[d.k0 + 4 * i + kr] : 1.0f;
}
__device__ __forceinline__ void tr_store(const TrDesc& d, int lane, const f32x4 (&v)[16], const float (&sc)[16], LAS float* scr) {
    const int kr = lane >> 4, nc = 4 * (lane & 15);
#pragma unroll
    for (int i = 0; i < 16; ++i) { LAS float* s = scr + (4 * i + kr) * 65 + nc; s[0] = v[i][0] * sc[i]; s[1] = v[i][1] * sc[i]; s[2] = v[i][2] * sc[i]; s[3] = v[i][3] * sc[i]; }
    LDS_WAIT(); asm volatile("" ::: "memory");
    const int c = lane & 7;
#pragma unroll
    for (int it = 0; it < 8; ++it) { const int n = (lane >> 3) + 8 * it; const LAS float* s = scr + (8 * c) * 65 + n;
        u32x4 o; o.x = pk2(s[0 * 65], s[1 * 65]); o.y = pk2(s[2 * 65], s[3 * 65]); o.z = pk2(s[4 * 65], s[5 * 65]); o.w = pk2(s[6 * 65], s[7 * 65]);
        __builtin_nontemporal_store(o, (u32x4*)(d.WT + (size_t)(d.drow0 + n) * d.dK + d.k0 + 8 * c)); }
    LDS_WAIT(); asm volatile("" ::: "memory");
}
__device__ __forceinline__ int win_src(int np) { if (np >= 512 && np < 1536) { const int t = (np - 512) >> 8, i = (np - 512) & 255; return i < 128 ? 512 + 128 * t + i : 1024 + 128 * t + (i - 128); } return np; }
__device__ __forceinline__ int win_dst64(int n0) { if (n0 >= 512 && n0 < 1024) { const int c = n0 - 512; return 512 + 256 * (c >> 7) + (c & 127); } if (n0 >= 1024 && n0 < 1536) { const int c = n0 - 1024; return 512 + 256 * (c >> 7) + 128 + (c & 127); } return n0; }
__device__ __forceinline__ int up_src(int np) { const int t = np >> 8, i = np & 255; return i < 128 ? 128 * t + i : 1024 + 128 * t + (i - 128); }
__device__ __forceinline__ int up_dst64(int n0) { if (n0 < 1024) return 256 * (n0 >> 7) + (n0 & 127); const int c = n0 - 1024; return 256 * (c >> 7) + 128 + (c & 127); }

__device__ __forceinline__ void row_load(const float* xr, int lane, f32x4 (&v)[4]) {
#pragma unroll
    for (int j = 0; j < 4; ++j) v[j] = *(const f32x4*)(xr + 4 * lane + 256 * j);
}
__device__ __forceinline__ void row_store_bf16(bf16_t* o, int lane, const f32x4 (&v)[4], float sc) {
#pragma unroll
    for (int j = 0; j < 4; ++j) { u32x2 w; w.x = pk2(v[j][0] * sc, v[j][1] * sc); w.y = pk2(v[j][2] * sc, v[j][3] * sc); *(u32x2*)(o + 4 * lane + 256 * j) = w; }
}
__device__ __forceinline__ void row_load_bf(const bf16_t* xr, int lane, u32x2 (&p)[4]) {
#pragma unroll
    for (int j = 0; j < 4; ++j) p[j] = *(const u32x2*)(xr + 4 * lane + 256 * j);
}
__device__ __forceinline__ void row_unpack(const u32x2 (&p)[4], f32x4 (&v)[4]) {
#pragma unroll
    for (int j = 0; j < 4; ++j) { v[j][0] = bflo(p[j].x); v[j][1] = bfhi(p[j].x); v[j][2] = bflo(p[j].y); v[j][3] = bfhi(p[j].y); }
}
__device__ __forceinline__ float row_sumsq(const f32x4 (&v)[4]) {
    float s = 0.f;
#pragma unroll
    for (int j = 0; j < 4; ++j) s += (v[j][0] * v[j][0] + v[j][1] * v[j][1]) + (v[j][2] * v[j][2] + v[j][3] * v[j][3]);
    return wave_sum(s);
}
__device__ __forceinline__ void phase_final(Frame& F, const bf16_t* xb, const rs_t* rsf, float* out, const float* g) {
    const int gw = F.vcu * 8 + F.wave, NGW = F.G * 8;
    for (int m = gw; m < T; m += NGW) { u32x2 p[4]; f32x4 v[4]; row_load_bf(xb + (size_t)m * D, F.lane, p); row_unpack(p, v); const float rs = rstd_of(rsf[m]);
#pragma unroll
        for (int j = 0; j < 4; ++j) { const f32x4 gg = *(const f32x4*)(g + 4 * F.lane + 256 * j); *(f32x4*)(out + (size_t)m * D + 4 * F.lane + 256 * j) = v[j] * rs * gg; } }
}

#ifndef TAIL_XF
#define TAIL_XF 12288
#endif
#ifndef TAIL_L1A
#define TAIL_L1A 5120
#endif
#ifndef TAIL_L1B
#define TAIL_L1B 3072
#endif
#ifndef TAIL_XF4
#define TAIL_XF4 4096
#endif
constexpr int I_WIN = 16 * 88, I_BR = 8 * 16, I_SQ = 16 * 16, I_UP = 16 * 32, I_PP = 4 * 16, I_POOL = 4;
constexpr int CONV_PER_LAYER = I_WIN + 3 * I_BR + I_SQ + 32 * I_UP + 32 * I_SQ + I_SQ + I_PP + 4 * I_POOL, CONV_NEXP = 32 * I_UP + 32 * I_SQ;
__device__ __forceinline__ TrDesc conv_desc(Frame& F, int l, int r) {
    if (r < 32 * I_UP) { const int e = r / I_UP, q = r % I_UP, kb = q / 32, nb = q % 32;
        return TrDesc{kin(21) + ((size_t)l * NE + e) * D * 2048, WSP(bf16_t, WS_WUP) + ((size_t)l * NE + e) * 2048 * D, kin(18) + l * D, 2048, D, 64 * kb, 64 * nb, up_dst64(64 * nb)}; } r -= 32 * I_UP;
    if (r < 32 * I_SQ) { const int e = r / I_SQ, q = r % I_SQ, kb = q / 16, nb = q % 16;
        return TrDesc{kin(23) + ((size_t)l * NE + e) * D * D, WSP(bf16_t, WS_WDN) + ((size_t)l * NE + e) * D * D, nullptr, D, D, 64 * kb, 64 * nb, 64 * nb}; } r -= 32 * I_SQ;
    if (r < I_WIN) { const int kb = r / 88, nb = r % 88;
        return TrDesc{kin(3) + (size_t)l * D * NZ, WSP(bf16_t, WS_WIN) + (size_t)l * NZ * D, kin(2) + l * D, NZ, D, 64 * kb, 64 * nb, win_dst64(64 * nb)}; } r -= I_WIN;
    if (r < 3 * I_BR) { const int k = r / I_BR, q = r % I_BR, kb = q / 16, nb = q % 16;
        return TrDesc{kin(15) + ((size_t)l * 3 + k) * 512 * D, WSP(bf16_t, WS_WBR) + ((size_t)l * 3 + k) * D * 512, nullptr, D, 512, 64 * kb, 64 * nb, 64 * nb}; } r -= 3 * I_BR;
    if (r < I_SQ) { const int kb = r / 16, nb = r % 16;
        return TrDesc{kin(17) + (size_t)l * D * D, WSP(bf16_t, WS_WOUT) + (size_t)l * D * D, nullptr, D, D, 64 * kb, 64 * nb, 64 * nb}; } r -= I_SQ;
    if (r < I_SQ) { const int kb = r / 16, nb = r % 16;
        return TrDesc{kin(26) + (size_t)l * D * D, WSP(bf16_t, WS_WPG) + (size_t)l * D * D, kin(25) + l * D, D, D, 64 * kb, 64 * nb, 64 * nb}; } r -= I_SQ;
    if (r < I_PP) { const int kb = r / 16, nb = r % 16;
        return TrDesc{kin(27) + (size_t)l * PLE * D, WSP(bf16_t, WS_WPP) + (size_t)l * D * PLE, nullptr, D, PLE, 64 * kb, 64 * nb, 64 * nb}; } r -= I_PP;
    { const int g = r / I_POOL, q = r % I_POOL, kb = q / 2, nb = q % 2;
        return TrDesc{kin(5) + ((size_t)l * 4 + g) * 128 * 128, WSP(bf16_t, WS_SMALLW + l * SW_LAYER + SW_WPT) + (size_t)g * 128 * 128, nullptr, 128, 128, 64 * kb, 64 * nb, 64 * nb}; }
}
template <class Map> __device__ __forceinline__ void conv_stream(Frame& F, int first, int stride, int count, const Map& map) {
    LAS float* scr = (LAS float*)(F.lds + F.wave * 16640);
    if (first >= count) return;
    f32x4 va[16], vb[16]; float sa[16], sb[16];
    int l, r; map(first, l, r); TrDesc da = conv_desc(F, l, r), db = da;
    tr_load(da, F.lane, va, sa);
    for (int it = first; it < count; it += 2 * stride) {
        const bool hb = it + stride < count;
        if (hb) { map(it + stride, l, r); db = conv_desc(F, l, r); tr_load(db, F.lane, vb, sb); }
        tr_store(da, F.lane, va, sa, scr);
        const bool ha = it + 2 * stride < count;
        if (ha) { map(it + 2 * stride, l, r); da = conv_desc(F, l, r); tr_load(da, F.lane, va, sa); }
        if (hb) tr_store(db, F.lane, vb, sb, scr);
    }
}
__device__ __forceinline__ void phase_weights(Frame& F) {
    const int gw = F.vcu * 8 + F.wave, NGW = F.G * 8;
    conv_stream(F, gw, NGW, I_WIN, [](int it, int& l, int& r) { l = 0; r = CONV_NEXP + it; });
    const size_t gt = (size_t)F.vcu * 512 + F.tid, NGT = (size_t)F.G * 512;
    { const float* sguw = kin(13);
      for (size_t i = gt; i < (size_t)NL * 4 * 128 * 128; i += NGT) { const int l = (int)(i >> 16), r = (int)(i & 65535), t = (r >> 7) & 127, s = r & 127;
        WSP(bf16_t, WS_SMALLW + l * SW_LAYER + SW_WSGU)[r] = (bf16_t)f2bf(s <= t ? sguw[i] : 0.f); } }
    { const float* rw = kin(19); const float* mn = kin(18);
      for (size_t i = gt; i < (size_t)NL * NE * D; i += NGT) { const int l = (int)(i >> 15), r = (int)(i & 32767), e = r >> 10, k = r & 1023;
        const float w = rw[((size_t)l * D + k) * NE + e] * mn[l * D + k]; const unsigned hi = f2bf(w); const float wl = w - __builtin_bit_cast(float, hi << 16);
        WSP(bf16_t, WS_SMALLW + l * SW_LAYER + SW_WRT)[r] = (bf16_t)hi; WSP(bf16_t, WS_SMALLW + l * SW_LAYER + SW_WRT + 65536)[r] = (bf16_t)f2bf(wl); } }
    { const float* bi = kin(4);
      for (size_t i = gt; i < (size_t)NL * NZ; i += NGT) { const int l = (int)(i / NZ), np = (int)(i % NZ);
        WSP(float, WS_SMALLW + l * SW_LAYER + SW_BIN)[np] = bi[l * NZ + win_src(np)]; } }
    { const float* bu = kin(22);
      for (size_t i = gt; i < (size_t)NL * NE * 2048; i += NGT) { const int l = (int)(i >> 16), r = (int)(i & 65535), e = r >> 11, np = r & 2047;
        WSP(float, WS_SMALLW + l * SW_LAYER + SW_BUP)[r] = bu[((size_t)l * NE + e) * 2048 + up_src(np)]; } }
    { rs_t* rsz = WSP(rs_t, WS_RS) + T; for (size_t i = gt; i < (size_t)3 * NL * T; i += NGT) rsz[i] = 0ull; }
    { const float* x = kin(0); bf16_t* X0 = WSP(bf16_t, WS_X0); rs_t* rs0 = WSP(rs_t, WS_RS);
      for (int m = gw; m < T; m += NGW) { f32x4 v[4]; row_load(x + (size_t)m * D, F.lane, v); const float ss = row_sumsq(v); row_store_bf16(X0 + (size_t)m * D, F.lane, v, 1.0f); if (F.lane == 0) rs0[m] = rs_fix(ss); } }
}
__device__ __forceinline__ void phase_convert_rest(Frame& F, int nb0) {
    const int nb = F.G - nb0, gw = ((int)blockIdx.x - nb0) * 8 + F.wave, NGW = nb * 8;
    constexpr int L0REST = CONV_PER_LAYER - CONV_NEXP - I_WIN, L0ALL = L0REST + CONV_NEXP;
    conv_stream(F, gw, NGW, L0ALL + CONV_PER_LAYER - TAIL_XF - TAIL_XF4 - TAIL_L1A - TAIL_L1B, [](int it, int& l, int& r) { if (it < L0REST) { l = 0; r = CONV_NEXP + I_WIN + it; } else if (it < L0ALL) { l = 0; r = it - L0REST; } else { l = 1; r = it - L0ALL + TAIL_XF + TAIL_XF4; if (r >= 32 * I_UP) r += TAIL_L1A + TAIL_L1B; } });
    const size_t gt = (size_t)((int)blockIdx.x - nb0) * 512 + F.tid, NGT = (size_t)nb * 512;
    { const float* pp = kin(1);
      for (size_t i = gt; i < (size_t)NL * T * PLE / 4; i += NGT) { const f32x4 v = *(const f32x4*)(pp + 4 * i); u32x2 w; w.x = pk2(v[0], v[1]); w.y = pk2(v[2], v[3]); *(u32x2*)(WSP(bf16_t, WS_PB) + 4 * i) = w; } }
}
__device__ __forceinline__ void conv_tail(Frame& F, int j, int n, int first, int count) {
    conv_stream(F, j * 8 + F.wave, n * 8, count, [first](int it, int& l, int& r) { l = 1; r = first + it; });
}

__device__ __forceinline__ float reduce_scatter64(float (&v)[64], int lane) {
#pragma unroll
    for (int m = 32, n = 32; m >= 1; m >>= 1, n >>= 1) {
        const bool up = (lane & m) != 0; float rcv[32];
#pragma unroll
        for (int i = 0; i < n; ++i) { const float a = v[i], b = v[i + n]; const float send = up ? a : b; v[i] = up ? b : a; rcv[i] = __shfl_xor(send, m); }
        __builtin_amdgcn_sched_barrier(0);
#pragma unroll
        for (int i = 0; i < n; ++i) v[i] += rcv[i];
    }
    return v[0];
}
__device__ __forceinline__ float reduce_scatter32(float (&v)[32], int lane) {
#pragma unroll
    for (int m = 32, n = 16; m >= 2; m >>= 1, n >>= 1) {
        const bool up = (lane & m) != 0; float rcv[16];
#pragma unroll
        for (int i = 0; i < n; ++i) { const float a = v[i], b = v[i + n]; const float send = up ? a : b; v[i] = up ? b : a; rcv[i] = __shfl_xor(send, m); }
        __builtin_amdgcn_sched_barrier(0);
#pragma unroll
        for (int i = 0; i < n; ++i) v[i] += rcv[i];
    }
    return v[0] + __shfl_xor(v[0], 1);
}
__device__ __forceinline__ void conv_unit(Frame& F, int l, int u) {
    const int t0 = 64 * u, s0 = t0 & (SEQ - 1);
    const bf16_t* ZP = WSP(bf16_t, WS_ZP);
    LAS unsigned char* in = F.lds;
    {
        u32x4 cv[12];
#pragma unroll
        for (int q = 0; q < 12; ++q) { const int idx = F.tid + 512 * q, r = idx >> 6, c16 = idx & 63; const int pos = s0 - 30 + r, rr = pos >= 0 ? t0 - 30 + r : t0 - s0;
            cv[q] = (idx < 94 * 64) ? *(const u32x4*)(ZP + (size_t)rr * ZPW + ZP_GLU + 8 * c16) : (u32x4){0u, 0u, 0u, 0u}; }
        __builtin_amdgcn_sched_barrier(0);
#pragma unroll
        for (int q = 0; q < 12; ++q) { const int idx = F.tid + 512 * q, r = idx >> 6, c16 = idx & 63; const bool ok = (s0 - 30 + r >= 0);
            u32x4 v = cv[q]; v.x = ok ? v.x : 0u; v.y = ok ? v.y : 0u; v.z = ok ? v.z : 0u; v.w = ok ? v.w : 0u;
            if (idx < 94 * 64) *(LAS u32x4*)(in + r * 1024 + c16 * 16) = v; }
    }
    const int cp = F.tid & 255, half = F.tid >> 8;
    f32x2 w[CONVK]; const float* cwp = kin(7);
#pragma unroll
    for (int j = 0; j < CONVK; ++j) w[j] = *(const f32x2*)(cwp + ((size_t)l * CONVK + j) * 512 + 2 * cp);
    const f32x2 cb = *(const f32x2*)(kin(8) + l * 512 + 2 * cp);
    f32x2 acc[32];
#pragma unroll
    for (int o = 0; o < 32; ++o) acc[o] = cb;
    __syncthreads();
    const LAS unsigned char* ip = in + (32 * half) * 1024 + cp * 4;
    unsigned pvl[62];
#pragma unroll
    for (int rr = 0; rr < 62; ++rr) pvl[rr] = *(const LAS unsigned*)(ip + rr * 1024);
    __builtin_amdgcn_sched_barrier(0);
#pragma unroll
    for (int rr = 0; rr < 62; ++rr) { const unsigned pv = pvl[rr]; const f32x2 v = (f32x2){bflo(pv), bfhi(pv)};
#pragma unroll
        for (int o = (rr > 30 ? rr - 30 : 0); o <= (rr < 31 ? rr : 31); ++o) acc[o] = acc[o] + w[rr - o] * v; }
    float st[64];
#pragma unroll
    for (int o = 0; o < 32; ++o) { st[o] = acc[o].x + acc[o].y; st[32 + o] = acc[o].x * acc[o].x + acc[o].y * acc[o].y; }
    const float tot = reduce_scatter64(st, F.lane);
    LAS float* red = (LAS float*)(F.lds + LDS_TAB);
    red[F.wave * 64 + F.lane] = tot;
    __syncthreads();
    if (F.tid < 128) { const int h = F.tid >> 6, i = F.tid & 63; red[512 + F.tid] = (red[(4 * h) * 64 + i] + red[(4 * h + 1) * 64 + i]) + (red[(4 * h + 2) * 64 + i] + red[(4 * h + 3) * 64 + i]); }
    __syncthreads();
    const f32x2 ng = *(const f32x2*)(kin(9) + l * 512 + 2 * cp), nb = *(const f32x2*)(kin(10) + l * 512 + 2 * cp);
    bf16_t* Y = WSP(bf16_t, WS_Y) + (size_t)(t0 + 32 * half) * YW + 512 + 2 * cp;
#pragma unroll
    for (int o = 0; o < 32; ++o) { const float mean = red[512 + half * 64 + o] * (1.0f / 512.0f), var = red[512 + half * 64 + 32 + o] * (1.0f / 512.0f) - mean * mean; const float rs = 1.0f / sqrtf(fmaxf(var, 0.f) + EPS);
        float y0 = (acc[o].x - mean) * rs * ng.x + nb.x, y1 = (acc[o].y - mean) * rs * ng.y + nb.y; y0 = y0 * sigmoidf_(y0); y1 = y1 * sigmoidf_(y1);
        *(unsigned*)(Y + (size_t)o * YW) = pk2(y0, y1); }
    __syncthreads();
}
template <int W> __device__ __forceinline__ void pool_window(const f32x2 (&f)[47], const f32x2 (&pre)[48], int s_first, LAS unsigned char* pa) {
#pragma unroll
    for (int o = 0; o < 32; ++o) { const f32x2 s = pre[o + 16] - pre[o + 16 - W];
        const int pos = s_first + o; const float inv = 1.0f / (float)(pos + 1 < W ? pos + 1 : W);
        const f32x2 p = s * inv - f[o + 15];
        *(LAS unsigned*)(pa + o * 1040) = pk2(p.x, p.y); }
}
__device__ __forceinline__ void pool_unit(Frame& F, int l, int u) {
    const int t0 = 64 * u, s0 = t0 & (SEQ - 1);
    const bf16_t* ZP = WSP(bf16_t, WS_ZP);
    LAS unsigned char* pA = F.lds;
    const int cp = F.tid & 255, half = F.tid >> 8, first = t0 + 32 * half;
    f32x2 f[47]; unsigned pvr[47];
#pragma unroll
    for (int i = 0; i < 47; ++i) { const int pos = s0 + 32 * half - 15 + i; const int rr = pos >= 0 ? first - 15 + i : t0 - s0;
        pvr[i] = *(const unsigned*)(ZP + (size_t)rr * ZPW + ZP_ZA + 2 * cp); }
    __builtin_amdgcn_sched_barrier(0);
#pragma unroll
    for (int i = 0; i < 47; ++i) { const int pos = s0 + 32 * half - 15 + i; const unsigned pv = pos >= 0 ? pvr[i] : 0u; f[i] = (f32x2){bflo(pv), bfhi(pv)}; }
    LAS unsigned char* pa = pA + (32 * half) * 1040 + cp * 4;
    const int g = (F.wave & 3);
    f32x2 pre[48]; pre[0] = (f32x2){0.f, 0.f};
#pragma unroll
    for (int i = 0; i < 47; ++i) pre[i + 1] = pre[i] + f[i];
    if (g == 0) pool_window<2>(f, pre, s0 + 32 * half, pa); else if (g == 1) pool_window<4>(f, pre, s0 + 32 * half, pa); else if (g == 2) pool_window<8>(f, pre, s0 + 32 * half, pa); else pool_window<16>(f, pre, s0 + 32 * half, pa);
    __syncthreads();
    const int gg = F.wave >> 1, dh = F.wave & 1, r = F.lane & 31, h = F.lane >> 5;
    const bf16_t* WPT = WSP(bf16_t, WS_SMALLW + l * SW_LAYER + SW_WPT) + (size_t)gg * 128 * 128;
    f32x16 acc[2][2];
#pragma unroll
    for (int mi = 0; mi < 2; ++mi)
#pragma unroll
        for (int ni = 0; ni < 2; ++ni)
#pragma unroll
            for (int q = 0; q < 16; ++q) acc[mi][ni][q] = 0.f;
    bf16x8 bw[8][2];
#pragma unroll
    for (int s = 0; s < 8; ++s)
#pragma unroll
        for (int ni = 0; ni < 2; ++ni) bw[s][ni] = *(const bf16x8*)(WPT + (size_t)(64 * dh + 32 * ni + r) * 128 + 16 * s + 8 * h);
#pragma unroll
    for (int s = 0; s < 8; ++s) { bf16x8 a[2];
#pragma unroll
        for (int mi = 0; mi < 2; ++mi) a[mi] = *(const LAS bf16x8*)(pA + (32 * mi + r) * 1040 + (128 * gg + 16 * s + 8 * h) * 2);
#pragma unroll
        for (int mi = 0; mi < 2; ++mi)
#pragma unroll
            for (int ni = 0; ni < 2; ++ni) acc[mi][ni] = __builtin_amdgcn_mfma_f32_32x32x16_bf16(bw[s][ni], a[mi], acc[mi][ni], 0, 0, 0); }
    bf16_t* Y = WSP(bf16_t, WS_Y); const float* psc = kin(6);
#pragma unroll
    for (int ni = 0; ni < 2; ++ni)
#pragma unroll
        for (int g = 0; g < 4; ++g) { const int d = 128 * gg + 64 * dh + 32 * ni + 8 * g + 4 * h; const f32x4 sc = *(const f32x4*)(psc + l * 512 + d);
#pragma unroll
            for (int mi = 0; mi < 2; ++mi) { u32x2 o; o.x = pk2(acc[mi][ni][4 * g + 0] * sc[0], acc[mi][ni][4 * g + 1] * sc[1]); o.y = pk2(acc[mi][ni][4 * g + 2] * sc[2], acc[mi][ni][4 * g + 3] * sc[3]);
                *(u32x2*)(Y + (size_t)(t0 + 32 * mi + r) * YW + d) = o; } }
    __syncthreads();
}
__device__ __forceinline__ void sgu_unit(Frame& F, int l, int u) {
    const int chunk = u >> 1, hp = u & 1, t0 = 128 * chunk;
    const bf16_t* ZP = WSP(bf16_t, WS_ZP);
    LAS unsigned char* vT = F.lds;
    {
        const float* lng = kin(11) + l * 512 + 8 * F.lane; const float* lnb = kin(12) + l * 512 + 8 * F.lane;
        const f32x4 g0 = *(const f32x4*)lng, g1 = *(const f32x4*)(lng + 4);
        const f32x4 b0 = *(const f32x4*)lnb, b1 = *(const f32x4*)(lnb + 4);
        u32x4 pvv[16];
#pragma unroll
        for (int i = 0; i < 16; ++i) pvv[i] = *(const u32x4*)(ZP + (size_t)(t0 + 16 * F.wave + i) * ZPW + ZP_ZV + 8 * F.lane);
        float st[32];
#pragma unroll
        for (int i = 0; i < 16; ++i) { const u32x4 pv = pvv[i]; const float x0 = bflo(pv.x), x1 = bfhi(pv.x), x2 = bflo(pv.y), x3 = bfhi(pv.y), x4 = bflo(pv.z), x5 = bfhi(pv.z), x6 = bflo(pv.w), x7 = bfhi(pv.w);
            st[i] = ((x0 + x1) + (x2 + x3)) + ((x4 + x5) + (x6 + x7)); st[16 + i] = ((x0 * x0 + x1 * x1) + (x2 * x2 + x3 * x3)) + ((x4 * x4 + x5 * x5) + (x6 * x6 + x7 * x7)); }
        const float tot = reduce_scatter32(st, F.lane);
        LAS float* wst = (LAS float*)(F.lds + LDS_TAB) + 32 * F.wave;
        if ((F.lane & 1) == 0) wst[F.lane >> 1] = tot;
        LDS_WAIT(); asm volatile("" ::: "memory");
        if ((F.lane >> 5) == hp) { const int cl = 8 * (F.lane & 31);
            float mu[16], rsd[16];
#pragma unroll
            for (int i = 0; i < 16; ++i) { const float mean = wst[i] * (1.0f / 512.0f), var = wst[16 + i] * (1.0f / 512.0f) - mean * mean; mu[i] = mean; rsd[i] = 1.0f / sqrtf(fmaxf(var, 0.f) + EPS); }
#pragma unroll
            for (int j = 0; j < 8; ++j) { const float gg = j < 4 ? g0[j & 3] : g1[j & 3], bb = j < 4 ? b0[j & 3] : b1[j & 3]; unsigned w[8];
#pragma unroll
                for (int i2 = 0; i2 < 8; ++i2) { const unsigned pa = pvv[2 * i2][j >> 1], pb = pvv[2 * i2 + 1][j >> 1];
                    const float xa = (j & 1) ? bfhi(pa) : bflo(pa), xb = (j & 1) ? bfhi(pb) : bflo(pb);
                    w[i2] = pk2((xa - mu[2 * i2]) * rsd[2 * i2] * gg + bb, (xb - mu[2 * i2 + 1]) * rsd[2 * i2 + 1] * gg + bb); }
                LAS unsigned char* dst = vT + (cl + j) * 272 + (16 * F.wave) * 2;
                *(LAS u32x4*)dst = (u32x4){w[0], w[1], w[2], w[3]}; *(LAS u32x4*)(dst + 16) = (u32x4){w[4], w[5], w[6], w[7]}; }
        }
    }
    const int hl = F.wave >> 2, ti = F.wave & 3, hh = 2 * hp + hl, r = F.lane & 31, h = F.lane >> 5;
    const bf16_t* WS_ = WSP(bf16_t, WS_SMALLW + l * SW_LAYER + SW_WSGU) + (size_t)hh * 128 * 128;
    bf16x8 af[8];
#pragma unroll
    for (int k = 0; k < 8; ++k) if (k < 2 * (ti + 1)) af[k] = *(const bf16x8*)(WS_ + (size_t)(32 * ti + r) * 128 + 16 * k + 8 * h);
    __syncthreads();
    f32x16 acc[4];
#pragma unroll
    for (int ci = 0; ci < 4; ++ci)
#pragma unroll
        for (int q = 0; q < 16; ++q) acc[ci][q] = 0.f;
#pragma unroll
    for (int k = 0; k < 8; ++k) if (k < 2 * (ti + 1)) {
#pragma unroll
        for (int ci = 0; ci < 4; ++ci) { const bf16x8 b = *(const LAS bf16x8*)(vT + (128 * hl + 32 * ci + r) * 272 + (16 * k + 8 * h) * 2);
            acc[ci] = __builtin_amdgcn_mfma_f32_32x32x16_bf16(b, af[k], acc[ci], 0, 0, 0); }
    }
    bf16_t* Y = WSP(bf16_t, WS_Y);
    { const int tl = 32 * ti + r; const float sb = kin(14)[((size_t)l * 4 + hh) * 128 + tl];
      const bf16_t* zr = ZP + (size_t)(t0 + tl) * ZPW + ZP_ZU + 128 * hh + 4 * h; bf16_t* yr = Y + (size_t)(t0 + tl) * YW + 1024 + 128 * hh + 4 * h;
      u32x2 zu[4][4];
#pragma unroll
      for (int ci = 0; ci < 4; ++ci)
#pragma unroll
          for (int g = 0; g < 4; ++g) zu[ci][g] = *(const u32x2*)(zr + 32 * ci + 8 * g);
#pragma unroll
      for (int ci = 0; ci < 4; ++ci)
#pragma unroll
          for (int g = 0; g < 4; ++g) { const u32x2 z = zu[ci][g]; u32x2 o;
              o.x = pk2(bflo(z.x) * (acc[ci][4 * g + 0] + sb), bfhi(z.x) * (acc[ci][4 * g + 1] + sb)); o.y = pk2(bflo(z.y) * (acc[ci][4 * g + 2] + sb), bfhi(z.y) * (acc[ci][4 * g + 3] + sb));
              *(u32x2*)(yr + 32 * ci + 8 * g) = o; } }
    __syncthreads();
}
#ifndef MIX_DUP
#define MIX_DUP 0
#endif
__device__ __forceinline__ void phase_mix(Frame& F, int l) {
    for (int rep = 0; rep < ((MIX_DUP & 1) ? 2 : 1); ++rep) for (int u = F.vcu; u < 256; u += F.G) sgu_unit(F, l, u);
    for (int rep = 0; rep < ((MIX_DUP & 2) ? 2 : 1); ++rep) for (int u = F.vcu; u < 256; u += F.G) conv_unit(F, l, u);
    for (int rep = 0; rep < ((MIX_DUP & 4) ? 2 : 1); ++rep) for (int u = F.vcu; u < 256; u += F.G) pool_unit(F, l, u);
}

__device__ __forceinline__ void phase_router(Frame& F, int l, const bf16_t* x, const rs_t* rs) {
    LAS float* P = (LAS float*)F.lds;
    LAS int* hist = (LAS int*)(F.lds + LDS_TAB);
    const bf16_t* WH = WSP(bf16_t, WS_SMALLW + l * SW_LAYER + SW_WRT); const bf16_t* WL = WH + 32768;
    float* TW = WSP(float, WS_TOPW); int* TOKL = WSP(int, WS_TOKL); int* SO = WSP(int, WS_SLOTOF);
    unsigned* gcnt = (unsigned*)(F.ws + WS_CTL) + CW_GCNT + 32 * l;
    const float* rbias = kin(20) + l * NE;
    if (F.tid < 32) hist[F.tid] = 0;
    const int rb = F.wave & 1, kq = F.wave >> 1, r = F.lane & 31, h = F.lane >> 5;
    for (int blk = F.vcu; blk < 256; blk += F.G) {
        const bf16_t* xr = x + (size_t)(64 * blk + 32 * rb + r) * D + 256 * kq + 8 * h;
        const bf16_t* whp = WH + (size_t)r * D + 256 * kq + 8 * h; const bf16_t* wlp = WL + (size_t)r * D + 256 * kq + 8 * h;
        bf16x8 xa[16];
#pragma unroll
        for (int s2 = 0; s2 < 16; ++s2) xa[s2] = *(const bf16x8*)(xr + 16 * s2);
        f32x16 acc;
#pragma unroll
        for (int q = 0; q < 16; ++q) acc[q] = 0.f;
#pragma unroll
        for (int sb = 0; sb < 4; ++sb) { bf16x8 ha[4], la[4];
#pragma unroll
            for (int s2 = 0; s2 < 4; ++s2) { ha[s2] = *(const bf16x8*)(whp + 16 * (4 * sb + s2)); la[s2] = *(const bf16x8*)(wlp + 16 * (4 * sb + s2)); }
#pragma unroll
            for (int s2 = 0; s2 < 4; ++s2) { acc = __builtin_amdgcn_mfma_f32_32x32x16_bf16(xa[4 * sb + s2], ha[s2], acc, 0, 0, 0); acc = __builtin_amdgcn_mfma_f32_32x32x16_bf16(xa[4 * sb + s2], la[s2], acc, 0, 0, 0); } }
#pragma unroll
        for (int q = 0; q < 16; ++q) P[(kq * 64 + 32 * rb + (q & 3) + 8 * (q >> 2) + 4 * h) * 33 + r] = acc[q];
        __syncthreads();
        if (F.lane < 8) {
            const int rl = 8 * F.wave + F.lane, row = 64 * blk + rl; const float rstd = rstd_of(rs[row]);
            float v0 = -3.0e38f, v1 = -3.0e38f, v2 = -3.0e38f, v3 = -3.0e38f; int i0 = 0, i1 = 0, i2 = 0, i3 = 0;
#pragma unroll
            for (int e = 0; e < 32; ++e) { const float v = ((P[(0 * 64 + rl) * 33 + e] + P[(1 * 64 + rl) * 33 + e]) + (P[(2 * 64 + rl) * 33 + e] + P[(3 * 64 + rl) * 33 + e])) * rstd + rbias[e];
                const bool c0 = v > v0, c1 = v > v1, c2 = v > v2, c3 = v > v3;
                v3 = c2 ? v2 : (c3 ? v : v3); i3 = c2 ? i2 : (c3 ? e : i3);
                v2 = c1 ? v1 : (c2 ? v : v2); i2 = c1 ? i1 : (c2 ? e : i2);
                v1 = c0 ? v0 : (c1 ? v : v1); i1 = c0 ? i0 : (c1 ? e : i1);
                v0 = c0 ? v : v0;             i0 = c0 ? e : i0; }
            const f32x4 tw = (f32x4){1.0f, __expf(v1 - v0), __expf(v2 - v0), __expf(v3 - v0)};
            *(f32x4*)(TW + row * 4) = tw;
            const int ie[4] = {i0, i1, i2, i3};
#pragma unroll
            for (int k = 0; k < 4; ++k) { const int rk = __hip_atomic_fetch_add((int*)(hist + ie[k]), 1, __ATOMIC_RELAXED, __HIP_MEMORY_SCOPE_WORKGROUP);
                hist[64 + rl * 4 + k] = ie[k] | (rk << 8); }
        }
        __syncthreads();
        if (F.tid < 32) { hist[32 + F.tid] = (int)__hip_atomic_fetch_add(gcnt + F.tid, (unsigned)hist[F.tid], __ATOMIC_RELAXED, __HIP_MEMORY_SCOPE_AGENT); hist[F.tid] = 0; }
        __syncthreads();
        if (F.tid < 256) { const int pk = hist[64 + F.tid], e = pk & 255, pos = hist[32 + e] + (pk >> 8), tok = 64 * blk + (F.tid >> 2);
            TOKL[e * T + pos] = tok; SO[tok * 4 + (F.tid & 3)] = e | (pos << 5); }
        __syncthreads();
    }
}
__device__ __forceinline__ void moe_tables(Frame& F, int l, bool split_tail = false) {
    LAS int* tab = (LAS int*)(F.lds + LDS_TAB);
    const unsigned* gcnt = (const unsigned*)(F.ws + WS_CTL) + CW_GCNT + 32 * l;
    if (F.tid < 64) { const int e = F.lane & 31; const int c = (int)gcnt[e]; const int pt = (c + 255) >> 8; int incl = pt;
#pragma unroll
        for (int o = 1; o < 32; o <<= 1) { const int v = __shfl_up(incl, o, 32); if (e >= o) incl += v; }
        if (F.lane < 32) { tab[MT_CNT + e] = c; tab[MT_TSTART + e] = incl - pt;
            if (e == 31) { tab[MT_NTILE] = incl;
                const int nu = incl * 4, nf = (nu / F.G) * F.G, rem = nu - nf; const int sp = (!split_tail || rem == 0) ? 1 : (rem * 4 <= F.G ? 4 : (rem * 2 <= F.G ? 2 : 1));
                tab[MT_SPLIT] = sp; tab[MT_NFULL] = nf; tab[MT_TAILROW] = (nf / 4) * 256; } } }
    __syncthreads();
    if (F.tid <= MAXTILES) { int e = 0;
#pragma unroll
        for (int q = 0; q < 31; ++q) e += (int)(((unsigned)(F.tid - tab[MT_TSTART + q + 1])) >> 31) ^ 1;
        tab[MT_TE + F.tid] = e; }
    __syncthreads();
}
__device__ __forceinline__ void phase_combine(Frame& F, int l, const bf16_t* xin, bf16_t* xout, rs_t* rsout) {
    moe_tables(F, l, SPLITK_TAIL && l == NL - 1);
    const int gw = F.vcu * 8 + F.wave, NGW = F.G * 8;
    const int* SO = WSP(int, WS_SLOTOF); const float* TW = WSP(float, WS_TOPW); const bf16_t* YE = WSP(bf16_t, WS_YE);
    const LAS int* tab = (const LAS int*)(F.lds + LDS_TAB); const int sp = tab[MT_SPLIT], trow = tab[MT_TAILROW]; const bf16_t* YEX = WSP(bf16_t, WS_YEX);
    for (int m = gw; m < T; m += NGW) {
        u32x2 p[4]; f32x4 v[4]; row_load_bf(xin + (size_t)m * D, F.lane, p);
        const f32x4 tw = *(const f32x4*)(TW + m * 4); const float twi = 1.0f / ((tw[0] + tw[1]) + (tw[2] + tw[3]));
        u32x2 y[4][4]; int slots[4];
#pragma unroll
        for (int k = 0; k < 4; ++k) { const int pk = SO[m * 4 + k]; slots[k] = tab[MT_TSTART + (pk & 31)] * 256 + (pk >> 5); row_load_bf(YE + (size_t)slots[k] * D, F.lane, y[k]); }
        row_unpack(p, v);
        if (sp > 1) {
#pragma unroll
            for (int k = 0; k < 4; ++k) if (slots[k] >= trow) { const float w = tw[k] * twi;
                for (int q = 1; q < sp; ++q) { u32x2 z[4]; row_load_bf(YEX + ((size_t)(q - 1) * YEX_ROWS + (size_t)(slots[k] - trow)) * D, F.lane, z);
#pragma unroll
                    for (int j = 0; j < 4; ++j) { v[j][0] += w * bflo(z[j].x); v[j][1] += w * bfhi(z[j].x); v[j][2] += w * bflo(z[j].y); v[j][3] += w * bfhi(z[j].y); } } } }
#pragma unroll
        for (int k = 0; k < 4; ++k) { const float w = tw[k] * twi;
#pragma unroll
            for (int j = 0; j < 4; ++j) { v[j][0] += w * bflo(y[k][j].x); v[j][1] += w * bfhi(y[k][j].x); v[j][2] += w * bflo(y[k][j].y); v[j][3] += w * bfhi(y[k][j].y); } }
        const float ss = row_sumsq(v); row_store_bf16(xout + (size_t)m * D, F.lane, v, 1.0f); if (F.lane == 0) rsout[m] = rs_fix(ss);
    }
}

__device__ __forceinline__ void idle_set(int n_units, int G, int c, int& j, int& n) {
    const int rem = n_units % G; if (rem == 0 || G - rem < 32) { j = c; n = G; } else { j = c - rem; n = G - rem; }
}
constexpr int PH_PER_LAYER = 9, N_PHASES = 1 + NL * PH_PER_LAYER + 1;
__global__ void __launch_bounds__(512, 2) mega_fwd(Args args) {
    extern __shared__ __attribute__((aligned(16))) unsigned char lds_raw[];
    Frame F;
    F.lds = (LAS unsigned char*)lds_raw; F.tid = threadIdx.x; F.lane = F.tid & 63; F.wave = __builtin_amdgcn_readfirstlane(F.tid >> 6);
    F.G = gridDim.x; { const int bx = blockIdx.x; F.vcu = (F.G % 8 == 0) ? (bx % 8) * (F.G / 8) + bx / 8 : bx; }
    F.out = args.out; F.ws = args.ws;
    volatile LAS unsigned* MISC = (volatile LAS unsigned*)(F.lds + LDS_MISC);
    if (F.tid < 64) MISC[F.tid] = 0u;
    __syncthreads();
    XcdBarrier bar; bar.bar = (unsigned*)(F.ws + WS_CTL) + CW_BAR; bar.x = 0; bar.st = nullptr;
    const int lo = args.ph_lo, hi = args.ph_hi;
    if (hi - lo > 1 && !args.use_cg) bar = xcd_barrier_post((unsigned*)(F.ws + WS_CTL) + CW_BAR, MISC + 8);
#ifndef BAR_DUP
#define BAR_DUP 0
#endif
#define SEAM(ph) do { if ((ph) + 1 < hi) { if (args.use_cg) cg::this_grid().sync(); else { xcd_barrier(bar); if (BAR_DUP) xcd_barrier(bar); } } } while (0)
#ifndef PH_MASK
#define PH_MASK 0xffff
#endif
#define PHT(k) ((k) == 0 ? 11 : (k) == N_PHASES - 1 ? 12 : ((k) - 1) % PH_PER_LAYER)
#define IN(k) (((PH_MASK >> PHT(k)) & 1) && lo <= (k) && (k) < hi)
#ifndef KDUP_MASK
#define KDUP_MASK 0
#endif
#ifndef SPLIT_GC
#define SPLIT_GC 160
#endif
#ifndef DUP_MASK
#define DUP_MASK 0
#endif
#define REPEAT(k) for (int rep_ = 0, nrep_ = (((DUP_MASK >> PHT(k)) & 1) ? 2 : 1); rep_ < nrep_; ++rep_, (rep_ < nrep_ ? xcd_barrier(bar) : (void)0))
    if (IN(0)) { REPEAT(0) { F.refresh(); phase_weights(F); } SEAM(0); }
    bf16_t* const X0 = WSP(bf16_t, WS_X0); bf16_t* const X1 = WSP(bf16_t, WS_X1); bf16_t* const X2 = WSP(bf16_t, WS_X2);
    for (int l = 0; l < NL; ++l) {
        const int pb = 1 + l * PH_PER_LAYER;
        const unsigned char* sw = F.ws + WS_SMALLW + l * SW_LAYER;
        rs_t* const rs0 = WSP(rs_t, WS_RS) + (size_t)(3 * l) * T;
        if (IN(pb + 0)) { REPEAT(pb + 0) { F.refresh();
            const int gc = (l == 0 && F.G > SPLIT_GC) ? SPLIT_GC : F.G;
            if ((int)blockIdx.x < gc) {
                DenseOrder S{(const char*)X0, (const char*)(WSP(bf16_t, WS_WIN) + (size_t)l * NZ * D), 64, 22, gc, (int)blockIdx.x, (size_t)256 * D * 2, (size_t)256 * D * 2, (KDUP_MASK >> 0) & 1};
                EpiIn E{WSP(bf16_t, WS_ZP), (const float*)(sw + SW_BIN), rs0};
                pg8::gemm_phase(F.lds, D, D, D, S, E);
                if (l == 0 && gc == F.G) { F.refresh(); phase_convert_rest(F, 0); }
                if (l == 1 && TAIL_L1A > 0) { int j, n; idle_set(64 * 22, F.G, (int)blockIdx.x, j, n); if (j >= 0) { F.refresh(); conv_tail(F, j, n, 32 * I_UP, TAIL_L1A); } }
            } else phase_convert_rest(F, gc); } SEAM(pb + 0); }
        if (IN(pb + 1)) { REPEAT(pb + 1) { F.refresh(); phase_mix(F, l); } SEAM(pb + 1); }
        if (IN(pb + 2)) { REPEAT(pb + 2) { F.refresh();
            BranchOrder S{(const char*)WSP(bf16_t, WS_Y), (const char*)(WSP(bf16_t, WS_WBR) + (size_t)l * 3 * D * 512), F.G, (int)blockIdx.x};
            EpiBranch E{WSP(bf16_t, WS_ZP), kin(16) + (size_t)l * 3 * D, WSP(bf16_t, WS_MG)};
            pg8::gemm_phase(F.lds, 512, YW, 512, S, E); } SEAM(pb + 2); }
        if (IN(pb + 3)) { F.refresh();
            DenseOrder S{(const char*)WSP(bf16_t, WS_MG), (const char*)(WSP(bf16_t, WS_WOUT) + (size_t)l * D * D), 64, 4, F.G, (int)blockIdx.x, (size_t)256 * D * 2, (size_t)256 * D * 2, 0};
            EpiRes E{X0, X1, rs0 + T};
            pg8::gemm_phase(F.lds, D, D, D, S, E); SEAM(pb + 3); }
        if (IN(pb + 4)) { F.refresh(); phase_router(F, l, X1, rs0 + T); SEAM(pb + 4); }
        if (IN(pb + 5)) { REPEAT(pb + 5) { F.refresh();
            moe_tables(F, l);
            LAS int* tab = (LAS int*)(F.lds + LDS_TAB); const int ntile = tab[MT_NTILE]; const int* TOKL = WSP(int, WS_TOKL);
            { int tk[5]; bool ok[5];
#pragma unroll
              for (int i = 0; i < 5; ++i) { const int q = F.tid + 512 * i, ui = q >> 8, r = q & 255, L = ui * F.G + F.vcu; const bool in = (q < MAX_UNITS_PER_WG * 256) && (L < ntile * 8);
                  const int tile = in ? (L >> 3) : 0, e = tab[MT_TE + tile], lr = (tile - tab[MT_TSTART + e]) * 256 + r; ok[i] = in && lr < tab[MT_CNT + e];
                  tk[i] = TOKL[e * T + (ok[i] ? lr : 0)]; }
#pragma unroll
              for (int i = 0; i < 5; ++i) { const int q = F.tid + 512 * i; if (q < MAX_UNITS_PER_WG * 256) ((LAS unsigned*)tab)[MT_TOKOFF + q] = ok[i] ? (unsigned)tk[i] * (unsigned)(D * 2) : 0u; } }
            __syncthreads();
            MoeOrder S{(const char*)X1, (const char*)(WSP(bf16_t, WS_WUP) + (size_t)l * NE * 2048 * D), tab + MT_TE, ntile * 8, 8, F.G, F.vcu, (size_t)2048 * D * 2, (size_t)256 * D * 2, 0, ntile * 8, 1};
            EpiUp E{WSP(bf16_t, WS_ACT), (const float*)(sw + SW_BUP), rs0 + T, (const LAS unsigned*)tab + MT_TOKOFF};
            pg8::gemm_phase<EpiUp, MoeOrder, true>(F.lds, D, D, D, S, E, (const LAS unsigned*)tab + MT_TOKOFF);
            { int j, n; idle_set(ntile * 8, F.G, F.vcu, j, n); F.refresh();
              DenseOrder S6{(const char*)(WSP(bf16_t, WS_PB) + (size_t)l * T * PLE), (const char*)(WSP(bf16_t, WS_WPP) + (size_t)l * D * PLE), 64, 4, n, j < 0 ? 256 : j, (size_t)256 * PLE * 2, (size_t)256 * PLE * 2, 0};
              EpiBf E6{WSP(bf16_t, WS_PP), nullptr, nullptr, 0};
              pg8::gemm_phase(F.lds, PLE, PLE, PLE, S6, E6);
              if (l == 0 && TAIL_XF4 > 0 && j >= 0) { F.refresh(); conv_tail(F, j, n, TAIL_XF, TAIL_XF4); }
              if (l == 1 && TAIL_L1B > 0 && j >= 0) { F.refresh(); conv_tail(F, j, n, 32 * I_UP + TAIL_L1A, TAIL_L1B); } } } SEAM(pb + 5); }
        if (IN(pb + 6)) { REPEAT(pb + 6) { F.refresh();
            moe_tables(F, l, SPLITK_TAIL && l == NL - 1);
            LAS int* tab = (LAS int*)(F.lds + LDS_TAB); const int ntile = tab[MT_NTILE];
            MoeOrder S{(const char*)WSP(bf16_t, WS_ACT), (const char*)(WSP(bf16_t, WS_WDN) + (size_t)l * NE * D * D), tab + MT_TE, ntile * 4, 4, F.G, F.vcu, (size_t)D * D * 2, (size_t)256 * D * 2, (size_t)256 * D * 2, tab[MT_NFULL], tab[MT_SPLIT]};
            EpiBf E{WSP(bf16_t, WS_YE), kin(24) + (size_t)l * NE * D, WSP(bf16_t, WS_YEX), tab[MT_TAILROW]};
            pg8::gemm_phase(F.lds, D, D, D, S, E);
            if (l == 0 && TAIL_XF > 0) { int j, n; idle_set(ntile * 4, F.G, F.vcu, j, n); if (j >= 0) { F.refresh(); conv_tail(F, j, n, 0, TAIL_XF); } } } SEAM(pb + 6); }
        if (IN(pb + 7)) { REPEAT(pb + 7) { F.refresh(); phase_combine(F, l, X1, X2, rs0 + 2 * T); } SEAM(pb + 7); }
        if (IN(pb + 8)) { F.refresh();
            DenseOrder S{(const char*)X2, (const char*)(WSP(bf16_t, WS_WPG) + (size_t)l * D * D), 64, 4, F.G, (int)blockIdx.x, (size_t)256 * D * 2, (size_t)256 * D * 2, 0};
            EpiPle E{X2, X0, WSP(bf16_t, WS_PP), rs0 + 2 * T, rs0 + 3 * T};
            pg8::gemm_phase(F.lds, D, D, D, S, E); SEAM(pb + 8); }
    }
    if (IN(N_PHASES - 1)) { F.refresh(); phase_final(F, X0, WSP(rs_t, WS_RS) + (size_t)(3 * NL) * T, F.out, kin(28)); }
#undef REPEAT
#undef IN
#undef SEAM
}

extern "C" void kernel_launch(void* const* d_in, const int* in_sizes, int n_in, void* d_out, int out_size, void* d_ws, size_t ws_size, hipStream_t stream) {
    static int grid = 0;
    if (grid == 0) {
        if (n_in != 29 || out_size != T * D || ws_size < WS_END) { fprintf(stderr, "kernel_launch: unexpected shapes (n_in %d out %d ws %zu)\n", n_in, out_size, ws_size); grid = -1; return; }
        int dev = 0, cus = 0, per_cu = 0;
        hipGetDevice(&dev); hipDeviceGetAttribute(&cus, hipDeviceAttributeMultiprocessorCount, dev);
        if (hipFuncSetAttribute((const void*)mega_fwd, hipFuncAttributeMaxDynamicSharedMemorySize, LDS_BYTES) != hipSuccess) { fprintf(stderr, "kernel_launch: hipFuncSetAttribute failed\n"); grid = -1; return; }
        if (hipOccupancyMaxActiveBlocksPerMultiprocessor(&per_cu, (const void*)mega_fwd, 512, LDS_BYTES) != hipSuccess || per_cu < 1) { fprintf(stderr, "kernel_launch: occupancy query says %d\n", per_cu); per_cu = 1; }
        (void)hipGetLastError();
        grid = cus;
    }
    if (grid < 0) return;
    hipMemsetAsync((char*)d_ws + WS_CTL, 0, CTL_ZERO_BYTES, stream);
    Args a{};
    for (int i = 0; i < 29; ++i) a.in[i] = (const float*)d_in[i];
    a.out = (float*)d_out; a.ws = (unsigned char*)d_ws;
#if MK_N_LAUNCHES == 1
    a.ph_lo = 0; a.ph_hi = N_PHASES; a.use_cg = 0;
    void* kargs[] = {&a};
    hipError_t e = hipLaunchCooperativeKernel((const void*)mega_fwd, dim3(grid), dim3(512), kargs, LDS_BYTES, stream);
    if (e != hipSuccess) fprintf(stderr, "cooperative launch failed: %s (grid %d)\n", hipGetErrorString(e), grid);
#else
    for (int ph = 0; ph < N_PHASES; ++ph) { a.ph_lo = ph; a.ph_hi = ph + 1; a.use_cg = 0;
        hipLaunchKernelGGL(mega_fwd, dim3(grid), dim3(512), LDS_BYTES, stream, a); }
#endif
}
```

```cpp
#include <hip/hip_runtime.h>
#include <hip/hip_cooperative_groups.h>
#include <cstdio>
#include <cstdint>
namespace cg = cooperative_groups;

#ifndef MK_N_LAUNCHES
#define MK_N_LAUNCHES 1
#endif

#define LAS __attribute__((address_space(3)))
#define GAS __attribute__((address_space(1)))
typedef unsigned short bf16_t;
typedef short bf16x8 __attribute__((ext_vector_type(8)));
typedef float f32x4 __attribute__((ext_vector_type(4)));
typedef float f32x16 __attribute__((ext_vector_type(16)));
typedef float f32x2 __attribute__((ext_vector_type(2)));
typedef unsigned u32x4 __attribute__((ext_vector_type(4)));
typedef unsigned u32x2 __attribute__((ext_vector_type(2)));

#ifndef SPLITK_TAIL
#define SPLITK_TAIL 1
#endif
constexpr int T = 16384, D = 1024, SEQ = 8192, NL = 2;
constexpr int NZ = 5632;
constexpr int ZPW = 5120;
constexpr int ZP_ZA = 0, ZP_GLU = 512, ZP_ZU = 1024, ZP_ZV = 1536, ZP_G = 2048;
constexpr int YW = 1536;
constexpr int NE = 32, TOPK = 4, PLE = 256, CONVK = 31;
constexpr int MAXTILES = 288, MAXROWS = MAXTILES * 256;
constexpr float EPS = 1e-6f;

constexpr size_t MiB = 1u << 20;
constexpr size_t WS_CTL = 0;
constexpr size_t WS_META = 1 * MiB;
constexpr size_t WS_TOPE = 2 * MiB;
constexpr size_t WS_TOPW = 3 * MiB;
constexpr size_t WS_SLOTOF = 4 * MiB;
constexpr size_t WS_SMALLW = 5 * MiB;
constexpr size_t SW_LAYER = 1 * MiB, SW_WPT = 0, SW_WSGU = 128 * 1024, SW_WRT = 256 * 1024, SW_BIN = 384 * 1024, SW_BUP = 512 * 1024;
constexpr size_t WS_WIN = 8 * MiB;
constexpr size_t WS_WBR = 32 * MiB;
constexpr size_t WS_WOUT = 40 * MiB;
constexpr size_t WS_WPG = 44 * MiB;
constexpr size_t WS_WPP = 48 * MiB;
constexpr size_t WS_PB = 50 * MiB;
constexpr size_t WS_WUP = 72 * MiB;
constexpr size_t WS_WDN = 328 * MiB;
constexpr size_t WS_XN = 456 * MiB;
constexpr size_t WS_ZP = 488 * MiB;
constexpr size_t WS_Y = 648 * MiB;
constexpr size_t WS_MG = 696 * MiB;
constexpr size_t WS_XG = 728 * MiB;
constexpr size_t WS_ACT = 872 * MiB;
constexpr size_t WS_YE = 1016 * MiB;
constexpr size_t WS_PP = 1160 * MiB;
constexpr size_t WS_YEX = 1192 * MiB;
constexpr size_t WS_END = 1288 * MiB;
constexpr size_t CTL_ZERO_BYTES = 32768;
constexpr int CW_BAR = 4096;
constexpr int CW_GCNT = 128;
constexpr size_t WS_TOKL = WS_XG;
constexpr size_t WS_X0 = WS_XN, WS_X1 = WS_XG + 16 * MiB, WS_X2 = WS_XG + 48 * MiB;
constexpr size_t WS_RS = WS_TOPE;

constexpr int RING_BYTES = 131072;
constexpr int LDS_TAB = RING_BYTES;
constexpr int LDS_RST = RING_BYTES + 11264;
constexpr int LDS_BIAS = LDS_RST + 9216;
constexpr int LDS_MISC = LDS_BIAS + 9216;
constexpr int LDS_BYTES = LDS_MISC + 256;
constexpr int MT_CNT = 0, MT_TSTART = 32, MT_NTILE = 96, MT_SPLIT = 97, MT_TAILROW = 98, MT_NFULL = 99, MT_TE = 128, MT_TOKOFF = 512, MAX_UNITS_PER_WG = 9;
constexpr int YEX_ROWS = 16384;

__device__ __forceinline__ unsigned f2bf(float f) { unsigned u = __builtin_bit_cast(unsigned, f); return (u + 0x7fffu + ((u >> 16) & 1u)) >> 16; }
__device__ __forceinline__ unsigned pk2(float lo, float hi) { unsigned r; asm("v_cvt_pk_bf16_f32 %0, %1, %2" : "=v"(r) : "v"(lo), "v"(hi)); return r; }
__device__ __forceinline__ float bflo(unsigned u) { return __builtin_bit_cast(float, u << 16); }
__device__ __forceinline__ float bfhi(unsigned u) { return __builtin_bit_cast(float, u & 0xffff0000u); }
typedef unsigned long long rs_t;
__device__ __forceinline__ rs_t rs_fix(float ss) { return (rs_t)(ss * 1048576.0f + 0.5f); }
__device__ __forceinline__ float rstd_of(rs_t q) { return __builtin_amdgcn_rsqf((float)q * (1.0f / (1048576.0f * 1024.0f)) + 1e-6f); }
__device__ __forceinline__ float sigmoidf_(float v) { return __builtin_amdgcn_rcpf(1.0f + __builtin_amdgcn_exp2f(-1.44269504089f * v)); }
__device__ __forceinline__ float sig_t(float t) { return __builtin_amdgcn_rcpf(1.0f + __builtin_amdgcn_exp2f(t)); }
__device__ __forceinline__ float wave_sum(float v) {
#pragma unroll
    for (int o = 1; o < 64; o <<= 1) v += __shfl_xor(v, o);
    return v;
}
#ifndef WT_STORES
#define WT_STORES 0
#endif
__device__ __forceinline__ void st16(void* p, u32x4 v) {
#if WT_STORES
    asm volatile("global_store_dwordx4 %0, %1, off sc1\n\ts_nop 1" :: "v"(p), "v"(v) : "memory");
#else
    *(u32x4*)p = v;
#endif
}
#define LDS_WAIT() asm volatile("s_waitcnt lgkmcnt(0)" ::: "memory")
#define VM_WAIT() asm volatile("s_waitcnt vmcnt(0)" ::: "memory")

namespace pg8 {
constexpr int BM = 256, BK = 64, HALF = 128, HTB = HALF * BK * 2, NXCD = 8, WGM = 8;
__host__ __device__ __forceinline__ int lds_byte(int r, int c) { const int st = (r >> 4) * 2 + (c >> 5), rr = r & 15, cc = c & 31, ob = rr * 64 + cc * 2; return st * 1024 + (ob ^ (((ob >> 9) & 1) << 5)); }
__host__ __device__ __forceinline__ void stage_rc(int b, int& R, int& C) { const int st = b / 1024, sb = b % 1024, swz = sb ^ (((sb >> 9) & 1) << 5); R = (st >> 1) * 16 + swz / 64; C = (st & 1) * 32 + (swz % 64) / 2; }
__host__ __device__ __forceinline__ int perm32(int rho) { const int n = rho >> 4, i = rho & 15; return 8 * (i >> 2) + 4 * n + (i & 3); }

struct Unit { const char* A; const char* B; int pm, pn, aux, ord, nt; };

__device__ __forceinline__ void static_tile(int L, int nM, int nN, int& pm, int& pn) {
    const int nwg = nM * nN; int wgid = L;
    { const int q = nwg / NXCD, r = nwg % NXCD, xcd = wgid % NXCD, off = wgid / NXCD; wgid = (xcd < r ? xcd * (q + 1) : r * (q + 1) + (xcd - r) * q) + off; }
    const int nig = WGM * nN, gid = wgid / nig, fm = gid * WGM, gsz = (nM - fm) < WGM ? (nM - fm) : WGM;
    pm = fm + ((wgid % nig) % gsz); pn = (wgid % nig) / gsz;
}

template <class Epi, class Sched, bool GATHER = false>
__device__ __forceinline__ void gemm_phase(LAS unsigned char* lds, const int K_, const int lda, const int ldb, const Sched& S, const Epi& E, const LAS unsigned* gtab = nullptr) {
    int K = K_; asm volatile("" : "+s"(K));
    int tid_ = threadIdx.x; asm volatile("" : "+v"(tid_));
    const int tid = tid_, wid = __builtin_amdgcn_readfirstlane(tid >> 6), lane = tid & 63, wr = wid >> 2, wc = wid & 3, fr = lane & 15, fq = lane >> 4;
    const int nt0 = K / BK;
    unsigned voffA[2], voffB[2], gR[2], gC[2], vC[2][2], vN[2][2], vs[2][2];
#pragma unroll
    for (int i = 0; i < 2; ++i) { int R, C; stage_rc(tid * 16 + i * 8192, R, C); const int Rb = Epi::PERM ? ((R & ~31) + perm32(R & 31)) : R;
        voffA[i] = (unsigned)(R * lda + C) * 2u; voffB[i] = (unsigned)(Rb * ldb + C) * 2u; gR[i] = (unsigned)R; gC[i] = (unsigned)C * 2u; }
#define PG8_GLOAD(dst, u) do { _Pragma("unroll") for (int _h = 0; _h < 2; ++_h) _Pragma("unroll") for (int _i = 0; _i < 2; ++_i) dst[_h][_i] = gtab[(u) * 256 + _h * 128 + gR[_i]] + gC[_i]; } while (0)
#define PG8_STAGE_A(bufoff, h, gbase, VO) do { if constexpr (GATHER) { PG8_STAGE(bufoff, gbase, VO[h]); } else { PG8_STAGE(bufoff, (gbase) + (h) * hstepA, voffA); } } while (0)
    const size_t kstep = (size_t)(BK * 2);
    const size_t hstepA = (size_t)HALF * lda * 2, hstepB = (size_t)HALF * ldb * 2;
    const unsigned ldsw = (unsigned)wid * 1024u;
    const int aoff = lds_byte(wr * 64 + fr, fq * 8), boff = lds_byte(wc * 32 + fr, fq * 8);
#define PG8_SA(b, h) (((b) * 2 + (h)) * HTB)
#define PG8_SB(b, h) ((4 + (b) * 2 + (h)) * HTB)
#define PG8_STAGE(bufoff, gbase, voff) do { _Pragma("unroll") for (int _i = 0; _i < 2; ++_i) \
        __builtin_amdgcn_global_load_lds((const unsigned*)((const char*)(gbase) + (voff)[_i]), (LAS unsigned*)(lds + (bufoff) + ldsw + _i * 8192), 16, 0, 0); } while (0)
#define PG8_LDA(dst, b, h) do { _Pragma("unroll") for (int m = 0; m < 4; ++m) _Pragma("unroll") for (int k = 0; k < 2; ++k) dst[m][k] = *(const LAS bf16x8*)(lds + PG8_SA(b, h) + aoff + m * 2048 + k * 1024); } while (0)
#define PG8_LDB(dst, b, h) do { _Pragma("unroll") for (int n = 0; n < 2; ++n) _Pragma("unroll") for (int k = 0; k < 2; ++k) dst[n][k] = *(const LAS bf16x8*)(lds + PG8_SB(b, h) + boff + n * 2048 + k * 1024); } while (0)
#define PG8_MMA(ai, bj, At, Bt) do { __builtin_amdgcn_s_setprio(1); _Pragma("unroll") for (int m = 0; m < 4; ++m) _Pragma("unroll") for (int n = 0; n < 2; ++n) _Pragma("unroll") for (int k = 0; k < 2; ++k) \
        acc[ai][bj][m][n] = __builtin_amdgcn_mfma_f32_16x16x32_bf16(Bt[n][k], At[m][k], acc[ai][bj][m][n], 0, 0, 0); __builtin_amdgcn_s_setprio(0); } while (0)
#define PG8_WAIT_V(n) asm volatile("s_waitcnt vmcnt(" #n ")" ::: "memory")
#define PG8_WAIT_L(n) asm volatile("s_waitcnt lgkmcnt(" #n ")" ::: "memory")
#define PG8_BAR __builtin_amdgcn_s_barrier()
#define PG8_SCHED __builtin_amdgcn_sched_barrier(0)
    Unit cur, nxt; int ui = 0;
    if (!S.next(0, cur)) return;
    f32x4 acc[2][2][4][2];
#pragma unroll
    for (int a = 0; a < 2; ++a)
#pragma unroll
        for (int b = 0; b < 2; ++b)
#pragma unroll
            for (int m = 0; m < 4; ++m)
#pragma unroll
                for (int n = 0; n < 2; ++n) acc[a][b][m][n] = (f32x4){0.f, 0.f, 0.f, 0.f};
    bf16x8 At[4][2], B0[2][2], B1[2][2];
    const char* cA = cur.A; const char* cB = cur.B;
    if constexpr (GATHER) PG8_GLOAD(vC, 0);
    PG8_STAGE(PG8_SB(0, 0), cB, voffB); PG8_STAGE(PG8_SB(0, 1), cB + hstepB, voffB); PG8_STAGE_A(PG8_SA(0, 0), 0, cA, vC); PG8_STAGE_A(PG8_SA(0, 1), 1, cA, vC);
    if (wr == 1) PG8_BAR;
    PG8_WAIT_V(2); PG8_BAR;
    PG8_STAGE(PG8_SB(1, 0), cB + kstep, voffB); PG8_STAGE_A(PG8_SA(1, 0), 0, cA + kstep, vC); PG8_STAGE(PG8_SB(1, 1), cB + hstepB + kstep, voffB);
    PG8_WAIT_V(6); PG8_BAR;
    for (;;) {
        const bool has_next = S.next(ui + 1, nxt);
        const char* nA = has_next ? nxt.A : cA; const char* nB = has_next ? nxt.B : cB;
        if constexpr (GATHER) { if (has_next) PG8_GLOAD(vN, ui + 1); else {
#pragma unroll
            for (int _h = 0; _h < 2; ++_h)
#pragma unroll
                for (int _i = 0; _i < 2; ++_i) vN[_h][_i] = vC[_h][_i]; } }
        const int nt = cur.nt > 0 ? cur.nt : nt0;
        for (int t = 0; t < nt; t += 2) {
            const bool last = (t == nt - 2);
            if constexpr (GATHER) {
#pragma unroll
                for (int _h = 0; _h < 2; ++_h)
#pragma unroll
                    for (int _i = 0; _i < 2; ++_i) vs[_h][_i] = last ? vN[_h][_i] : vC[_h][_i]; }
            const char* a1 = cA + (size_t)(t + 1) * kstep;
            const char* a2 = last ? nA : cA + (size_t)(t + 2) * kstep; const char* b2 = last ? nB : cB + (size_t)(t + 2) * kstep;
            const char* a3 = a2 + kstep; const char* b3 = b2 + kstep;
            PG8_LDB(B0, 0, 0); PG8_LDB(B1, 0, 1); PG8_SCHED; PG8_LDA(At, 0, 0); PG8_STAGE_A(PG8_SA(1, 1), 1, a1, vC);
            PG8_WAIT_V(8); PG8_WAIT_L(0); PG8_BAR; PG8_MMA(0, 0, At, B0); PG8_MMA(0, 1, At, B1); PG8_BAR; PG8_SCHED;
            PG8_LDA(At, 0, 1); PG8_STAGE(PG8_SB(0, 0), b2, voffB); PG8_STAGE(PG8_SB(0, 1), b2 + hstepB, voffB); PG8_STAGE_A(PG8_SA(0, 0), 0, a2, vs);
            PG8_WAIT_V(8); PG8_WAIT_L(0); PG8_BAR; PG8_MMA(1, 0, At, B0); PG8_MMA(1, 1, At, B1); PG8_BAR; PG8_SCHED;
            PG8_LDB(B0, 1, 0); PG8_LDB(B1, 1, 1); PG8_SCHED; PG8_LDA(At, 1, 0); PG8_STAGE_A(PG8_SA(0, 1), 1, a2, vs);
            PG8_WAIT_V(8); PG8_WAIT_L(0); PG8_BAR; PG8_MMA(0, 0, At, B0); PG8_MMA(0, 1, At, B1); PG8_BAR; PG8_SCHED;
            PG8_LDA(At, 1, 1); PG8_STAGE(PG8_SB(1, 0), b3, voffB); PG8_STAGE(PG8_SB(1, 1), b3 + hstepB, voffB); PG8_STAGE_A(PG8_SA(1, 0), 0, a3, vs);
            PG8_WAIT_V(8); PG8_WAIT_L(0); PG8_BAR; PG8_MMA(1, 0, At, B0); PG8_MMA(1, 1, At, B1); PG8_BAR; PG8_SCHED;
        }
        if (wr == 0) PG8_BAR;
        bool zero = true; if (cur.aux >= 0) { if constexpr (Epi::EDUP) { (void)E(acc, cur, wr, wc, fr, fq); asm volatile("" ::: "memory"); } zero = E(acc, cur, wr, wc, fr, fq); }
        if constexpr (Epi::DRAIN) __builtin_amdgcn_s_waitcnt(0x0F70);
        if (!has_next) break;
        if (zero) {
#pragma unroll
            for (int a = 0; a < 2; ++a)
#pragma unroll
                for (int b = 0; b < 2; ++b)
#pragma unroll
                    for (int m = 0; m < 4; ++m)
#pragma unroll
                        for (int n = 0; n < 2; ++n) acc[a][b][m][n] = (f32x4){0.f, 0.f, 0.f, 0.f};
        }
        cur = nxt; cA = nA; cB = nB; ++ui;
        if constexpr (GATHER) {
#pragma unroll
            for (int _h = 0; _h < 2; ++_h)
#pragma unroll
                for (int _i = 0; _i < 2; ++_i) vC[_h][_i] = vN[_h][_i]; }
        if (wr == 1) PG8_BAR;
    }
    PG8_WAIT_V(0);
    PG8_BAR;
#undef PG8_SA
#undef PG8_SB
#undef PG8_STAGE
#undef PG8_STAGE_A
#undef PG8_GLOAD
#undef PG8_LDA
#undef PG8_LDB
#undef PG8_MMA
#undef PG8_WAIT_V
#undef PG8_WAIT_L
#undef PG8_BAR
#undef PG8_SCHED
}
}
using pg8::Unit;


struct DenseOrder {
    const char* A; const char* B; int nM, nN, G, c; size_t astep, bstep; int dup;
    __device__ __forceinline__ bool next(int i, Unit& u) const {
        const int L = (dup ? (i >> 1) : i) * G + c; if (L >= nM * nN) return false;
        int pm, pn; pg8::static_tile(L, nM, nN, pm, pn);
        u.pm = pm; u.pn = pn; u.ord = i; u.nt = 0; u.aux = (dup && !(i & 1)) ? -1 : 0; u.A = A + (size_t)pm * astep; u.B = B + (size_t)pn * bstep; return true;
    }
};
struct BranchOrder {
    const char* Y; const char* W; int G, c;
    __device__ __forceinline__ bool next(int i, Unit& u) const {
        const int tl = (i / 3) * G + c; if (tl >= 256) return false;
        int pm, pn; pg8::static_tile(tl, 64, 4, pm, pn); const int br = i % 3;
        u.pm = pm; u.pn = pn; u.ord = i; u.nt = 0; u.aux = br; u.A = Y + ((size_t)pm * 256 * YW + (size_t)br * 512) * 2; u.B = W + ((size_t)br * 1024 * 512 + (size_t)pn * 256 * 512) * 2; return true;
    }
};
struct MoeOrder {
    const char* A; const char* W; const LAS int* tile_e; int n_units, NP, G, c; size_t wstride, bstep, astep;
    int n_full, split;
    __device__ __forceinline__ bool next(int i, Unit& u) const {
        int L = i * G + c, q = 0, nq = 1;
        if (L >= n_full && split > 1) { const int j = L - n_full; L = n_full + j / split; q = j % split; nq = split; }
        if (L >= n_units) return false;
        const int tile = L / NP, pn = L - tile * NP; const int e = tile_e[tile];
        const size_t koff = (size_t)q * (1024 / nq) * 2;
        u.pm = tile; u.pn = pn; u.ord = i; u.aux = e | (q << 8); u.nt = 16 / nq; u.A = A + (size_t)tile * astep + koff; u.B = W + (size_t)e * wstride + (size_t)pn * bstep + koff; return true;
    }
};

typedef f32x4 Acc[2][2][4][2];
#ifndef EDUP_IN
#define EDUP_IN 0
#endif
#ifndef EDUP_UP
#define EDUP_UP 0
#endif
struct EpiIn {
    static constexpr bool PERM = true, DRAIN = false, EDUP = (EDUP_IN != 0);
    bf16_t* ZP; const LAS float* rst; const LAS float* bia;
    __device__ __forceinline__ bool operator()(Acc& acc, const Unit& u, int wr, int wc, int fr, int fq) const {
        const int row0 = u.pm * 256 + wr * 64 + fr, pn = u.pn, cl = wc * 32 + 8 * fq;
        float rsv[2][4];
#pragma unroll
        for (int ai = 0; ai < 2; ++ai)
#pragma unroll
            for (int m = 0; m < 4; ++m) rsv[ai][m] = rst[u.ord * 256 + wr * 64 + fr + ai * 128 + m * 16];
        const LAS float* bp = bia + u.ord * 256 + cl;
        f32x4 bv[2][2];
#pragma unroll
        for (int bj = 0; bj < 2; ++bj)
#pragma unroll
            for (int n = 0; n < 2; ++n) bv[bj][n] = *(const LAS f32x4*)(bp + bj * 128 + 4 * n);
        constexpr float NL2E = -1.44269504089f;
        if (pn >= 2 && pn < 6) {
            bf16_t* base = ZP + ZP_GLU + (pn - 2) * 128 + cl;
            const f32x4 bg0 = bv[1][0] * NL2E, bg1 = bv[1][1] * NL2E;
#pragma unroll
            for (int ai = 0; ai < 2; ++ai)
#pragma unroll
                for (int m = 0; m < 4; ++m) { float o[8]; const float rc = rsv[ai][m] * NL2E;
#pragma unroll
                    for (int n = 0; n < 2; ++n) { const f32x4 a = acc[ai][0][m][n] * rsv[ai][m] + bv[0][n], t = acc[ai][1][m][n] * rc + (n ? bg1 : bg0);
#pragma unroll
                        for (int j = 0; j < 4; ++j) o[4 * n + j] = a[j] * __builtin_amdgcn_rcpf(1.0f + __builtin_amdgcn_exp2f(t[j])); }
                    u32x4 w; w.x = pk2(o[0], o[1]); w.y = pk2(o[2], o[3]); w.z = pk2(o[4], o[5]); w.w = pk2(o[6], o[7]);
                    st16(base + (size_t)(row0 + ai * 128 + m * 16) * ZPW, w); }
        } else if (pn >= 10) {
            bf16_t* base = ZP + (pn - 2) * 256 + cl;
            f32x4 bq[2][2];
#pragma unroll
            for (int bj = 0; bj < 2; ++bj)
#pragma unroll
                for (int n = 0; n < 2; ++n) bq[bj][n] = bv[bj][n] * NL2E;
#pragma unroll
            for (int ai = 0; ai < 2; ++ai)
#pragma unroll
                for (int m = 0; m < 4; ++m) { const float rc = rsv[ai][m] * NL2E;
#pragma unroll
                    for (int bj = 0; bj < 2; ++bj) { const f32x4 t0 = acc[ai][bj][m][0] * rc + bq[bj][0], t1 = acc[ai][bj][m][1] * rc + bq[bj][1]; f32x4 v0, v1;
#pragma unroll
                        for (int j = 0; j < 4; ++j) { v0[j] = __builtin_amdgcn_exp2f(t0[j]); v1[j] = __builtin_amdgcn_exp2f(t1[j]); }
                        v0 = v0 + 1.0f; v1 = v1 + 1.0f;
                        u32x4 w; w.x = pk2(v0[0], v0[1]); w.y = pk2(v0[2], v0[3]); w.z = pk2(v1[0], v1[1]); w.w = pk2(v1[2], v1[3]);
                        st16(base + (size_t)(row0 + ai * 128 + m * 16) * ZPW + bj * 128, w); } }
        } else {
            const int dc = (pn < 2 ? pn * 256 : (pn - 2) * 256 + 0) ;
            bf16_t* base = ZP + dc + cl;
#pragma unroll
            for (int ai = 0; ai < 2; ++ai)
#pragma unroll
                for (int m = 0; m < 4; ++m)
#pragma unroll
                    for (int bj = 0; bj < 2; ++bj) { const f32x4 v0 = acc[ai][bj][m][0] * rsv[ai][m] + bv[bj][0], v1 = acc[ai][bj][m][1] * rsv[ai][m] + bv[bj][1];
                        u32x4 w; w.x = pk2(v0[0], v0[1]); w.y = pk2(v0[2], v0[3]); w.z = pk2(v1[0], v1[1]); w.w = pk2(v1[2], v1[3]);
                        st16(base + (size_t)(row0 + ai * 128 + m * 16) * ZPW + bj * 128, w); }
        }
        return true;
    }
};
#ifndef GRND
#define GRND 3
#endif
struct EpiBranch {
    static constexpr bool PERM = true, DRAIN = false, EDUP = false;
    const bf16_t* ZP; const float* bb; bf16_t* MG;
    __device__ __forceinline__ bool operator()(Acc& acc, const Unit& u, int wr, int wc, int fr, int fq) const {
        const int row0 = u.pm * 256 + wr * 64 + fr, c0 = u.pn * 256 + wc * 32 + 8 * fq, br = u.aux;
        f32x4 bv[2][2];
#pragma unroll
        for (int bj = 0; bj < 2; ++bj)
#pragma unroll
            for (int n = 0; n < 2; ++n) bv[bj][n] = *(const f32x4*)(bb + br * 1024 + c0 + bj * 128 + 4 * n);
        const bf16_t* gp = ZP + ZP_G + br * 1024 + c0;
#pragma unroll
        for (int r0 = 0; r0 < 8; r0 += GRND) {
            u32x4 ga[GRND][2], gb[GRND][2];
#pragma unroll
            for (int rr = 0; rr < GRND; ++rr) if (r0 + rr < 8)
#pragma unroll
                for (int bj = 0; bj < 2; ++bj) { const size_t go = (size_t)(row0 + ((r0 + rr) >> 2) * 128 + ((r0 + rr) & 3) * 16) * ZPW + bj * 128;
                    ga[rr][bj] = *(const u32x4*)(gp + go); gb[rr][bj] = *(const u32x4*)(gp + (br < 2 ? 1024 : 0) + go); }
            __builtin_amdgcn_sched_barrier(0);
#pragma unroll
            for (int rr = 0; rr < GRND; ++rr) if (r0 + rr < 8) { const int ai = (r0 + rr) >> 2, m = (r0 + rr) & 3;
                const size_t ro = (size_t)(row0 + ai * 128 + m * 16);
#pragma unroll
                for (int bj = 0; bj < 2; ++bj) {
                    float f[8];
                    if (br < 2) {
#pragma unroll
                        for (int q = 0; q < 4; ++q) { f[2 * q] = fminf(bflo(gb[rr][bj][q]), 1e30f) * __builtin_amdgcn_rcpf(bflo(ga[rr][bj][q])); f[2 * q + 1] = fminf(bfhi(gb[rr][bj][q]), 1e30f) * __builtin_amdgcn_rcpf(bfhi(ga[rr][bj][q])); }
                    } else {
#pragma unroll
                        for (int q = 0; q < 4; ++q) { f[2 * q] = __builtin_amdgcn_rcpf(bflo(ga[rr][bj][q])); f[2 * q + 1] = __builtin_amdgcn_rcpf(bfhi(ga[rr][bj][q])); } }
#pragma unroll
                    for (int n = 0; n < 2; ++n)
#pragma unroll
                        for (int j = 0; j < 4; ++j) acc[ai][bj][m][n][j] = (acc[ai][bj][m][n][j] + bv[bj][n][j]) * f[4 * n + j];
                    if (br == 2) { const f32x4 v0 = acc[ai][bj][m][0], v1 = acc[ai][bj][m][1];
                        u32x4 w; w.x = pk2(v0[0], v0[1]); w.y = pk2(v0[2], v0[3]); w.z = pk2(v1[0], v1[1]); w.w = pk2(v1[2], v1[3]);
                        st16(MG + ro * D + c0 + bj * 128, w); }
                }
            }
            asm volatile("" ::: "memory");
        }
        return br == 2;
    }
};
struct EpiRes {
    static constexpr bool PERM = true, DRAIN = false, EDUP = false;
    const bf16_t* xin; bf16_t* xout; rs_t* rsout;
    __device__ __forceinline__ bool operator()(Acc& acc, const Unit& u, int wr, int wc, int fr, int fq) const {
        const int row0 = u.pm * 256 + wr * 64 + fr, c0 = u.pn * 256 + wc * 32 + 8 * fq;
#pragma unroll
        for (int ai = 0; ai < 2; ++ai) {
            u32x4 xv[4][2];
#pragma unroll
            for (int m = 0; m < 4; ++m)
#pragma unroll
                for (int bj = 0; bj < 2; ++bj) xv[m][bj] = *(const u32x4*)(xin + (size_t)(row0 + ai * 128 + m * 16) * D + c0 + bj * 128);
            __builtin_amdgcn_sched_barrier(0);
#pragma unroll
            for (int m = 0; m < 4; ++m) { const int r = row0 + ai * 128 + m * 16; float ss = 0.f;
#pragma unroll
                for (int bj = 0; bj < 2; ++bj) { const u32x4 x = xv[m][bj]; f32x4 v0 = acc[ai][bj][m][0], v1 = acc[ai][bj][m][1];
                    v0[0] += bflo(x.x); v0[1] += bfhi(x.x); v0[2] += bflo(x.y); v0[3] += bfhi(x.y); v1[0] += bflo(x.z); v1[1] += bfhi(x.z); v1[2] += bflo(x.w); v1[3] += bfhi(x.w);
                    ss += ((v0[0] * v0[0] + v0[1] * v0[1]) + (v0[2] * v0[2] + v0[3] * v0[3])) + ((v1[0] * v1[0] + v1[1] * v1[1]) + (v1[2] * v1[2] + v1[3] * v1[3]));
                    u32x4 w; w.x = pk2(v0[0], v0[1]); w.y = pk2(v0[2], v0[3]); w.z = pk2(v1[0], v1[1]); w.w = pk2(v1[2], v1[3]);
                    st16(xout + (size_t)r * D + c0 + bj * 128, w); }
                ss += __shfl_xor(ss, 16); ss += __shfl_xor(ss, 32);
                if (fq == 0) atomicAdd(rsout + r, rs_fix(ss)); }
            asm volatile("" ::: "memory"); }
        return true;
    }
};
struct EpiUp {
    static constexpr bool PERM = true, DRAIN = false, EDUP = (EDUP_UP != 0);
    bf16_t* ACT; const LAS float* rst; const LAS float* bia;
    __device__ __forceinline__ bool operator()(Acc& acc, const Unit& u, int wr, int wc, int fr, int fq) const {
        const int row0 = u.pm * 256 + wr * 64 + fr, cl = wc * 32 + 8 * fq;
        float rsv[2][4];
#pragma unroll
        for (int ai = 0; ai < 2; ++ai)
#pragma unroll
            for (int m = 0; m < 4; ++m) rsv[ai][m] = rst[u.ord * 256 + ai * 128 + wr * 64 + m * 16 + fr];
        const LAS float* bp = bia + u.ord * 256 + cl;
        f32x4 bg[2], bl[2];
#pragma unroll
        for (int n = 0; n < 2; ++n) { bg[n] = *(const LAS f32x4*)(bp + 4 * n); bl[n] = *(const LAS f32x4*)(bp + 128 + 4 * n); }
        bf16_t* base = ACT + u.pn * 128 + cl;
#pragma unroll
        for (int ai = 0; ai < 2; ++ai)
#pragma unroll
            for (int m = 0; m < 4; ++m) { unsigned o[4]; const f32x2 r2 = {rsv[ai][m], rsv[ai][m]};
#pragma unroll
                for (int n = 0; n < 2; ++n)
#pragma unroll
                    for (int h = 0; h < 2; ++h) {
                        const f32x2 a0 = {acc[ai][0][m][n][2 * h], acc[ai][0][m][n][2 * h + 1]}, a1 = {acc[ai][1][m][n][2 * h], acc[ai][1][m][n][2 * h + 1]};
                        const f32x2 b0 = {bg[n][2 * h], bg[n][2 * h + 1]}, b1 = {bl[n][2 * h], bl[n][2 * h + 1]};
                        f32x2 g = a0 * r2 + b0, l = a1 * r2 + b1;
                        g.x = fminf(g.x, 7.0f); g.y = fminf(g.y, 7.0f);
                        l.x = __builtin_amdgcn_fmed3f(l.x, -7.0f, 7.0f); l.y = __builtin_amdgcn_fmed3f(l.y, -7.0f, 7.0f);
                        const f32x2 t = g * (f32x2){-1.702f * 1.44269504089f, -1.702f * 1.44269504089f};
                        f32x2 d = {__builtin_amdgcn_exp2f(t.x), __builtin_amdgcn_exp2f(t.y)};
                        d = d + (f32x2){1.0f, 1.0f};
                        const f32x2 sg = {__builtin_amdgcn_rcpf(d.x), __builtin_amdgcn_rcpf(d.y)};
                        const f32x2 a = g * sg, ov = a * l + a;
                        o[2 * n + h] = pk2(ov.x, ov.y); }
                u32x4 w; w.x = o[0]; w.y = o[1]; w.z = o[2]; w.w = o[3];
                st16(base + (size_t)(row0 + ai * 128 + m * 16) * D, w); }
        return true;
    }
};
struct EpiBf {
    static constexpr bool PERM = true, DRAIN = false, EDUP = false;
    bf16_t* O; const float* bias; bf16_t* OX; int tail_row0;
    __device__ __forceinline__ bool operator()(Acc& acc, const Unit& u, int wr, int wc, int fr, int fq) const {
        const int row0 = u.pm * 256 + wr * 64 + fr, c0 = u.pn * 256 + wc * 32 + 8 * fq, e = u.aux & 255, q = (u.aux >> 8) & 3;
        f32x4 bv[2][2];
#pragma unroll
        for (int bj = 0; bj < 2; ++bj)
#pragma unroll
            for (int n = 0; n < 2; ++n) bv[bj][n] = (bias && q == 0) ? *(const f32x4*)(bias + e * 1024 + c0 + bj * 128 + 4 * n) : (f32x4){0.f, 0.f, 0.f, 0.f};
        bf16_t* ob = (q == 0) ? O + (size_t)row0 * D : OX + ((size_t)(q - 1) * YEX_ROWS + (size_t)(row0 - tail_row0)) * D;
#pragma unroll
        for (int ai = 0; ai < 2; ++ai)
#pragma unroll
            for (int m = 0; m < 4; ++m)
#pragma unroll
                for (int bj = 0; bj < 2; ++bj) { const f32x4 v0 = acc[ai][bj][m][0] + bv[bj][0], v1 = acc[ai][bj][m][1] + bv[bj][1];
                    u32x4 w; w.x = pk2(v0[0], v0[1]); w.y = pk2(v0[2], v0[3]); w.z = pk2(v1[0], v1[1]); w.w = pk2(v1[2], v1[3]);
                    st16(ob + (size_t)(ai * 128 + m * 16) * D + c0 + bj * 128, w); }
        return true;
    }
};
struct EpiPle {
    static constexpr bool PERM = true, DRAIN = false, EDUP = false;
    const bf16_t* xin; bf16_t* xout; const bf16_t* PP; const rs_t* rs; rs_t* rsout;
    __device__ __forceinline__ bool operator()(Acc& acc, const Unit& u, int wr, int wc, int fr, int fq) const {
        const int row0 = u.pm * 256 + wr * 64 + fr, c0 = u.pn * 256 + wc * 32 + 8 * fq;
#pragma unroll
        for (int am = 0; am < 4; ++am) { const int ai = am >> 1, m0 = (am & 1) * 2;
            u32x4 xv[2][2], pv[2][2]; float rsv[2];
#pragma unroll
            for (int mm = 0; mm < 2; ++mm) { const int r = row0 + ai * 128 + (m0 + mm) * 16; rsv[mm] = rstd_of(rs[r]) * -1.44269504089f;
#pragma unroll
                for (int bj = 0; bj < 2; ++bj) { xv[mm][bj] = *(const u32x4*)(xin + (size_t)r * D + c0 + bj * 128); pv[mm][bj] = *(const u32x4*)(PP + (size_t)r * D + c0 + bj * 128); } }
            __builtin_amdgcn_sched_barrier(0);
#pragma unroll
            for (int mm = 0; mm < 2; ++mm) { const int m = m0 + mm, r = row0 + ai * 128 + m * 16; float ss = 0.f;
#pragma unroll
                for (int bj = 0; bj < 2; ++bj) { const u32x4 x = xv[mm][bj], p = pv[mm][bj]; const f32x4 a0 = acc[ai][bj][m][0] * rsv[mm], a1 = acc[ai][bj][m][1] * rsv[mm]; float v[8];
                    v[0] = bflo(x.x) + sig_t(a0[0]) * bflo(p.x); v[1] = bfhi(x.x) + sig_t(a0[1]) * bfhi(p.x); v[2] = bflo(x.y) + sig_t(a0[2]) * bflo(p.y); v[3] = bfhi(x.y) + sig_t(a0[3]) * bfhi(p.y);
                    v[4] = bflo(x.z) + sig_t(a1[0]) * bflo(p.z); v[5] = bfhi(x.z) + sig_t(a1[1]) * bfhi(p.z); v[6] = bflo(x.w) + sig_t(a1[2]) * bflo(p.w); v[7] = bfhi(x.w) + sig_t(a1[3]) * bfhi(p.w);
                    ss += ((v[0] * v[0] + v[1] * v[1]) + (v[2] * v[2] + v[3] * v[3])) + ((v[4] * v[4] + v[5] * v[5]) + (v[6] * v[6] + v[7] * v[7]));
                    u32x4 w; w.x = pk2(v[0], v[1]); w.y = pk2(v[2], v[3]); w.z = pk2(v[4], v[5]); w.w = pk2(v[6], v[7]);
                    st16(xout + (size_t)r * D + c0 + bj * 128, w); }
                ss += __shfl_xor(ss, 16); ss += __shfl_xor(ss, 32);
                if (fq == 0) atomicAdd(rsout + r, rs_fix(ss)); }
            asm volatile("" ::: "memory"); }
        return true;
    }
};

#define XB_TMO      128
#define XB_XCNT(j)  (256  + 64 * (j))
#define XB_XSUB(j)  (1280 + 64 * (j))
#define XB_XGEN(j)  (2304 + 64 * (j))
#define XB_TOP      3328
#define XB_TOPGEN   3392
#define XCD_BAR_WORDS 3456
#define XB_SPIN_CAP (1u << 22)
__device__ __forceinline__ unsigned xb_ld(unsigned* p)              { return __hip_atomic_load(p, __ATOMIC_RELAXED, __HIP_MEMORY_SCOPE_AGENT); }
__device__ __forceinline__ unsigned xb_add(unsigned* p, unsigned v) { return __hip_atomic_fetch_add(p, v, __ATOMIC_RELAXED, __HIP_MEMORY_SCOPE_AGENT); }
__device__ __forceinline__ unsigned xb_xcc_id() { return (unsigned)__builtin_amdgcn_s_getreg((3 << 11) | 20) & 0xFu; }
#define XB_SPIN(cond, bar) do { unsigned _sp = 0; while (cond) { __builtin_amdgcn_s_sleep(1); \
    if ((++_sp & 255u) == 0u) { if (xb_ld(&(bar)[XB_TMO])) break; if (_sp > XB_SPIN_CAP) { atomicAdd(&(bar)[XB_TMO], 1u); break; } } } } while (0)
struct XcdBarrier { unsigned* bar; unsigned x; volatile LAS unsigned* st; };
__device__ __forceinline__ XcdBarrier xcd_barrier_post(unsigned* bar, volatile LAS unsigned* st) {
    XcdBarrier b; b.bar = bar; b.x = xb_xcc_id(); b.st = st;
    if (threadIdx.x == 0) (void)xb_add(&bar[XB_XCNT(b.x)], 1u);
    return b;
}
__device__ __forceinline__ void xcd_barrier_complete(unsigned* bar, unsigned x, unsigned& nloc, unsigned& nx) {
    const unsigned G = gridDim.x * gridDim.y * gridDim.z;
    unsigned sum, cnt, mine, sp = 0u;
    for (;;) {
        sum = 0u; cnt = 0u; mine = 0u;
#pragma unroll
        for (unsigned j = 0; j < 16; ++j) { const unsigned c = xb_ld(&bar[XB_XCNT(j)]); sum += c; cnt += (c > 0u) ? 1u : 0u; mine = (j == x) ? c : mine; }
        if (sum == G) break;
        __builtin_amdgcn_s_sleep(1);
        if ((++sp & 255u) == 0u) { if (xb_ld(&bar[XB_TMO])) break; if (sp > XB_SPIN_CAP) { atomicAdd(&bar[XB_TMO], 1u); break; } }
    }
    nloc = mine > 0u ? mine : 1u; nx = cnt > 0u ? cnt : 1u;
}
__device__ __forceinline__ void xcd_barrier(const XcdBarrier& b) {
    asm volatile("s_waitcnt vmcnt(0)" ::: "memory");
    __syncthreads();
    if (threadIdx.x == 0) {
        unsigned* bar = b.bar;
        __builtin_amdgcn_s_waitcnt(0);
        unsigned nloc = b.st[0], nx = b.st[1];
        if (nloc == 0u) { xcd_barrier_complete(bar, b.x, nloc, nx); b.st[0] = nloc; b.st[1] = nx; }
        const unsigned old = xb_add(&bar[XB_XSUB(b.x)], 1u);
        const unsigned gen = old / nloc;
        if (old + 1u == (gen + 1u) * nloc) {
            __builtin_amdgcn_fence(__ATOMIC_RELEASE, "agent");
            asm volatile("s_waitcnt vmcnt(0)" ::: "memory");
            const unsigned og = xb_add(&bar[XB_TOP], 1u);
            const unsigned tg = og / nx;
            if (og + 1u == (tg + 1u) * nx) xb_add(&bar[XB_TOPGEN], 1u);
            else XB_SPIN(xb_ld(&bar[XB_TOPGEN]) == tg, bar);
            __builtin_amdgcn_fence(__ATOMIC_ACQUIRE, "agent");
            xb_add(&bar[XB_XGEN(b.x)], 1u);
            asm volatile("s_waitcnt vmcnt(0)" ::: "memory");
        } else {
            XB_SPIN(xb_ld(&bar[XB_XGEN(b.x)]) == gen, bar);
            __builtin_amdgcn_fence(__ATOMIC_ACQUIRE, "agent");
            asm volatile("s_waitcnt vmcnt(0)" ::: "memory");
        }
    }
    __syncthreads();
}

struct Args { const float* in[29]; float* out; unsigned char* ws; int ph_lo, ph_hi, use_cg, pad; };
struct Frame {
    LAS unsigned char* lds; int tid, lane, wave, G, vcu;
    float* out; unsigned char* ws;
    __device__ __forceinline__ void refresh() { int t = threadIdx.x; asm volatile("" : "+v"(t)); tid = t; lane = t & 63; wave = __builtin_amdgcn_readfirstlane(t >> 6); }
};
__device__ __forceinline__ const float* kin(int i) {
    const char __attribute__((address_space(4)))* p = (const char __attribute__((address_space(4)))*)__builtin_amdgcn_kernarg_segment_ptr();
    asm volatile("" : "+s"(p));
    return *(const float* const __attribute__((address_space(4)))*)(p + 8 * i);
}
#define WSP(T_, off) ((T_*)(F.ws + (off)))

struct TrDesc { const float* W; bf16_t* WT; const float* scale; int N, dK, k0, n0, drow0; };
__device__ __forceinline__ void tr_load(const TrDesc& d, int lane, f32x4 (&v)[16], float (&sc)[16]) {
    const int kr = lane >> 4, nc = 4 * (lane & 15);
#pragma unroll
    for (int i = 0; i < 16; ++i) v[i] = __builtin_nontemporal_load((const f32x4*)(d.W + (size_t)(d.k0 + 4 * i + kr) * d.N + d.n0 + nc));
#pragma unroll
    for (int i = 0; i < 16; ++i) sc[i] = d.scale ? d.scale[d.k0 + 4 * i + kr] : 1.0f;
}
__device__ __forceinline__ void tr_store(const TrDesc& d, int lane, const f32x4 (&v)[16], const float (&sc)[16], LAS float* scr) {
    const int kr = lane >> 4, nc = 4 * (lane & 15);
#pragma unroll
    for (int i = 0; i < 16; ++i) { LAS float* s = scr + (4 * i + kr) * 65 + nc; s[0] = v[i][0] * sc[i]; s[1] = v[i][1] * sc[i]; s[2] = v[i][2] * sc[i]; s[3] = v[i][3] * sc[i]; }
    LDS_WAIT(); asm volatile("" ::: "memory");
    const int c = lane & 7;
#pragma unroll
    for (int it = 0; it < 8; ++it) { const int n = (lane >> 3) + 8 * it; const LAS float* s = scr + (8 * c) * 65 + n;
        u32x4 o; o.x = pk2(s[0 * 65], s[1 * 65]); o.y = pk2(s[2 * 65], s[3 * 65]); o.z = pk2(s[4 * 65], s[5 * 65]); o.w = pk2(s[6 * 65], s[7 * 65]);
        __builtin_nontemporal_store(o, (u32x4*)(d.WT + (size_t)(d.drow0 + n) * d.dK + d.k0 + 8 * c)); }
    LDS_WAIT(); asm volatile("" ::: "memory");
}
__device__ __forceinline__ int win_src(int np) { if (np >= 512 && np < 1536) { const int t = (np - 512) >> 8, i = (np - 512) & 255; return i < 128 ? 512 + 128 * t + i : 1024 + 128 * t + (i - 128); } return np; }
__device__ __forceinline__ int win_dst64(int n0) { if (n0 >= 512 && n0 < 1024) { const int c = n0 - 512; return 512 + 256 * (c >> 7) + (c & 127); } if (n0 >= 1024 && n0 < 1536) { const int c = n0 - 1024; return 512 + 256 * (c >> 7) + 128 + (c & 127); } return n0; }
__device__ __forceinline__ int up_src(int np) { const int t = np >> 8, i = np & 255; return i < 128 ? 128 * t + i : 1024 + 128 * t + (i - 128); }
__device__ __forceinline__ int up_dst64(int n0) { if (n0 < 1024) return 256 * (n0 >> 7) + (n0 & 127); const int c = n0 - 1024; return 256 * (c >> 7) + 128 + (c & 127); }

__device__ __forceinline__ void row_load(const float* xr, int lane, f32x4 (&v)[4]) {
#pragma unroll
    for (int j = 0; j < 4; ++j) v[j] = *(const f32x4*)(xr + 4 * lane + 256 * j);
}
__device__ __forceinline__ void row_store_bf16(bf16_t* o, int lane, const f32x4 (&v)[4], float sc) {
#pragma unroll
    for (int j = 0; j < 4; ++j) { u32x2 w; w.x = pk2(v[j][0] * sc, v[j][1] * sc); w.y = pk2(v[j][2] * sc, v[j][3] * sc); *(u32x2*)(o + 4 * lane + 256 * j) = w; }
}
__device__ __forceinline__ void row_load_bf(const bf16_t* xr, int lane, u32x2 (&p)[4]) {
#pragma unroll
    for (int j = 0; j < 4; ++j) p[j] = *(const u32x2*)(xr + 4 * lane + 256 * j);
}
__device__ __forceinline__ void row_unpack(const u32x2 (&p)[4], f32x4 (&v)[4]) {
#pragma unroll
    for (int j = 0; j < 4; ++j) { v[j][0] = bflo(p[j].x); v[j][1] = bfhi(p[j].x); v[j][2] = bflo(p[j].y); v[j][3] = bfhi(p[j].y); }
}
__device__ __forceinline__ float row_sumsq(const f32x4 (&v)[4]) {
    float s = 0.f;
#pragma unroll
    for (int j = 0; j < 4; ++j) s += (v[j][0] * v[j][0] + v[j][1] * v[j][1]) + (v[j][2] * v[j][2] + v[j][3] * v[j][3]);
    return wave_sum(s);
}
__device__ __forceinline__ void phase_final(Frame& F, const bf16_t* xb, const rs_t* rsf, float* out, const float* g) {
    const int gw = F.vcu * 8 + F.wave, NGW = F.G * 8;
    for (int m = gw; m < T; m += NGW) { u32x2 p[4]; f32x4 v[4]; row_load_bf(xb + (size_t)m * D, F.lane, p); row_unpack(p, v); const float rs = rstd_of(rsf[m]);
#pragma unroll
        for (int j = 0; j < 4; ++j) { const f32x4 gg = *(const f32x4*)(g + 4 * F.lane + 256 * j); *(f32x4*)(out + (size_t)m * D + 4 * F.lane + 256 * j) = v[j] * rs * gg; } }
}

#ifndef TAIL_XF
#define TAIL_XF 12288
#endif
#ifndef TAIL_L1A
#define TAIL_L1A 5120
#endif
#ifndef TAIL_L1B
#define TAIL_L1B 3072
#endif
#ifndef TAIL_XF4
#define TAIL_XF4 4096
#endif
constexpr int I_WIN = 16 * 88, I_BR = 8 * 16, I_SQ = 16 * 16, I_UP = 16 * 32, I_PP = 4 * 16, I_POOL = 4;
constexpr int CONV_PER_LAYER = I_WIN + 3 * I_BR + I_SQ + 32 * I_UP + 32 * I_SQ + I_SQ + I_PP + 4 * I_POOL, CONV_NEXP = 32 * I_UP + 32 * I_SQ;
__device__ __forceinline__ TrDesc conv_desc(Frame& F, int l, int r) {
    if (r < 32 * I_UP) { const int e = r / I_UP, q = r % I_UP, kb = q / 32, nb = q % 32;
        return TrDesc{kin(21) + ((size_t)l * NE + e) * D * 2048, WSP(bf16_t, WS_WUP) + ((size_t)l * NE + e) * 2048 * D, kin(18) + l * D, 2048, D, 64 * kb, 64 * nb, up_dst64(64 * nb)}; } r -= 32 * I_UP;
    if (r < 32 * I_SQ) { const int e = r / I_SQ, q = r % I_SQ, kb = q / 16, nb = q % 16;
        return TrDesc{kin(23) + ((size_t)l * NE + e) * D * D, WSP(bf16_t, WS_WDN) + ((size_t)l * NE + e) * D * D, nullptr, D, D, 64 * kb, 64 * nb, 64 * nb}; } r -= 32 * I_SQ;
    if (r < I_WIN) { const int kb = r / 88, nb = r % 88;
        return TrDesc{kin(3) + (size_t)l * D * NZ, WSP(bf16_t, WS_WIN) + (size_t)l * NZ * D, kin(2) + l * D, NZ, D, 64 * kb, 64 * nb, win_dst64(64 * nb)}; } r -= I_WIN;
    if (r < 3 * I_BR) { const int k = r / I_BR, q = r % I_BR, kb = q / 16, nb = q % 16;
        return TrDesc{kin(15) + ((size_t)l * 3 + k) * 512 * D, WSP(bf16_t, WS_WBR) + ((size_t)l * 3 + k) * D * 512, nullptr, D, 512, 64 * kb, 64 * nb, 64 * nb}; } r -= 3 * I_BR;
    if (r < I_SQ) { const int kb = r / 16, nb = r % 16;
        return TrDesc{kin(17) + (size_t)l * D * D, WSP(bf16_t, WS_WOUT) + (size_t)l * D * D, nullptr, D, D, 64 * kb, 64 * nb, 64 * nb}; } r -= I_SQ;
    if (r < I_SQ) { const int kb = r / 16, nb = r % 16;
        return TrDesc{kin(26) + (size_t)l * D * D, WSP(bf16_t, WS_WPG) + (size_t)l * D * D, kin(25) + l * D, D, D, 64 * kb, 64 * nb, 64 * nb}; } r -= I_SQ;
    if (r < I_PP) { const int kb = r / 16, nb = r % 16;
        return TrDesc{kin(27) + (size_t)l * PLE * D, WSP(bf16_t, WS_WPP) + (size_t)l * D * PLE, nullptr, D, PLE, 64 * kb, 64 * nb, 64 * nb}; } r -= I_PP;
    { const int g = r / I_POOL, q = r % I_POOL, kb = q / 2, nb = q % 2;
        return TrDesc{kin(5) + ((size_t)l * 4 + g) * 128 * 128, WSP(bf16_t, WS_SMALLW + l * SW_LAYER + SW_WPT) + (size_t)g * 128 * 128, nullptr, 128, 128, 64 * kb, 64 * nb, 64 * nb}; }
}
template <class Map> __device__ __forceinline__ void conv_stream(Frame& F, int first, int stride, int count, const Map& map) {
    LAS float* scr = (LAS float*)(F.lds + F.wave * 16640);
    if (first >= count) return;
    f32x4 va[16], vb[16]; float sa[16], sb[16];
    int l, r; map(first, l, r); TrDesc da = conv_desc(F, l, r), db = da;
    tr_load(da, F.lane, va, sa);
    for (int it = first; it < count; it += 2 * stride) {
        const bool hb = it + stride < count;
        if (hb) { map(it + stride, l, r); db = conv_desc(F, l, r); tr_load(db, F.lane, vb, sb); }
        tr_store(da, F.lane, va, sa, scr);
        const bool ha = it + 2 * stride < count;
        if (ha) { map(it + 2 * stride, l, r); da = conv_desc(F, l, r); tr_load(da, F.lane, va, sa); }
        if (hb) tr_store(db, F.lane, vb, sb, scr);
    }
}
__device__ __forceinline__ void phase_weights(Frame& F) {
    const int gw = F.vcu * 8 + F.wave, NGW = F.G * 8;
    conv_stream(F, gw, NGW, I_WIN, [](int it, int& l, int& r) { l = 0; r = CONV_NEXP + it; });
    const size_t gt = (size_t)F.vcu * 512 + F.tid, NGT = (size_t)F.G * 512;
    { const float* sguw = kin(13);
      for (size_t i = gt; i < (size_t)NL * 4 * 128 * 128; i += NGT) { const int l = (int)(i >> 16), r = (int)(i & 65535), t = (r >> 7) & 127, s = r & 127;
        WSP(bf16_t, WS_SMALLW + l * SW_LAYER + SW_WSGU)[r] = (bf16_t)f2bf(s <= t ? sguw[i] : 0.f); } }
    { const float* rw = kin(19); const float* mn = kin(18);
      for (size_t i = gt; i < (size_t)NL * NE * D; i += NGT) { const int l = (int)(i >> 15), r = (int)(i & 32767), e = r >> 10, k = r & 1023;
        const float w = rw[((size_t)l * D + k) * NE + e] * mn[l * D + k]; const unsigned hi = f2bf(w); const float wl = w - __builtin_bit_cast(float, hi << 16);
        WSP(bf16_t, WS_SMALLW + l * SW_LAYER + SW_WRT)[r] = (bf16_t)hi; WSP(bf16_t, WS_SMALLW + l * SW_LAYER + SW_WRT + 65536)[r] = (bf16_t)f2bf(wl); } }
    { const float* bi = kin(4);
      for (size_t i = gt; i < (size_t)NL * NZ; i += NGT) { const int l = (int)(i / NZ), np = (int)(i % NZ);
        WSP(float, WS_SMALLW + l * SW_LAYER + SW_BIN)[np] = bi[l * NZ + win_src(np)]; } }
    { const float* bu = kin(22);
      for (size_t i = gt; i < (size_t)NL * NE * 2048; i += NGT) { const int l = (int)(i >> 16), r = (int)(i & 65535), e = r >> 11, np = r & 2047;
        WSP(float, WS_SMALLW + l * SW_LAYER + SW_BUP)[r] = bu[((size_t)l * NE + e) * 2048 + up_src(np)]; } }
    { rs_t* rsz = WSP(rs_t, WS_RS) + T; for (size_t i = gt; i < (size_t)3 * NL * T; i += NGT) rsz[i] = 0ull; }
    { const float* x = kin(0); bf16_t* X0 = WSP(bf16_t, WS_X0); rs_t* rs0 = WSP(rs_t, WS_RS);
      for (int m = gw; m < T; m += NGW) { f32x4 v[4]; row_load(x + (size_t)m * D, F.lane, v); const float ss = row_sumsq(v); row_store_bf16(X0 + (size_t)m * D, F.lane, v, 1.0f); if (F.lane == 0) rs0[m] = rs_fix(ss); } }
}
__device__ __forceinline__ void phase_convert_rest(Frame& F, int nb0) {
    const int nb = F.G - nb0, gw = ((int)blockIdx.x - nb0) * 8 + F.wave, NGW = nb * 8;
    constexpr int L0REST = CONV_PER_LAYER - CONV_NEXP - I_WIN, L0ALL = L0REST + CONV_NEXP;
    conv_stream(F, gw, NGW, L0ALL + CONV_PER_LAYER - TAIL_XF - TAIL_XF4 - TAIL_L1A - TAIL_L1B, [](int it, int& l, int& r) { if (it < L0REST) { l = 0; r = CONV_NEXP + I_WIN + it; } else if (it < L0ALL) { l = 0; r = it - L0REST; } else { l = 1; r = it - L0ALL + TAIL_XF + TAIL_XF4; if (r >= 32 * I_UP) r += TAIL_L1A + TAIL_L1B; } });
    const size_t gt = (size_t)((int)blockIdx.x - nb0) * 512 + F.tid, NGT = (size_t)nb * 512;
    { const float* pp = kin(1);
      for (size_t i = gt; i < (size_t)NL * T * PLE / 4; i += NGT) { const f32x4 v = *(const f32x4*)(pp + 4 * i); u32x2 w; w.x = pk2(v[0], v[1]); w.y = pk2(v[2], v[3]); *(u32x2*)(WSP(bf16_t, WS_PB) + 4 * i) = w; } }
}
__device__ __forceinline__ void conv_tail(Frame& F, int j, int n, int first, int count) {
    conv_stream(F, j * 8 + F.wave, n * 8, count, [first](int it, int& l, int& r) { l = 1; r = first + it; });
}

__device__ __forceinline__ float reduce_scatter64(float (&v)[64], int lane) {
#pragma unroll
    for (int m = 32, n = 32; m >= 1; m >>= 1, n >>= 1) {
        const bool up = (lane & m) != 0; float rcv[32];
#pragma unroll
        for (int i = 0; i < n; ++i) { const float a = v[i], b = v[i + n]; const float send = up ? a : b; v[i] = up ? b : a; rcv[i] = __shfl_xor(send, m); }
        __builtin_amdgcn_sched_barrier(0);
#pragma unroll
        for (int i = 0; i < n; ++i) v[i] += rcv[i];
    }
    return v[0];
}
__device__ __forceinline__ float reduce_scatter32(float (&v)[32], int lane) {
#pragma unroll
    for (int m = 32, n = 16; m >= 2; m >>= 1, n >>= 1) {
        const bool up = (lane & m) != 0; float rcv[16];
#pragma unroll
        for (int i = 0; i < n; ++i) { const float a = v[i], b = v[i + n]; const float send = up ? a : b; v[i] = up ? b : a; rcv[i] = __shfl_xor(send, m); }
        __builtin_amdgcn_sched_barrier(0);
#pragma unroll
        for (int i = 0; i < n; ++i) v[i] += rcv[i];
    }
    return v[0] + __shfl_xor(v[0], 1);
}
__device__ __forceinline__ void conv_unit(Frame& F, int l, int u) {
    const int t0 = 64 * u, s0 = t0 & (SEQ - 1);
    const bf16_t* ZP = WSP(bf16_t, WS_ZP);
    LAS unsigned char* in = F.lds;
    {
        u32x4 cv[12];
#pragma unroll
        for (int q = 0; q < 12; ++q) { const int idx = F.tid + 512 * q, r = idx >> 6, c16 = idx & 63; const int pos = s0 - 30 + r, rr = pos >= 0 ? t0 - 30 + r : t0 - s0;
            cv[q] = (idx < 94 * 64) ? *(const u32x4*)(ZP + (size_t)rr * ZPW + ZP_GLU + 8 * c16) : (u32x4){0u, 0u, 0u, 0u}; }
        __builtin_amdgcn_sched_barrier(0);
#pragma unroll
        for (int q = 0; q < 12; ++q) { const int idx = F.tid + 512 * q, r = idx >> 6, c16 = idx & 63; const bool ok = (s0 - 30 + r >= 0);
            u32x4 v = cv[q]; v.x = ok ? v.x : 0u; v.y = ok ? v.y : 0u; v.z = ok ? v.z : 0u; v.w = ok ? v.w : 0u;
            if (idx < 94 * 64) *(LAS u32x4*)(in + r * 1024 + c16 * 16) = v; }
    }
    const int cp = F.tid & 255, half = F.tid >> 8;
    f32x2 w[CONVK]; const float* cwp = kin(7);
#pragma unroll
    for (int j = 0; j < CONVK; ++j) w[j] = *(const f32x2*)(cwp + ((size_t)l * CONVK + j) * 512 + 2 * cp);
    const f32x2 cb = *(const f32x2*)(kin(8) + l * 512 + 2 * cp);
    f32x2 acc[32];
#pragma unroll
    for (int o = 0; o < 32; ++o) acc[o] = cb;
    __syncthreads();
    const LAS unsigned char* ip = in + (32 * half) * 1024 + cp * 4;
    unsigned pvl[62];
#pragma unroll
    for (int rr = 0; rr < 62; ++rr) pvl[rr] = *(const LAS unsigned*)(ip + rr * 1024);
    __builtin_amdgcn_sched_barrier(0);
#pragma unroll
    for (int rr = 0; rr < 62; ++rr) { const unsigned pv = pvl[rr]; const f32x2 v = (f32x2){bflo(pv), bfhi(pv)};
#pragma unroll
        for (int o = (rr > 30 ? rr - 30 : 0); o <= (rr < 31 ? rr : 31); ++o) acc[o] = acc[o] + w[rr - o] * v; }
    float st[64];
#pragma unroll
    for (int o = 0; o < 32; ++o) { st[o] = acc[o].x + acc[o].y; st[32 + o] = acc[o].x * acc[o].x + acc[o].y * acc[o].y; }
    const float tot = reduce_scatter64(st, F.lane);
    LAS float* red = (LAS float*)(F.lds + LDS_TAB);
    red[F.wave * 64 + F.lane] = tot;
    __syncthreads();
    if (F.tid < 128) { const int h = F.tid >> 6, i = F.tid & 63; red[512 + F.tid] = (red[(4 * h) * 64 + i] + red[(4 * h + 1) * 64 + i]) + (red[(4 * h + 2) * 64 + i] + red[(4 * h + 3) * 64 + i]); }
    __syncthreads();
    const f32x2 ng = *(const f32x2*)(kin(9) + l * 512 + 2 * cp), nb = *(const f32x2*)(kin(10) + l * 512 + 2 * cp);
    bf16_t* Y = WSP(bf16_t, WS_Y) + (size_t)(t0 + 32 * half) * YW + 512 + 2 * cp;
#pragma unroll
    for (int o = 0; o < 32; ++o) { const float mean = red[512 + half * 64 + o] * (1.0f / 512.0f), var = red[512 + half * 64 + 32 + o] * (1.0f / 512.0f) - mean * mean; const float rs = 1.0f / sqrtf(fmaxf(var, 0.f) + EPS);
        float y0 = (acc[o].x - mean) * rs * ng.x + nb.x, y1 = (acc[o].y - mean) * rs * ng.y + nb.y; y0 = y0 * sigmoidf_(y0); y1 = y1 * sigmoidf_(y1);
        *(unsigned*)(Y + (size_t)o * YW) = pk2(y0, y1); }
    __syncthreads();
}
template <int W> __device__ __forceinline__ void pool_window(const f32x2 (&f)[47], const f32x2 (&pre)[48], int s_first, LAS unsigned char* pa) {
#pragma unroll
    for (int o = 0; o < 32; ++o) { const f32x2 s = pre[o + 16] - pre[o + 16 - W];
        const int pos = s_first + o; const float inv = 1.0f / (float)(pos + 1 < W ? pos + 1 : W);
        const f32x2 p = s * inv - f[o + 15];
        *(LAS unsigned*)(pa + o * 1040) = pk2(p.x, p.y); }
}
__device__ __forceinline__ void pool_unit(Frame& F, int l, int u) {
    const int t0 = 64 * u, s0 = t0 & (SEQ - 1);
    const bf16_t* ZP = WSP(bf16_t, WS_ZP);
    LAS unsigned char* pA = F.lds;
    const int cp = F.tid & 255, half = F.tid >> 8, first = t0 + 32 * half;
    f32x2 f[47]; unsigned pvr[47];
#pragma unroll
    for (int i = 0; i < 47; ++i) { const int pos = s0 + 32 * half - 15 + i; const int rr = pos >= 0 ? first - 15 + i : t0 - s0;
        pvr[i] = *(const unsigned*)(ZP + (size_t)rr * ZPW + ZP_ZA + 2 * cp); }
    __builtin_amdgcn_sched_barrier(0);
#pragma unroll
    for (int i = 0; i < 47; ++i) { const int pos = s0 + 32 * half - 15 + i; const unsigned pv = pos >= 0 ? pvr[i] : 0u; f[i] = (f32x2){bflo(pv), bfhi(pv)}; }
    LAS unsigned char* pa = pA + (32 * half) * 1040 + cp * 4;
    const int g = (F.wave & 3);
    f32x2 pre[48]; pre[0] = (f32x2){0.f, 0.f};
#pragma unroll
    for (int i = 0; i < 47; ++i) pre[i + 1] = pre[i] + f[i];
    if (g == 0) pool_window<2>(f, pre, s0 + 32 * half, pa); else if (g == 1) pool_window<4>(f, pre, s0 + 32 * half, pa); else if (g == 2) pool_window<8>(f, pre, s0 + 32 * half, pa); else pool_window<16>(f, pre, s0 + 32 * half, pa);
    __syncthreads();
    const int gg = F.wave >> 1, dh = F.wave & 1, r = F.lane & 31, h = F.lane >> 5;
    const bf16_t* WPT = WSP(bf16_t, WS_SMALLW + l * SW_LAYER + SW_WPT) + (size_t)gg * 128 * 128;
    f32x16 acc[2][2];
#pragma unroll
    for (int mi = 0; mi < 2; ++mi)
#pragma unroll
        for (int ni = 0; ni < 2; ++ni)
#pragma unroll
            for (int q = 0; q < 16; ++q) acc[mi][ni][q] = 0.f;
    bf16x8 bw[8][2];
#pragma unroll
    for (int s = 0; s < 8; ++s)
#pragma unroll
        for (int ni = 0; ni < 2; ++ni) bw[s][ni] = *(const bf16x8*)(WPT + (size_t)(64 * dh + 32 * ni + r) * 128 + 16 * s + 8 * h);
#pragma unroll
    for (int s = 0; s < 8; ++s) { bf16x8 a[2];
#pragma unroll
        for (int mi = 0; mi < 2; ++mi) a[mi] = *(const LAS bf16x8*)(pA + (32 * mi + r) * 1040 + (128 * gg + 16 * s + 8 * h) * 2);
#pragma unroll
        for (int mi = 0; mi < 2; ++mi)
#pragma unroll
            for (int ni = 0; ni < 2; ++ni) acc[mi][ni] = __builtin_amdgcn_mfma_f32_32x32x16_bf16(bw[s][ni], a[mi], acc[mi][ni], 0, 0, 0); }
    bf16_t* Y = WSP(bf16_t, WS_Y); const float* psc = kin(6);
#pragma unroll
    for (int ni = 0; ni < 2; ++ni)
#pragma unroll
        for (int g = 0; g < 4; ++g) { const int d = 128 * gg + 64 * dh + 32 * ni + 8 * g + 4 * h; const f32x4 sc = *(const f32x4*)(psc + l * 512 + d);
#pragma unroll
            for (int mi = 0; mi < 2; ++mi) { u32x2 o; o.x = pk2(acc[mi][ni][4 * g + 0] * sc[0], acc[mi][ni][4 * g + 1] * sc[1]); o.y = pk2(acc[mi][ni][4 * g + 2] * sc[2], acc[mi][ni][4 * g + 3] * sc[3]);
                *(u32x2*)(Y + (size_t)(t0 + 32 * mi + r) * YW + d) = o; } }
    __syncthreads();
}
__device__ __forceinline__ void sgu_unit(Frame& F, int l, int u) {
    const int chunk = u >> 1, hp = u & 1, t0 = 128 * chunk;
    const bf16_t* ZP = WSP(bf16_t, WS_ZP);
    LAS unsigned char* vT = F.lds;
    {
        const float* lng = kin(11) + l * 512 + 8 * F.lane; const float* lnb = kin(12) + l * 512 + 8 * F.lane;
        const f32x4 g0 = *(const f32x4*)lng, g1 = *(const f32x4*)(lng + 4);
        const f32x4 b0 = *(const f32x4*)lnb, b1 = *(const f32x4*)(lnb + 4);
        u32x4 pvv[16];
#pragma unroll
        for (int i = 0; i < 16; ++i) pvv[i] = *(const u32x4*)(ZP + (size_t)(t0 + 16 * F.wave + i) * ZPW + ZP_ZV + 8 * F.lane);
        float st[32];
#pragma unroll
        for (int i = 0; i < 16; ++i) { const u32x4 pv = pvv[i]; const float x0 = bflo(pv.x), x1 = bfhi(pv.x), x2 = bflo(pv.y), x3 = bfhi(pv.y), x4 = bflo(pv.z), x5 = bfhi(pv.z), x6 = bflo(pv.w), x7 = bfhi(pv.w);
            st[i] = ((x0 + x1) + (x2 + x3)) + ((x4 + x5) + (x6 + x7)); st[16 + i] = ((x0 * x0 + x1 * x1) + (x2 * x2 + x3 * x3)) + ((x4 * x4 + x5 * x5) + (x6 * x6 + x7 * x7)); }
        const float tot = reduce_scatter32(st, F.lane);
        LAS float* wst = (LAS float*)(F.lds + LDS_TAB) + 32 * F.wave;
        if ((F.lane & 1) == 0) wst[F.lane >> 1] = tot;
        LDS_WAIT(); asm volatile("" ::: "memory");
        if ((F.lane >> 5) == hp) { const int cl = 8 * (F.lane & 31);
            float mu[16], rsd[16];
#pragma unroll
            for (int i = 0; i < 16; ++i) { const float mean = wst[i] * (1.0f / 512.0f), var = wst[16 + i] * (1.0f / 512.0f) - mean * mean; mu[i] = mean; rsd[i] = 1.0f / sqrtf(fmaxf(var, 0.f) + EPS); }
#pragma unroll
            for (int j = 0; j < 8; ++j) { const float gg = j < 4 ? g0[j & 3] : g1[j & 3], bb = j < 4 ? b0[j & 3] : b1[j & 3]; unsigned w[8];
#pragma unroll
                for (int i2 = 0; i2 < 8; ++i2) { const unsigned pa = pvv[2 * i2][j >> 1], pb = pvv[2 * i2 + 1][j >> 1];
                    const float xa = (j & 1) ? bfhi(pa) : bflo(pa), xb = (j & 1) ? bfhi(pb) : bflo(pb);
                    w[i2] = pk2((xa - mu[2 * i2]) * rsd[2 * i2] * gg + bb, (xb - mu[2 * i2 + 1]) * rsd[2 * i2 + 1] * gg + bb); }
                LAS unsigned char* dst = vT + (cl + j) * 272 + (16 * F.wave) * 2;
                *(LAS u32x4*)dst = (u32x4){w[0], w[1], w[2], w[3]}; *(LAS u32x4*)(dst + 16) = (u32x4){w[4], w[5], w[6], w[7]}; }
        }
    }
    const int hl = F.wave >> 2, ti = F.wave & 3, hh = 2 * hp + hl, r = F.lane & 31, h = F.lane >> 5;
    const bf16_t* WS_ = WSP(bf16_t, WS_SMALLW + l * SW_LAYER + SW_WSGU) + (size_t)hh * 128 * 128;
    bf16x8 af[8];
#pragma unroll
    for (int k = 0; k < 8; ++k) if (k < 2 * (ti + 1)) af[k] = *(const bf16x8*)(WS_ + (size_t)(32 * ti + r) * 128 + 16 * k + 8 * h);
    __syncthreads();
    f32x16 acc[4];
#pragma unroll
    for (int ci = 0; ci < 4; ++ci)
#pragma unroll
        for (int q = 0; q < 16; ++q) acc[ci][q] = 0.f;
#pragma unroll
    for (int k = 0; k < 8; ++k) if (k < 2 * (ti + 1)) {
#pragma unroll
        for (int ci = 0; ci < 4; ++ci) { const bf16x8 b = *(const LAS bf16x8*)(vT + (128 * hl + 32 * ci + r) * 272 + (16 * k + 8 * h) * 2);
            acc[ci] = __builtin_amdgcn_mfma_f32_32x32x16_bf16(b, af[k], acc[ci], 0, 0, 0); }
    }
    bf16_t* Y = WSP(bf16_t, WS_Y);
    { const int tl = 32 * ti + r; const float sb = kin(14)[((size_t)l * 4 + hh) * 128 + tl];
      const bf16_t* zr = ZP + (size_t)(t0 + tl) * ZPW + ZP_ZU + 128 * hh + 4 * h; bf16_t* yr = Y + (size_t)(t0 + tl) * YW + 1024 + 128 * hh + 4 * h;
      u32x2 zu[4][4];
#pragma unroll
      for (int ci = 0; ci < 4; ++ci)
#pragma unroll
          for (int g = 0; g < 4; ++g) zu[ci][g] = *(const u32x2*)(zr + 32 * ci + 8 * g);
#pragma unroll
      for (int ci = 0; ci < 4; ++ci)
#pragma unroll
          for (int g = 0; g < 4; ++g) { const u32x2 z = zu[ci][g]; u32x2 o;
              o.x = pk2(bflo(z.x) * (acc[ci][4 * g + 0] + sb), bfhi(z.x) * (acc[ci][4 * g + 1] + sb)); o.y = pk2(bflo(z.y) * (acc[ci][4 * g + 2] + sb), bfhi(z.y) * (acc[ci][4 * g + 3] + sb));
              *(u32x2*)(yr + 32 * ci + 8 * g) = o; } }
    __syncthreads();
}
#ifndef MIX_DUP
#define MIX_DUP 0
#endif
__device__ __forceinline__ void phase_mix(Frame& F, int l) {
    for (int rep = 0; rep < ((MIX_DUP & 1) ? 2 : 1); ++rep) for (int u = F.vcu; u < 256; u += F.G) sgu_unit(F, l, u);
    for (int rep = 0; rep < ((MIX_DUP & 2) ? 2 : 1); ++rep) for (int u = F.vcu; u < 256; u += F.G) conv_unit(F, l, u);
    for (int rep = 0; rep < ((MIX_DUP & 4) ? 2 : 1); ++rep) for (int u = F.vcu; u < 256; u += F.G) pool_unit(F, l, u);
}

__device__ __forceinline__ void phase_router(Frame& F, int l, const bf16_t* x, const rs_t* rs) {
    LAS float* P = (LAS float*)F.lds;
    LAS int* hist = (LAS int*)(F.lds + LDS_TAB);
    const bf16_t* WH = WSP(bf16_t, WS_SMALLW + l * SW_LAYER + SW_WRT); const bf16_t* WL = WH + 32768;
    float* TW = WSP(float, WS_TOPW); int* TOKL = WSP(int, WS_TOKL); int* SO = WSP(int, WS_SLOTOF);
    unsigned* gcnt = (unsigned*)(F.ws + WS_CTL) + CW_GCNT + 32 * l;
    const float* rbias = kin(20) + l * NE;
    if (F.tid < 32) hist[F.tid] = 0;
    const int rb = F.wave & 1, kq = F.wave >> 1, r = F.lane & 31, h = F.lane >> 5;
    for (int blk = F.vcu; blk < 256; blk += F.G) {
        const bf16_t* xr = x + (size_t)(64 * blk + 32 * rb + r) * D + 256 * kq + 8 * h;
        const bf16_t* whp = WH + (size_t)r * D + 256 * kq + 8 * h; const bf16_t* wlp = WL + (size_t)r * D + 256 * kq + 8 * h;
        bf16x8 xa[16];
#pragma unroll
        for (int s2 = 0; s2 < 16; ++s2) xa[s2] = *(const bf16x8*)(xr + 16 * s2);
        f32x16 acc;
#pragma unroll
        for (int q = 0; q < 16; ++q) acc[q] = 0.f;
#pragma unroll
        for (int sb = 0; sb < 4; ++sb) { bf16x8 ha[4], la[4];
#pragma unroll
            for (int s2 = 0; s2 < 4; ++s2) { ha[s2] = *(const bf16x8*)(whp + 16 * (4 * sb + s2)); la[s2] = *(const bf16x8*)(wlp + 16 * (4 * sb + s2)); }
#pragma unroll
            for (int s2 = 0; s2 < 4; ++s2) { acc = __builtin_amdgcn_mfma_f32_32x32x16_bf16(xa[4 * sb + s2], ha[s2], acc, 0, 0, 0); acc = __builtin_amdgcn_mfma_f32_32x32x16_bf16(xa[4 * sb + s2], la[s2], acc, 0, 0, 0); } }
#pragma unroll
        for (int q = 0; q < 16; ++q) P[(kq * 64 + 32 * rb + (q & 3) + 8 * (q >> 2) + 4 * h) * 33 + r] = acc[q];
        __syncthreads();
        if (F.lane < 8) {
            const int rl = 8 * F.wave + F.lane, row = 64 * blk + rl; const float rstd = rstd_of(rs[row]);
            float v0 = -3.0e38f, v1 = -3.0e38f, v2 = -3.0e38f, v3 = -3.0e38f; int i0 = 0, i1 = 0, i2 = 0, i3 = 0;
#pragma unroll
            for (int e = 0; e < 32; ++e) { const float v = ((P[(0 * 64 + rl) * 33 + e] + P[(1 * 64 + rl) * 33 + e]) + (P[(2 * 64 + rl) * 33 + e] + P[(3 * 64 + rl) * 33 + e])) * rstd + rbias[e];
                const bool c0 = v > v0, c1 = v > v1, c2 = v > v2, c3 = v > v3;
                v3 = c2 ? v2 : (c3 ? v : v3); i3 = c2 ? i2 : (c3 ? e : i3);
                v2 = c1 ? v1 : (c2 ? v : v2); i2 = c1 ? i1 : (c2 ? e : i2);
                v1 = c0 ? v0 : (c1 ? v : v1); i1 = c0 ? i0 : (c1 ? e : i1);
                v0 = c0 ? v : v0;             i0 = c0 ? e : i0; }
            const f32x4 tw = (f32x4){1.0f, __expf(v1 - v0), __expf(v2 - v0), __expf(v3 - v0)};
            *(f32x4*)(TW + row * 4) = tw;
            const int ie[4] = {i0, i1, i2, i3};
#pragma unroll
            for (int k = 0; k < 4; ++k) { const int rk = __hip_atomic_fetch_add((int*)(hist + ie[k]), 1, __ATOMIC_RELAXED, __HIP_MEMORY_SCOPE_WORKGROUP);
                hist[64 + rl * 4 + k] = ie[k] | (rk << 8); }
        }
        __syncthreads();
        if (F.tid < 32) { hist[32 + F.tid] = (int)__hip_atomic_fetch_add(gcnt + F.tid, (unsigned)hist[F.tid], __ATOMIC_RELAXED, __HIP_MEMORY_SCOPE_AGENT); hist[F.tid] = 0; }
        __syncthreads();
        if (F.tid < 256) { const int pk = hist[64 + F.tid], e = pk & 255, pos = hist[32 + e] + (pk >> 8), tok = 64 * blk + (F.tid >> 2);
            TOKL[e * T + pos] = tok; SO[tok * 4 + (F.tid & 3)] = e | (pos << 5); }
        __syncthreads();
    }
}
__device__ __forceinline__ void moe_tables(Frame& F, int l, bool split_tail = false) {
    LAS int* tab = (LAS int*)(F.lds + LDS_TAB);
    const unsigned* gcnt = (const unsigned*)(F.ws + WS_CTL) + CW_GCNT + 32 * l;
    if (F.tid < 64) { const int e = F.lane & 31; const int c = (int)gcnt[e]; const int pt = (c + 255) >> 8; int incl = pt;
#pragma unroll
        for (int o = 1; o < 32; o <<= 1) { const int v = __shfl_up(incl, o, 32); if (e >= o) incl += v; }
        if (F.lane < 32) { tab[MT_CNT + e] = c; tab[MT_TSTART + e] = incl - pt;
            if (e == 31) { tab[MT_NTILE] = incl;
                const int nu = incl * 4, nf = (nu / F.G) * F.G, rem = nu - nf; const int sp = (!split_tail || rem == 0) ? 1 : (rem * 4 <= F.G ? 4 : (rem * 2 <= F.G ? 2 : 1));
                tab[MT_SPLIT] = sp; tab[MT_NFULL] = nf; tab[MT_TAILROW] = (nf / 4) * 256; } } }
    __syncthreads();
    if (F.tid <= MAXTILES) { int e = 0;
#pragma unroll
        for (int q = 0; q < 31; ++q) e += (int)(((unsigned)(F.tid - tab[MT_TSTART + q + 1])) >> 31) ^ 1;
        tab[MT_TE + F.tid] = e; }
    __syncthreads();
}
__device__ __forceinline__ void phase_combine(Frame& F, int l, const bf16_t* xin, bf16_t* xout, rs_t* rsout) {
    moe_tables(F, l, SPLITK_TAIL && l == NL - 1);
    const int gw = F.vcu * 8 + F.wave, NGW = F.G * 8;
    const int* SO = WSP(int, WS_SLOTOF); const float* TW = WSP(float, WS_TOPW); const bf16_t* YE = WSP(bf16_t, WS_YE);
    const LAS int* tab = (const LAS int*)(F.lds + LDS_TAB); const int sp = tab[MT_SPLIT], trow = tab[MT_TAILROW]; const bf16_t* YEX = WSP(bf16_t, WS_YEX);
    for (int m = gw; m < T; m += NGW) {
        u32x2 p[4]; f32x4 v[4]; row_load_bf(xin + (size_t)m * D, F.lane, p);
        const f32x4 tw = *(const f32x4*)(TW + m * 4); const float twi = 1.0f / ((tw[0] + tw[1]) + (tw[2] + tw[3]));
        u32x2 y[4][4]; int slots[4];
#pragma unroll
        for (int k = 0; k < 4; ++k) { const int pk = SO[m * 4 + k]; slots[k] = tab[MT_TSTART + (pk & 31)] * 256 + (pk >> 5); row_load_bf(YE + (size_t)slots[k] * D, F.lane, y[k]); }
        row_unpack(p, v);
        if (sp > 1) {
#pragma unroll
            for (int k = 0; k < 4; ++k) if (slots[k] >= trow) { const float w = tw[k] * twi;
                for (int q = 1; q < sp; ++q) { u32x2 z[4]; row_load_bf(YEX + ((size_t)(q - 1) * YEX_ROWS + (size_t)(slots[k] - trow)) * D, F.lane, z);
#pragma unroll
                    for (int j = 0; j < 4; ++j) { v[j][0] += w * bflo(z[j].x); v[j][1] += w * bfhi(z[j].x); v[j][2] += w * bflo(z[j].y); v[j][3] += w * bfhi(z[j].y); } } } }
#pragma unroll
        for (int k = 0; k < 4; ++k) { const float w = tw[k] * twi;
#pragma unroll
            for (int j = 0; j < 4; ++j) { v[j][0] += w * bflo(y[k][j].x); v[j][1] += w * bfhi(y[k][j].x); v[j][2] += w * bflo(y[k][j].y); v[j][3] += w * bfhi(y[k][j].y); } }
        const float ss = row_sumsq(v); row_store_bf16(xout + (size_t)m * D, F.lane, v, 1.0f); if (F.lane == 0) rsout[m] = rs_fix(ss);
    }
}

__device__ __forceinline__ void idle_set(int n_units, int G, int c, int& j, int& n) {
    const int rem = n_units % G; if (rem == 0 || G - rem < 32) { j = c; n = G; } else { j = c - rem; n = G - rem; }
}
constexpr int PH_PER_LAYER = 9, N_PHASES = 1 + NL * PH_PER_LAYER + 1;
__global__ void __launch_bounds__(512, 2) mega_fwd(Args args) {
    extern __shared__ __attribute__((aligned(16))) unsigned char lds_raw[];
    Frame F;
    F.lds = (LAS unsigned char*)lds_raw; F.tid = threadIdx.x; F.lane = F.tid & 63; F.wave = __builtin_amdgcn_readfirstlane(F.tid >> 6);
    F.G = gridDim.x; { const int bx = blockIdx.x; F.vcu = (F.G % 8 == 0) ? (bx % 8) * (F.G / 8) + bx / 8 : bx; }
    F.out = args.out; F.ws = args.ws;
    volatile LAS unsigned* MISC = (volatile LAS unsigned*)(F.lds + LDS_MISC);
    if (F.tid < 64) MISC[F.tid] = 0u;
    __syncthreads();
    XcdBarrier bar; bar.bar = (unsigned*)(F.ws + WS_CTL) + CW_BAR; bar.x = 0; bar.st = nullptr;
    const int lo = args.ph_lo, hi = args.ph_hi;
    if (hi - lo > 1 && !args.use_cg) bar = xcd_barrier_post((unsigned*)(F.ws + WS_CTL) + CW_BAR, MISC + 8);
#ifndef BAR_DUP
#define BAR_DUP 0
#endif
#define SEAM(ph) do { if ((ph) + 1 < hi) { if (args.use_cg) cg::this_grid().sync(); else { xcd_barrier(bar); if (BAR_DUP) xcd_barrier(bar); } } } while (0)
#ifndef PH_MASK
#define PH_MASK 0xffff
#endif
#define PHT(k) ((k) == 0 ? 11 : (k) == N_PHASES - 1 ? 12 : ((k) - 1) % PH_PER_LAYER)
#define IN(k) (((PH_MASK >> PHT(k)) & 1) && lo <= (k) && (k) < hi)
#ifndef KDUP_MASK
#define KDUP_MASK 0
#endif
#ifndef SPLIT_GC
#define SPLIT_GC 160
#endif
#ifndef DUP_MASK
#define DUP_MASK 0
#endif
#define REPEAT(k) for (int rep_ = 0, nrep_ = (((DUP_MASK >> PHT(k)) & 1) ? 2 : 1); rep_ < nrep_; ++rep_, (rep_ < nrep_ ? xcd_barrier(bar) : (void)0))
    if (IN(0)) { REPEAT(0) { F.refresh(); phase_weights(F); } SEAM(0); }
    bf16_t* const X0 = WSP(bf16_t, WS_X0); bf16_t* const X1 = WSP(bf16_t, WS_X1); bf16_t* const X2 = WSP(bf16_t, WS_X2);
    for (int l = 0; l < NL; ++l) {
        const int pb = 1 + l * PH_PER_LAYER;
        const unsigned char* sw = F.ws + WS_SMALLW + l * SW_LAYER;
        rs_t* const rs0 = WSP(rs_t, WS_RS) + (size_t)(3 * l) * T;
        if (IN(pb + 0)) { REPEAT(pb + 0) { F.refresh();
            const int gc = (l == 0 && F.G > SPLIT_GC) ? SPLIT_GC : F.G;
            if ((int)blockIdx.x < gc) {
                DenseOrder S{(const char*)X0, (const char*)(WSP(bf16_t, WS_WIN) + (size_t)l * NZ * D), 64, 22, gc, (int)blockIdx.x, (size_t)256 * D * 2, (size_t)256 * D * 2, (KDUP_MASK >> 0) & 1};
                { const float* bin = (const float*)(sw + SW_BIN);
                  rs_t rv[5]; float bq[5];
#pragma unroll
                  for (int i = 0; i < 5; ++i) { const int q = F.tid + 512 * i; Unit uu; const bool in = (q < MAX_UNITS_PER_WG * 256) && S.next(q >> 8, uu);
                      rv[i] = rs0[in ? uu.pm * 256 + (q & 255) : 0]; bq[i] = bin[in ? uu.pn * 256 + (q & 255) : 0]; }
#pragma unroll
                  for (int i = 0; i < 5; ++i) { const int q = F.tid + 512 * i; if (q < MAX_UNITS_PER_WG * 256) { ((LAS float*)(F.lds + LDS_RST))[q] = rstd_of(rv[i]); ((LAS float*)(F.lds + LDS_BIAS))[q] = bq[i]; } } }
                __syncthreads();
                EpiIn E{WSP(bf16_t, WS_ZP), (const LAS float*)(F.lds + LDS_RST), (const LAS float*)(F.lds + LDS_BIAS)};
                pg8::gemm_phase(F.lds, D, D, D, S, E);
                if (l == 0 && gc == F.G) { F.refresh(); phase_convert_rest(F, 0); }
                if (l == 1 && TAIL_L1A > 0) { int j, n; idle_set(64 * 22, F.G, (int)blockIdx.x, j, n); if (j >= 0) { F.refresh(); conv_tail(F, j, n, 32 * I_UP, TAIL_L1A); } }
            } else phase_convert_rest(F, gc); } SEAM(pb + 0); }
        if (IN(pb + 1)) { REPEAT(pb + 1) { F.refresh(); phase_mix(F, l); } SEAM(pb + 1); }
        if (IN(pb + 2)) { REPEAT(pb + 2) { F.refresh();
            BranchOrder S{(const char*)WSP(bf16_t, WS_Y), (const char*)(WSP(bf16_t, WS_WBR) + (size_t)l * 3 * D * 512), F.G, (int)blockIdx.x};
            EpiBranch E{WSP(bf16_t, WS_ZP), kin(16) + (size_t)l * 3 * D, WSP(bf16_t, WS_MG)};
            pg8::gemm_phase(F.lds, 512, YW, 512, S, E); } SEAM(pb + 2); }
        if (IN(pb + 3)) { F.refresh();
            DenseOrder S{(const char*)WSP(bf16_t, WS_MG), (const char*)(WSP(bf16_t, WS_WOUT) + (size_t)l * D * D), 64, 4, F.G, (int)blockIdx.x, (size_t)256 * D * 2, (size_t)256 * D * 2, 0};
            EpiRes E{X0, X1, rs0 + T};
            pg8::gemm_phase(F.lds, D, D, D, S, E); SEAM(pb + 3); }
        if (IN(pb + 4)) { F.refresh(); phase_router(F, l, X1, rs0 + T); SEAM(pb + 4); }
        if (IN(pb + 5)) { REPEAT(pb + 5) { F.refresh();
            moe_tables(F, l);
            LAS int* tab = (LAS int*)(F.lds + LDS_TAB); const int ntile = tab[MT_NTILE]; const int* TOKL = WSP(int, WS_TOKL);
            { int tk[5]; bool ok[5]; float bq[5]; rs_t rv[5]; const float* bup = (const float*)(sw + SW_BUP); const rs_t* rsx = rs0 + T;
#pragma unroll
              for (int i = 0; i < 5; ++i) { const int q = F.tid + 512 * i, ui = q >> 8, r = q & 255, L = ui * F.G + F.vcu; const bool in = (q < MAX_UNITS_PER_WG * 256) && (L < ntile * 8);
                  const int tile = in ? (L >> 3) : 0, e = tab[MT_TE + tile], lr = (tile - tab[MT_TSTART + e]) * 256 + r; ok[i] = in && lr < tab[MT_CNT + e];
                  tk[i] = TOKL[e * T + (ok[i] ? lr : 0)]; bq[i] = bup[e * 2048 + (in ? (L & 7) : 0) * 256 + r]; }
#pragma unroll
              for (int i = 0; i < 5; ++i) rv[i] = rsx[ok[i] ? tk[i] : 0];
#pragma unroll
              for (int i = 0; i < 5; ++i) { const int q = F.tid + 512 * i; if (q < MAX_UNITS_PER_WG * 256) { ((LAS unsigned*)tab)[MT_TOKOFF + q] = ok[i] ? (unsigned)tk[i] * (unsigned)(D * 2) : 0u;
                  ((LAS float*)(F.lds + LDS_RST))[q] = rstd_of(rv[i]); ((LAS float*)(F.lds + LDS_BIAS))[q] = bq[i]; } } }
            __syncthreads();
            MoeOrder S{(const char*)X1, (const char*)(WSP(bf16_t, WS_WUP) + (size_t)l * NE * 2048 * D), tab + MT_TE, ntile * 8, 8, F.G, F.vcu, (size_t)2048 * D * 2, (size_t)256 * D * 2, 0, ntile * 8, 1};
            EpiUp E{WSP(bf16_t, WS_ACT), (const LAS float*)(F.lds + LDS_RST), (const LAS float*)(F.lds + LDS_BIAS)};
            pg8::gemm_phase<EpiUp, MoeOrder, true>(F.lds, D, D, D, S, E, (const LAS unsigned*)tab + MT_TOKOFF);
            { int j, n; idle_set(ntile * 8, F.G, F.vcu, j, n); F.refresh();
              DenseOrder S6{(const char*)(WSP(bf16_t, WS_PB) + (size_t)l * T * PLE), (const char*)(WSP(bf16_t, WS_WPP) + (size_t)l * D * PLE), 64, 4, n, j < 0 ? 256 : j, (size_t)256 * PLE * 2, (size_t)256 * PLE * 2, 0};
              EpiBf E6{WSP(bf16_t, WS_PP), nullptr, nullptr, 0};
              pg8::gemm_phase(F.lds, PLE, PLE, PLE, S6, E6);
              if (l == 0 && TAIL_XF4 > 0 && j >= 0) { F.refresh(); conv_tail(F, j, n, TAIL_XF, TAIL_XF4); }
              if (l == 1 && TAIL_L1B > 0 && j >= 0) { F.refresh(); conv_tail(F, j, n, 32 * I_UP + TAIL_L1A, TAIL_L1B); } } } SEAM(pb + 5); }
        if (IN(pb + 6)) { REPEAT(pb + 6) { F.refresh();
            moe_tables(F, l, SPLITK_TAIL && l == NL - 1);
            LAS int* tab = (LAS int*)(F.lds + LDS_TAB); const int ntile = tab[MT_NTILE];
            MoeOrder S{(const char*)WSP(bf16_t, WS_ACT), (const char*)(WSP(bf16_t, WS_WDN) + (size_t)l * NE * D * D), tab + MT_TE, ntile * 4, 4, F.G, F.vcu, (size_t)D * D * 2, (size_t)256 * D * 2, (size_t)256 * D * 2, tab[MT_NFULL], tab[MT_SPLIT]};
            EpiBf E{WSP(bf16_t, WS_YE), kin(24) + (size_t)l * NE * D, WSP(bf16_t, WS_YEX), tab[MT_TAILROW]};
            pg8::gemm_phase(F.lds, D, D, D, S, E);
            if (l == 0 && TAIL_XF > 0) { int j, n; idle_set(ntile * 4, F.G, F.vcu, j, n); if (j >= 0) { F.refresh(); conv_tail(F, j, n, 0, TAIL_XF); } } } SEAM(pb + 6); }
        if (IN(pb + 7)) { REPEAT(pb + 7) { F.refresh(); phase_combine(F, l, X1, X2, rs0 + 2 * T); } SEAM(pb + 7); }
        if (IN(pb + 8)) { F.refresh();
            DenseOrder S{(const char*)X2, (const char*)(WSP(bf16_t, WS_WPG) + (size_t)l * D * D), 64, 4, F.G, (int)blockIdx.x, (size_t)256 * D * 2, (size_t)256 * D * 2, 0};
            EpiPle E{X2, X0, WSP(bf16_t, WS_PP), rs0 + 2 * T, rs0 + 3 * T};
            pg8::gemm_phase(F.lds, D, D, D, S, E); SEAM(pb + 8); }
    }
    if (IN(N_PHASES - 1)) { F.refresh(); phase_final(F, X0, WSP(rs_t, WS_RS) + (size_t)(3 * NL) * T, F.out, kin(28)); }
#undef REPEAT
#undef IN
#undef SEAM
}

extern "C" void kernel_launch(void* const* d_in, const int* in_sizes, int n_in, void* d_out, int out_size, void* d_ws, size_t ws_size, hipStream_t stream) {
    static int grid = 0;
    if (grid == 0) {
        if (n_in != 29 || out_size != T * D || ws_size < WS_END) { fprintf(stderr, "kernel_launch: unexpected shapes (n_in %d out %d ws %zu)\n", n_in, out_size, ws_size); grid = -1; return; }
        int dev = 0, cus = 0, per_cu = 0;
        hipGetDevice(&dev); hipDeviceGetAttribute(&cus, hipDeviceAttributeMultiprocessorCount, dev);
        if (hipFuncSetAttribute((const void*)mega_fwd, hipFuncAttributeMaxDynamicSharedMemorySize, LDS_BYTES) != hipSuccess) { fprintf(stderr, "kernel_launch: hipFuncSetAttribute failed\n"); grid = -1; return; }
        if (hipOccupancyMaxActiveBlocksPerMultiprocessor(&per_cu, (const void*)mega_fwd, 512, LDS_BYTES) != hipSuccess || per_cu < 1) { fprintf(stderr, "kernel_launch: occupancy query says %d\n", per_cu); per_cu = 1; }
        (void)hipGetLastError();
        grid = cus;
    }
    if (grid < 0) return;
    hipMemsetAsync((char*)d_ws + WS_CTL, 0, CTL_ZERO_BYTES, stream);
    Args a{};
    for (int i = 0; i < 29; ++i) a.in[i] = (const float*)d_in[i];
    a.out = (float*)d_out; a.ws = (unsigned char*)d_ws;
#if MK_N_LAUNCHES == 1
    a.ph_lo = 0; a.ph_hi = N_PHASES; a.use_cg = 0;
    void* kargs[] = {&a};
    hipError_t e = hipLaunchCooperativeKernel((const void*)mega_fwd, dim3(grid), dim3(512), kargs, LDS_BYTES, stream);
    if (e != hipSuccess) fprintf(stderr, "cooperative launch failed: %s (grid %d)\n", hipGetErrorString(e), grid);
#else
    for (int ph = 0; ph < N_PHASES; ++ph) { a.ph_lo = ph; a.ph_hi = ph + 1; a.use_cg = 0;
        hipLaunchKernelGGL(mega_fwd, dim3(grid), dim3(512), LDS_BYTES, stream, a); }
#endif
}
```

```cpp
#include <hip/hip_runtime.h>
#include <hip/hip_cooperative_groups.h>
#include <cstdio>
#include <cstdint>
namespace cg = cooperative_groups;

#ifndef MK_N_LAUNCHES
#define MK_N_LAUNCHES 1
#endif

#define LAS __attribute__((address_space(3)))
#define GAS __attribute__((address_space(1)))
typedef unsigned short bf16_t;
typedef short bf16x8 __attribute__((ext_vector_type(8)));
typedef float f32x4 __attribute__((ext_vector_type(4)));
typedef float f32x16 __attribute__((ext_vector_type(16)));
typedef float f32x2 __attribute__((ext_vector_type(2)));
typedef unsigned u32x4 __attribute__((ext_vector_type(4)));
typedef unsigned u32x2 __attribute__((ext_vector_type(2)));

#ifndef SPLITK_TAIL
#define SPLITK_TAIL 1
#endif
constexpr int T = 16384, D = 1024, SEQ = 8192, NL = 2;
constexpr int NZ = 5632;
constexpr int ZPW = 5120;
constexpr int ZP_ZA = 0, ZP_GLU = 512, ZP_ZU = 1024, ZP_ZV = 1536, ZP_G = 2048;
constexpr int YW = 1536;
constexpr int NE = 32, TOPK = 4, PLE = 256, CONVK = 31;
constexpr int MAXTILES = 288, MAXROWS = MAXTILES * 256;
constexpr float EPS = 1e-6f;

constexpr size_t MiB = 1u << 20;
constexpr size_t WS_CTL = 0;
constexpr size_t WS_META = 1 * MiB;
constexpr size_t WS_TOPE = 2 * MiB;
constexpr size_t WS_TOPW = 3 * MiB;
constexpr size_t WS_SLOTOF = 4 * MiB;
constexpr size_t WS_SMALLW = 5 * MiB;
constexpr size_t SW_LAYER = 1 * MiB, SW_WPT = 0, SW_WSGU = 128 * 1024, SW_WRT = 256 * 1024, SW_BIN = 384 * 1024, SW_BUP = 512 * 1024;
constexpr size_t WS_WIN = 8 * MiB;
constexpr size_t WS_WBR = 32 * MiB;
constexpr size_t WS_WOUT = 40 * MiB;
constexpr size_t WS_WPG = 44 * MiB;
constexpr size_t WS_WPP = 48 * MiB;
constexpr size_t WS_PB = 50 * MiB;
constexpr size_t WS_WUP = 72 * MiB;
constexpr size_t WS_WDN = 328 * MiB;
constexpr size_t WS_XN = 456 * MiB;
constexpr size_t WS_ZP = 488 * MiB;
constexpr size_t WS_Y = 648 * MiB;
constexpr size_t WS_MG = 696 * MiB;
constexpr size_t WS_XG = 728 * MiB;
constexpr size_t WS_ACT = 872 * MiB;
constexpr size_t WS_YE = 1016 * MiB;
constexpr size_t WS_PP = 1160 * MiB;
constexpr size_t WS_YEX = 1192 * MiB;
constexpr size_t WS_END = 1288 * MiB;
constexpr size_t CTL_ZERO_BYTES = 32768;
constexpr int CW_BAR = 4096;
constexpr int CW_GCNT = 128;
constexpr size_t WS_TOKL = WS_XG;
constexpr size_t WS_X0 = WS_XN, WS_X1 = WS_XG + 16 * MiB, WS_X2 = WS_XG + 48 * MiB;
constexpr size_t WS_RS = WS_TOPE;

constexpr int RING_BYTES = 131072;
constexpr int LDS_TAB = RING_BYTES;
constexpr int LDS_RST = RING_BYTES + 11264;
constexpr int LDS_BIAS = LDS_RST + 9216;
constexpr int LDS_MISC = LDS_BIAS + 9216;
constexpr int LDS_BYTES = LDS_MISC + 256;
constexpr int MT_CNT = 0, MT_TSTART = 32, MT_NTILE = 96, MT_SPLIT = 97, MT_TAILROW = 98, MT_NFULL = 99, MT_TE = 128, MT_TOKOFF = 512, MAX_UNITS_PER_WG = 9;
constexpr int YEX_ROWS = 16384;

__device__ __forceinline__ unsigned f2bf(float f) { unsigned u = __builtin_bit_cast(unsigned, f); return (u + 0x7fffu + ((u >> 16) & 1u)) >> 16; }
__device__ __forceinline__ unsigned pk2(float lo, float hi) { unsigned r; asm("v_cvt_pk_bf16_f32 %0, %1, %2" : "=v"(r) : "v"(lo), "v"(hi)); return r; }
__device__ __forceinline__ float bflo(unsigned u) { return __builtin_bit_cast(float, u << 16); }
__device__ __forceinline__ float bfhi(unsigned u) { return __builtin_bit_cast(float, u & 0xffff0000u); }
typedef unsigned long long rs_t;
__device__ __forceinline__ rs_t rs_fix(float ss) { return (rs_t)(ss * 1048576.0f + 0.5f); }
__device__ __forceinline__ float rstd_of(rs_t q) { return __builtin_amdgcn_rsqf((float)q * (1.0f / (1048576.0f * 1024.0f)) + 1e-6f); }
__device__ __forceinline__ float sigmoidf_(float v) { return __builtin_amdgcn_rcpf(1.0f + __builtin_amdgcn_exp2f(-1.44269504089f * v)); }
__device__ __forceinline__ float sig_t(float t) { return __builtin_amdgcn_rcpf(1.0f + __builtin_amdgcn_exp2f(t)); }
__device__ __forceinline__ float wave_sum(float v) {
#pragma unroll
    for (int o = 1; o < 64; o <<= 1) v += __shfl_xor(v, o);
    return v;
}
#ifndef WT_STORES
#define WT_STORES 0
#endif
__device__ __forceinline__ void st16(void* p, u32x4 v) {
#if WT_STORES
    asm volatile("global_store_dwordx4 %0, %1, off sc1\n\ts_nop 1" :: "v"(p), "v"(v) : "memory");
#else
    *(u32x4*)p = v;
#endif
}
#define LDS_WAIT() asm volatile("s_waitcnt lgkmcnt(0)" ::: "memory")
#define VM_WAIT() asm volatile("s_waitcnt vmcnt(0)" ::: "memory")

namespace pg8 {
constexpr int BM = 256, BK = 64, HALF = 128, HTB = HALF * BK * 2, NXCD = 8, WGM = 8;
__host__ __device__ __forceinline__ int lds_byte(int r, int c) { const int st = (r >> 4) * 2 + (c >> 5), rr = r & 15, cc = c & 31, ob = rr * 64 + cc * 2; return st * 1024 + (ob ^ (((ob >> 9) & 1) << 5)); }
__host__ __device__ __forceinline__ void stage_rc(int b, int& R, int& C) { const int st = b / 1024, sb = b % 1024, swz = sb ^ (((sb >> 9) & 1) << 5); R = (st >> 1) * 16 + swz / 64; C = (st & 1) * 32 + (swz % 64) / 2; }
__host__ __device__ __forceinline__ int perm32(int rho) { const int n = rho >> 4, i = rho & 15; return 8 * (i >> 2) + 4 * n + (i & 3); }

struct Unit { const char* A; const char* B; int pm, pn, aux, ord, nt; };

__device__ __forceinline__ void static_tile(int L, int nM, int nN, int& pm, int& pn) {
    const int nwg = nM * nN; int wgid = L;
    { const int q = nwg / NXCD, r = nwg % NXCD, xcd = wgid % NXCD, off = wgid / NXCD; wgid = (xcd < r ? xcd * (q + 1) : r * (q + 1) + (xcd - r) * q) + off; }
    const int nig = WGM * nN, gid = wgid / nig, fm = gid * WGM, gsz = (nM - fm) < WGM ? (nM - fm) : WGM;
    pm = fm + ((wgid % nig) % gsz); pn = (wgid % nig) / gsz;
}

template <class Epi, class Sched, bool GATHER = false>
__device__ __forceinline__ void gemm_phase(LAS unsigned char* lds, const int K_, const int lda, const int ldb, const Sched& S, const Epi& E, const LAS unsigned* gtab = nullptr) {
    int K = K_; asm volatile("" : "+s"(K));
    int tid_ = threadIdx.x; asm volatile("" : "+v"(tid_));
    const int tid = tid_, wid = __builtin_amdgcn_readfirstlane(tid >> 6), lane = tid & 63, wr = wid >> 2, wc = wid & 3, fr = lane & 15, fq = lane >> 4;
    const int nt0 = K / BK;
    unsigned voffA[2], voffB[2], gR[2], gC[2], vC[2][2], vN[2][2], vs[2][2];
#pragma unroll
    for (int i = 0; i < 2; ++i) { int R, C; stage_rc(tid * 16 + i * 8192, R, C); const int Rb = Epi::PERM ? ((R & ~31) + perm32(R & 31)) : R;
        voffA[i] = (unsigned)(R * lda + C) * 2u; voffB[i] = (unsigned)(Rb * ldb + C) * 2u; gR[i] = (unsigned)R; gC[i] = (unsigned)C * 2u; }
#define PG8_GLOAD(dst, u) do { _Pragma("unroll") for (int _h = 0; _h < 2; ++_h) _Pragma("unroll") for (int _i = 0; _i < 2; ++_i) dst[_h][_i] = gtab[(u) * 256 + _h * 128 + gR[_i]] + gC[_i]; } while (0)
#define PG8_STAGE_A(bufoff, h, gbase, VO) do { if constexpr (GATHER) { PG8_STAGE(bufoff, gbase, VO[h]); } else { PG8_STAGE(bufoff, (gbase) + (h) * hstepA, voffA); } } while (0)
    const size_t kstep = (size_t)(BK * 2);
    const size_t hstepA = (size_t)HALF * lda * 2, hstepB = (size_t)HALF * ldb * 2;
    const unsigned ldsw = (unsigned)wid * 1024u;
    const int aoff = lds_byte(wr * 64 + fr, fq * 8), boff = lds_byte(wc * 32 + fr, fq * 8);
#define PG8_SA(b, h) (((b) * 2 + (h)) * HTB)
#define PG8_SB(b, h) ((4 + (b) * 2 + (h)) * HTB)
#define PG8_STAGE(bufoff, gbase, voff) do { _Pragma("unroll") for (int _i = 0; _i < 2; ++_i) \
        __builtin_amdgcn_global_load_lds((const unsigned*)((const char*)(gbase) + (voff)[_i]), (LAS unsigned*)(lds + (bufoff) + ldsw + _i * 8192), 16, 0, 0); } while (0)
#define PG8_LDA(dst, b, h) do { _Pragma("unroll") for (int m = 0; m < 4; ++m) _Pragma("unroll") for (int k = 0; k < 2; ++k) dst[m][k] = *(const LAS bf16x8*)(lds + PG8_SA(b, h) + aoff + m * 2048 + k * 1024); } while (0)
#define PG8_LDB(dst, b, h) do { _Pragma("unroll") for (int n = 0; n < 2; ++n) _Pragma("unroll") for (int k = 0; k < 2; ++k) dst[n][k] = *(const LAS bf16x8*)(lds + PG8_SB(b, h) + boff + n * 2048 + k * 1024); } while (0)
#define PG8_MMA(ai, bj, At, Bt) do { __builtin_amdgcn_s_setprio(1); _Pragma("unroll") for (int m = 0; m < 4; ++m) _Pragma("unroll") for (int n = 0; n < 2; ++n) _Pragma("unroll") for (int k = 0; k < 2; ++k) \
        acc[ai][bj][m][n] = __builtin_amdgcn_mfma_f32_16x16x32_bf16(Bt[n][k], At[m][k], acc[ai][bj][m][n], 0, 0, 0); __builtin_amdgcn_s_setprio(0); } while (0)
#define PG8_WAIT_V(n) asm volatile("s_waitcnt vmcnt(" #n ")" ::: "memory")
#define PG8_WAIT_L(n) asm volatile("s_waitcnt lgkmcnt(" #n ")" ::: "memory")
#define PG8_BAR __builtin_amdgcn_s_barrier()
#define PG8_SCHED __builtin_amdgcn_sched_barrier(0)
    Unit cur, nxt; int ui = 0;
    if (!S.next(0, cur)) return;
    f32x4 acc[2][2][4][2];
#pragma unroll
    for (int a = 0; a < 2; ++a)
#pragma unroll
        for (int b = 0; b < 2; ++b)
#pragma unroll
            for (int m = 0; m < 4; ++m)
#pragma unroll
                for (int n = 0; n < 2; ++n) acc[a][b][m][n] = (f32x4){0.f, 0.f, 0.f, 0.f};
    bf16x8 At[4][2], B0[2][2], B1[2][2];
    const char* cA = cur.A; const char* cB = cur.B;
    if constexpr (GATHER) PG8_GLOAD(vC, 0);
    PG8_STAGE(PG8_SB(0, 0), cB, voffB); PG8_STAGE(PG8_SB(0, 1), cB + hstepB, voffB); PG8_STAGE_A(PG8_SA(0, 0), 0, cA, vC); PG8_STAGE_A(PG8_SA(0, 1), 1, cA, vC);
    if (wr == 1) PG8_BAR;
    PG8_WAIT_V(2); PG8_BAR;
    PG8_STAGE(PG8_SB(1, 0), cB + kstep, voffB); PG8_STAGE_A(PG8_SA(1, 0), 0, cA + kstep, vC); PG8_STAGE(PG8_SB(1, 1), cB + hstepB + kstep, voffB);
    PG8_WAIT_V(6); PG8_BAR;
    for (;;) {
        const bool has_next = S.next(ui + 1, nxt);
        const char* nA = has_next ? nxt.A : cA; const char* nB = has_next ? nxt.B : cB;
        if constexpr (GATHER) { if (has_next) PG8_GLOAD(vN, ui + 1); else {
#pragma unroll
            for (int _h = 0; _h < 2; ++_h)
#pragma unroll
                for (int _i = 0; _i < 2; ++_i) vN[_h][_i] = vC[_h][_i]; } }
        const int nt = cur.nt > 0 ? cur.nt : nt0;
        for (int t = 0; t < nt; t += 2) {
            const bool last = (t == nt - 2);
            if constexpr (GATHER) {
#pragma unroll
                for (int _h = 0; _h < 2; ++_h)
#pragma unroll
                    for (int _i = 0; _i < 2; ++_i) vs[_h][_i] = last ? vN[_h][_i] : vC[_h][_i]; }
            const char* a1 = cA + (size_t)(t + 1) * kstep;
            const char* a2 = last ? nA : cA + (size_t)(t + 2) * kstep; const char* b2 = last ? nB : cB + (size_t)(t + 2) * kstep;
            const char* a3 = a2 + kstep; const char* b3 = b2 + kstep;
            PG8_LDB(B0, 0, 0); PG8_LDB(B1, 0, 1); PG8_SCHED; PG8_LDA(At, 0, 0); PG8_STAGE_A(PG8_SA(1, 1), 1, a1, vC);
            PG8_WAIT_V(8); PG8_WAIT_L(0); PG8_BAR; PG8_MMA(0, 0, At, B0); PG8_MMA(0, 1, At, B1); PG8_BAR; PG8_SCHED;
            PG8_LDA(At, 0, 1); PG8_STAGE(PG8_SB(0, 0), b2, voffB); PG8_STAGE(PG8_SB(0, 1), b2 + hstepB, voffB); PG8_STAGE_A(PG8_SA(0, 0), 0, a2, vs);
            PG8_WAIT_V(8); PG8_WAIT_L(0); PG8_BAR; PG8_MMA(1, 0, At, B0); PG8_MMA(1, 1, At, B1); PG8_BAR; PG8_SCHED;
            PG8_LDB(B0, 1, 0); PG8_LDB(B1, 1, 1); PG8_SCHED; PG8_LDA(At, 1, 0); PG8_STAGE_A(PG8_SA(0, 1), 1, a2, vs);
            PG8_WAIT_V(8); PG8_WAIT_L(0); PG8_BAR; PG8_MMA(0, 0, At, B0); PG8_MMA(0, 1, At, B1); PG8_BAR; PG8_SCHED;
            PG8_LDA(At, 1, 1); PG8_STAGE(PG8_SB(1, 0), b3, voffB); PG8_STAGE(PG8_SB(1, 1), b3 + hstepB, voffB); PG8_STAGE_A(PG8_SA(1, 0), 0, a3, vs);
            PG8_WAIT_V(8); PG8_WAIT_L(0); PG8_BAR; PG8_MMA(1, 0, At, B0); PG8_MMA(1, 1, At, B1); PG8_BAR; PG8_SCHED;
        }
        if (wr == 0) PG8_BAR;
        bool zero = true; if (cur.aux >= 0) { if constexpr (Epi::EDUP) { (void)E(acc, cur, wr, wc, fr, fq); asm volatile("" ::: "memory"); } zero = E(acc, cur, wr, wc, fr, fq); }
        if constexpr (Epi::DRAIN) __builtin_amdgcn_s_waitcnt(0x0F70);
        if (!has_next) break;
        if (zero) {
#pragma unroll
            for (int a = 0; a < 2; ++a)
#pragma unroll
                for (int b = 0; b < 2; ++b)
#pragma unroll
                    for (int m = 0; m < 4; ++m)
#pragma unroll
                        for (int n = 0; n < 2; ++n) acc[a][b][m][n] = (f32x4){0.f, 0.f, 0.f, 0.f};
        }
        cur = nxt; cA = nA; cB = nB; ++ui;
        if constexpr (GATHER) {
#pragma unroll
            for (int _h = 0; _h < 2; ++_h)
#pragma unroll
                for (int _i = 0; _i < 2; ++_i) vC[_h][_i] = vN[_h][_i]; }
        if (wr == 1) PG8_BAR;
    }
    PG8_WAIT_V(0);
    PG8_BAR;
#undef PG8_SA
#undef PG8_SB
#undef PG8_STAGE
#undef PG8_STAGE_A
#undef PG8_GLOAD
#undef PG8_LDA
#undef PG8_LDB
#undef PG8_MMA
#undef PG8_WAIT_V
#undef PG8_WAIT_L
#undef PG8_BAR
#undef PG8_SCHED
}
}
using pg8::Unit;


struct DenseOrder {
    const char* A; const char* B; int nM, nN, G, c; size_t astep, bstep; int dup;
    __device__ __forceinline__ bool next(int i, Unit& u) const {
        const int L = (dup ? (i >> 1) : i) * G + c; if (L >= nM * nN) return false;
        int pm, pn; pg8::static_tile(L, nM, nN, pm, pn);
        u.pm = pm; u.pn = pn; u.ord = i; u.nt = 0; u.aux = (dup && !(i & 1)) ? -1 : 0; u.A = A + (size_t)pm * astep; u.B = B + (size_t)pn * bstep; return true;
    }
};
struct BranchOrder {
    const char* Y; const char* W; int G, c;
    __device__ __forceinline__ bool next(int i, Unit& u) const {
        const int tl = (i / 3) * G + c; if (tl >= 256) return false;
        int pm, pn; pg8::static_tile(tl, 64, 4, pm, pn); const int br = i % 3;
        u.pm = pm; u.pn = pn; u.ord = i; u.nt = 0; u.aux = br; u.A = Y + ((size_t)pm * 256 * YW + (size_t)br * 512) * 2; u.B = W + ((size_t)br * 1024 * 512 + (size_t)pn * 256 * 512) * 2; return true;
    }
};
struct MoeOrder {
    const char* A; const char* W; const LAS int* tile_e; int n_units, NP, G, c; size_t wstride, bstep, astep;
    int n_full, split;
    __device__ __forceinline__ bool next(int i, Unit& u) const {
        int L = i * G + c, q = 0, nq = 1;
        if (L >= n_full && split > 1) { const int j = L - n_full; L = n_full + j / split; q = j % split; nq = split; }
        if (L >= n_units) return false;
        const int tile = L / NP, pn = L - tile * NP; const int e = tile_e[tile];
        const size_t koff = (size_t)q * (1024 / nq) * 2;
        u.pm = tile; u.pn = pn; u.ord = i; u.aux = e | (q << 8); u.nt = 16 / nq; u.A = A + (size_t)tile * astep + koff; u.B = W + (size_t)e * wstride + (size_t)pn * bstep + koff; return true;
    }
};

typedef f32x4 Acc[2][2][4][2];
#ifndef EDUP_IN
#define EDUP_IN 0
#endif
#ifndef EDUP_UP
#define EDUP_UP 0
#endif
struct EpiIn {
    static constexpr bool PERM = true, DRAIN = false, EDUP = (EDUP_IN != 0);
    bf16_t* ZP; const LAS float* rst; const LAS float* bia;
    __device__ __forceinline__ bool operator()(Acc& acc, const Unit& u, int wr, int wc, int fr, int fq) const {
        const int row0 = u.pm * 256 + wr * 64 + fr, pn = u.pn, cl = wc * 32 + 8 * fq;
        float rsv[2][4];
#pragma unroll
        for (int ai = 0; ai < 2; ++ai)
#pragma unroll
            for (int m = 0; m < 4; ++m) rsv[ai][m] = rst[u.ord * 256 + wr * 64 + fr + ai * 128 + m * 16];
        const LAS float* bp = bia + u.ord * 256 + cl;
        f32x4 bv[2][2];
#pragma unroll
        for (int bj = 0; bj < 2; ++bj)
#pragma unroll
            for (int n = 0; n < 2; ++n) bv[bj][n] = *(const LAS f32x4*)(bp + bj * 128 + 4 * n);
        constexpr float NL2E = -1.44269504089f;
        if (pn >= 2 && pn < 6) {
            bf16_t* base = ZP + ZP_GLU + (pn - 2) * 128 + cl;
            const f32x4 bg0 = bv[1][0] * NL2E, bg1 = bv[1][1] * NL2E;
#pragma unroll
            for (int ai = 0; ai < 2; ++ai)
#pragma unroll
                for (int m = 0; m < 4; ++m) { float o[8]; const float rc = rsv[ai][m] * NL2E;
#pragma unroll
                    for (int n = 0; n < 2; ++n) { const f32x4 a = acc[ai][0][m][n] * rsv[ai][m] + bv[0][n], t = acc[ai][1][m][n] * rc + (n ? bg1 : bg0);
#pragma unroll
                        for (int j = 0; j < 4; ++j) o[4 * n + j] = a[j] * __builtin_amdgcn_rcpf(1.0f + __builtin_amdgcn_exp2f(t[j])); }
                    u32x4 w; w.x = pk2(o[0], o[1]); w.y = pk2(o[2], o[3]); w.z = pk2(o[4], o[5]); w.w = pk2(o[6], o[7]);
                    st16(base + (size_t)(row0 + ai * 128 + m * 16) * ZPW, w); }
        } else if (pn >= 10) {
            bf16_t* base = ZP + (pn - 2) * 256 + cl;
            f32x4 bq[2][2];
#pragma unroll
            for (int bj = 0; bj < 2; ++bj)
#pragma unroll
                for (int n = 0; n < 2; ++n) bq[bj][n] = bv[bj][n] * NL2E;
#pragma unroll
            for (int ai = 0; ai < 2; ++ai)
#pragma unroll
                for (int m = 0; m < 4; ++m) { const float rc = rsv[ai][m] * NL2E;
#pragma unroll
                    for (int bj = 0; bj < 2; ++bj) { const f32x4 t0 = acc[ai][bj][m][0] * rc + bq[bj][0], t1 = acc[ai][bj][m][1] * rc + bq[bj][1]; f32x4 v0, v1;
#pragma unroll
                        for (int j = 0; j < 4; ++j) { v0[j] = __builtin_amdgcn_exp2f(t0[j]); v1[j] = __builtin_amdgcn_exp2f(t1[j]); }
                        v0 = v0 + 1.0f; v1 = v1 + 1.0f;
                        u32x4 w; w.x = pk2(v0[0], v0[1]); w.y = pk2(v0[2], v0[3]); w.z = pk2(v1[0], v1[1]); w.w = pk2(v1[2], v1[3]);
                        st16(base + (size_t)(row0 + ai * 128 + m * 16) * ZPW + bj * 128, w); } }
        } else {
            const int dc = (pn < 2 ? pn * 256 : (pn - 2) * 256 + 0) ;
            bf16_t* base = ZP + dc + cl;
#pragma unroll
            for (int ai = 0; ai < 2; ++ai)
#pragma unroll
                for (int m = 0; m < 4; ++m)
#pragma unroll
                    for (int bj = 0; bj < 2; ++bj) { const f32x4 v0 = acc[ai][bj][m][0] * rsv[ai][m] + bv[bj][0], v1 = acc[ai][bj][m][1] * rsv[ai][m] + bv[bj][1];
                        u32x4 w; w.x = pk2(v0[0], v0[1]); w.y = pk2(v0[2], v0[3]); w.z = pk2(v1[0], v1[1]); w.w = pk2(v1[2], v1[3]);
                        st16(base + (size_t)(row0 + ai * 128 + m * 16) * ZPW + bj * 128, w); }
        }
        return true;
    }
};
#ifndef GRND
#define GRND 3
#endif
struct EpiBranch {
    static constexpr bool PERM = true, DRAIN = false, EDUP = false;
    const bf16_t* ZP; const float* bb; bf16_t* MG;
    __device__ __forceinline__ bool operator()(Acc& acc, const Unit& u, int wr, int wc, int fr, int fq) const {
        const int row0 = u.pm * 256 + wr * 64 + fr, c0 = u.pn * 256 + wc * 32 + 8 * fq, br = u.aux;
        f32x4 bv[2][2];
#pragma unroll
        for (int bj = 0; bj < 2; ++bj)
#pragma unroll
            for (int n = 0; n < 2; ++n) bv[bj][n] = *(const f32x4*)(bb + br * 1024 + c0 + bj * 128 + 4 * n);
        const bf16_t* gp = ZP + ZP_G + br * 1024 + c0;
#pragma unroll
        for (int r0 = 0; r0 < 8; r0 += GRND) {
            u32x4 ga[GRND][2], gb[GRND][2];
#pragma unroll
            for (int rr = 0; rr < GRND; ++rr) if (r0 + rr < 8)
#pragma unroll
                for (int bj = 0; bj < 2; ++bj) { const size_t go = (size_t)(row0 + ((r0 + rr) >> 2) * 128 + ((r0 + rr) & 3) * 16) * ZPW + bj * 128;
                    ga[rr][bj] = *(const u32x4*)(gp + go); gb[rr][bj] = *(const u32x4*)(gp + (br < 2 ? 1024 : 0) + go); }
            __builtin_amdgcn_sched_barrier(0);
#pragma unroll
            for (int rr = 0; rr < GRND; ++rr) if (r0 + rr < 8) { const int ai = (r0 + rr) >> 2, m = (r0 + rr) & 3;
                const size_t ro = (size_t)(row0 + ai * 128 + m * 16);
#pragma unroll
                for (int bj = 0; bj < 2; ++bj) {
                    float f[8];
                    if (br < 2) {
#pragma unroll
                        for (int q = 0; q < 4; ++q) { f[2 * q] = fminf(bflo(gb[rr][bj][q]), 1e30f) * __builtin_amdgcn_rcpf(bflo(ga[rr][bj][q])); f[2 * q + 1] = fminf(bfhi(gb[rr][bj][q]), 1e30f) * __builtin_amdgcn_rcpf(bfhi(ga[rr][bj][q])); }
                    } else {
#pragma unroll
                        for (int q = 0; q < 4; ++q) { f[2 * q] = __builtin_amdgcn_rcpf(bflo(ga[rr][bj][q])); f[2 * q + 1] = __builtin_amdgcn_rcpf(bfhi(ga[rr][bj][q])); } }
#pragma unroll
                    for (int n = 0; n < 2; ++n)
#pragma unroll
                        for (int j = 0; j < 4; ++j) acc[ai][bj][m][n][j] = (acc[ai][bj][m][n][j] + bv[bj][n][j]) * f[4 * n + j];
                    if (br == 2) { const f32x4 v0 = acc[ai][bj][m][0], v1 = acc[ai][bj][m][1];
                        u32x4 w; w.x = pk2(v0[0], v0[1]); w.y = pk2(v0[2], v0[3]); w.z = pk2(v1[0], v1[1]); w.w = pk2(v1[2], v1[3]);
                        st16(MG + ro * D + c0 + bj * 128, w); }
                }
            }
            asm volatile("" ::: "memory");
        }
        return br == 2;
    }
};
struct EpiRes {
    static constexpr bool PERM = true, DRAIN = false, EDUP = false;
    const bf16_t* xin; bf16_t* xout; rs_t* rsout;
    __device__ __forceinline__ bool operator()(Acc& acc, const Unit& u, int wr, int wc, int fr, int fq) const {
        const int row0 = u.pm * 256 + wr * 64 + fr, c0 = u.pn * 256 + wc * 32 + 8 * fq;
#pragma unroll
        for (int ai = 0; ai < 2; ++ai) {
            u32x4 xv[4][2];
#pragma unroll
            for (int m = 0; m < 4; ++m)
#pragma unroll
                for (int bj = 0; bj < 2; ++bj) xv[m][bj] = *(const u32x4*)(xin + (size_t)(row0 + ai * 128 + m * 16) * D + c0 + bj * 128);
            __builtin_amdgcn_sched_barrier(0);
#pragma unroll
            for (int m = 0; m < 4; ++m) { const int r = row0 + ai * 128 + m * 16; float ss = 0.f;
#pragma unroll
                for (int bj = 0; bj < 2; ++bj) { const u32x4 x = xv[m][bj]; f32x4 v0 = acc[ai][bj][m][0], v1 = acc[ai][bj][m][1];
                    v0[0] += bflo(x.x); v0[1] += bfhi(x.x); v0[2] += bflo(x.y); v0[3] += bfhi(x.y); v1[0] += bflo(x.z); v1[1] += bfhi(x.z); v1[2] += bflo(x.w); v1[3] += bfhi(x.w);
                    ss += ((v0[0] * v0[0] + v0[1] * v0[1]) + (v0[2] * v0[2] + v0[3] * v0[3])) + ((v1[0] * v1[0] + v1[1] * v1[1]) + (v1[2] * v1[2] + v1[3] * v1[3]));
                    u32x4 w; w.x = pk2(v0[0], v0[1]); w.y = pk2(v0[2], v0[3]); w.z = pk2(v1[0], v1[1]); w.w = pk2(v1[2], v1[3]);
                    st16(xout + (size_t)r * D + c0 + bj * 128, w); }
                ss += __shfl_xor(ss, 16); ss += __shfl_xor(ss, 32);
                if (fq == 0) atomicAdd(rsout + r, rs_fix(ss)); }
            asm volatile("" ::: "memory"); }
        return true;
    }
};
struct EpiUp {
    static constexpr bool PERM = true, DRAIN = false, EDUP = (EDUP_UP != 0);
    bf16_t* ACT; const LAS float* rst; const LAS float* bia;
    __device__ __forceinline__ bool operator()(Acc& acc, const Unit& u, int wr, int wc, int fr, int fq) const {
        const int row0 = u.pm * 256 + wr * 64 + fr, cl = wc * 32 + 8 * fq;
        float rsv[2][4];
#pragma unroll
        for (int ai = 0; ai < 2; ++ai)
#pragma unroll
            for (int m = 0; m < 4; ++m) rsv[ai][m] = rst[u.ord * 256 + ai * 128 + wr * 64 + m * 16 + fr];
        const LAS float* bp = bia + u.ord * 256 + cl;
        f32x4 bg[2], bl[2];
#pragma unroll
        for (int n = 0; n < 2; ++n) { bg[n] = *(const LAS f32x4*)(bp + 4 * n); bl[n] = *(const LAS f32x4*)(bp + 128 + 4 * n); }
        bf16_t* base = ACT + u.pn * 128 + cl;
#pragma unroll
        for (int ai = 0; ai < 2; ++ai)
#pragma unroll
            for (int m = 0; m < 4; ++m) { unsigned o[4]; const f32x2 r2 = {rsv[ai][m], rsv[ai][m]};
#pragma unroll
                for (int n = 0; n < 2; ++n)
#pragma unroll
                    for (int h = 0; h < 2; ++h) {
                        const f32x2 a0 = {acc[ai][0][m][n][2 * h], acc[ai][0][m][n][2 * h + 1]}, a1 = {acc[ai][1][m][n][2 * h], acc[ai][1][m][n][2 * h + 1]};
                        const f32x2 b0 = {bg[n][2 * h], bg[n][2 * h + 1]}, b1 = {bl[n][2 * h], bl[n][2 * h + 1]};
                        f32x2 g = a0 * r2 + b0, l = a1 * r2 + b1;
                        g.x = fminf(g.x, 7.0f); g.y = fminf(g.y, 7.0f);
                        l.x = __builtin_amdgcn_fmed3f(l.x, -7.0f, 7.0f); l.y = __builtin_amdgcn_fmed3f(l.y, -7.0f, 7.0f);
                        const f32x2 t = g * (f32x2){-1.702f * 1.44269504089f, -1.702f * 1.44269504089f};
                        f32x2 d = {__builtin_amdgcn_exp2f(t.x), __builtin_amdgcn_exp2f(t.y)};
                        d = d + (f32x2){1.0f, 1.0f};
                        const f32x2 sg = {__builtin_amdgcn_rcpf(d.x), __builtin_amdgcn_rcpf(d.y)};
                        const f32x2 a = g * sg, ov = a * l + a;
                        o[2 * n + h] = pk2(ov.x, ov.y); }
                u32x4 w; w.x = o[0]; w.y = o[1]; w.z = o[2]; w.w = o[3];
                st16(base + (size_t)(row0 + ai * 128 + m * 16) * D, w); }
        return true;
    }
};
struct EpiBf {
    static constexpr bool PERM = true, DRAIN = false, EDUP = false;
    bf16_t* O; const LAS float* bia; bf16_t* OX; int tail_row0;
    __device__ __forceinline__ bool operator()(Acc& acc, const Unit& u, int wr, int wc, int fr, int fq) const {
        const int row0 = u.pm * 256 + wr * 64 + fr, c0 = u.pn * 256 + wc * 32 + 8 * fq, e = u.aux & 255, q = (u.aux >> 8) & 3;
        f32x4 bv[2][2];
#pragma unroll
        for (int bj = 0; bj < 2; ++bj)
#pragma unroll
            for (int n = 0; n < 2; ++n) bv[bj][n] = bia ? *(const LAS f32x4*)(bia + u.ord * 256 + wc * 32 + 8 * fq + bj * 128 + 4 * n) : (f32x4){0.f, 0.f, 0.f, 0.f};
        bf16_t* ob = (q == 0) ? O + (size_t)row0 * D : OX + ((size_t)(q - 1) * YEX_ROWS + (size_t)(row0 - tail_row0)) * D;
#pragma unroll
        for (int ai = 0; ai < 2; ++ai)
#pragma unroll
            for (int m = 0; m < 4; ++m)
#pragma unroll
                for (int bj = 0; bj < 2; ++bj) { const f32x4 v0 = acc[ai][bj][m][0] + bv[bj][0], v1 = acc[ai][bj][m][1] + bv[bj][1];
                    u32x4 w; w.x = pk2(v0[0], v0[1]); w.y = pk2(v0[2], v0[3]); w.z = pk2(v1[0], v1[1]); w.w = pk2(v1[2], v1[3]);
                    st16(ob + (size_t)(ai * 128 + m * 16) * D + c0 + bj * 128, w); }
        return true;
    }
};
struct EpiPle {
    static constexpr bool PERM = true, DRAIN = false, EDUP = false;
    const bf16_t* xin; bf16_t* xout; const bf16_t* PP; const rs_t* rs; rs_t* rsout;
    __device__ __forceinline__ bool operator()(Acc& acc, const Unit& u, int wr, int wc, int fr, int fq) const {
        const int row0 = u.pm * 256 + wr * 64 + fr, c0 = u.pn * 256 + wc * 32 + 8 * fq;
#pragma unroll
        for (int am = 0; am < 4; ++am) { const int ai = am >> 1, m0 = (am & 1) * 2;
            u32x4 xv[2][2], pv[2][2]; float rsv[2];
#pragma unroll
            for (int mm = 0; mm < 2; ++mm) { const int r = row0 + ai * 128 + (m0 + mm) * 16; rsv[mm] = rstd_of(rs[r]) * -1.44269504089f;
#pragma unroll
                for (int bj = 0; bj < 2; ++bj) { xv[mm][bj] = *(const u32x4*)(xin + (size_t)r * D + c0 + bj * 128); pv[mm][bj] = *(const u32x4*)(PP + (size_t)r * D + c0 + bj * 128); } }
            __builtin_amdgcn_sched_barrier(0);
#pragma unroll
            for (int mm = 0; mm < 2; ++mm) { const int m = m0 + mm, r = row0 + ai * 128 + m * 16; float ss = 0.f;
#pragma unroll
                for (int bj = 0; bj < 2; ++bj) { const u32x4 x = xv[mm][bj], p = pv[mm][bj]; const f32x4 a0 = acc[ai][bj][m][0] * rsv[mm], a1 = acc[ai][bj][m][1] * rsv[mm]; float v[8];
                    v[0] = bflo(x.x) + sig_t(a0[0]) * bflo(p.x); v[1] = bfhi(x.x) + sig_t(a0[1]) * bfhi(p.x); v[2] = bflo(x.y) + sig_t(a0[2]) * bflo(p.y); v[3] = bfhi(x.y) + sig_t(a0[3]) * bfhi(p.y);
                    v[4] = bflo(x.z) + sig_t(a1[0]) * bflo(p.z); v[5] = bfhi(x.z) + sig_t(a1[1]) * bfhi(p.z); v[6] = bflo(x.w) + sig_t(a1[2]) * bflo(p.w); v[7] = bfhi(x.w) + sig_t(a1[3]) * bfhi(p.w);
                    ss += ((v[0] * v[0] + v[1] * v[1]) + (v[2] * v[2] + v[3] * v[3])) + ((v[4] * v[4] + v[5] * v[5]) + (v[6] * v[6] + v[7] * v[7]));
                    u32x4 w; w.x = pk2(v[0], v[1]); w.y = pk2(v[2], v[3]); w.z = pk2(v[4], v[5]); w.w = pk2(v[6], v[7]);
                    st16(xout + (size_t)r * D + c0 + bj * 128, w); }
                ss += __shfl_xor(ss, 16); ss += __shfl_xor(ss, 32);
                if (fq == 0) atomicAdd(rsout + r, rs_fix(ss)); }
            asm volatile("" ::: "memory"); }
        return true;
    }
};

#define XB_TMO      128
#define XB_XCNT(j)  (256  + 64 * (j))
#define XB_XSUB(j)  (1280 + 64 * (j))
#define XB_XGEN(j)  (2304 + 64 * (j))
#define XB_TOP      3328
#define XB_TOPGEN   3392
#define XCD_BAR_WORDS 3456
#define XB_SPIN_CAP (1u << 22)
__device__ __forceinline__ unsigned xb_ld(unsigned* p)              { return __hip_atomic_load(p, __ATOMIC_RELAXED, __HIP_MEMORY_SCOPE_AGENT); }
__device__ __forceinline__ unsigned xb_add(unsigned* p, unsigned v) { return __hip_atomic_fetch_add(p, v, __ATOMIC_RELAXED, __HIP_MEMORY_SCOPE_AGENT); }
__device__ __forceinline__ unsigned xb_xcc_id() { return (unsigned)__builtin_amdgcn_s_getreg((3 << 11) | 20) & 0xFu; }
#define XB_SPIN(cond, bar) do { unsigned _sp = 0; while (cond) { __builtin_amdgcn_s_sleep(1); \
    if ((++_sp & 255u) == 0u) { if (xb_ld(&(bar)[XB_TMO])) break; if (_sp > XB_SPIN_CAP) { atomicAdd(&(bar)[XB_TMO], 1u); break; } } } } while (0)
struct XcdBarrier { unsigned* bar; unsigned x; volatile LAS unsigned* st; };
__device__ __forceinline__ XcdBarrier xcd_barrier_post(unsigned* bar, volatile LAS unsigned* st) {
    XcdBarrier b; b.bar = bar; b.x = xb_xcc_id(); b.st = st;
    if (threadIdx.x == 0) (void)xb_add(&bar[XB_XCNT(b.x)], 1u);
    return b;
}
__device__ __forceinline__ void xcd_barrier_complete(unsigned* bar, unsigned x, unsigned& nloc, unsigned& nx) {
    const unsigned G = gridDim.x * gridDim.y * gridDim.z;
    unsigned sum, cnt, mine, sp = 0u;
    for (;;) {
        sum = 0u; cnt = 0u; mine = 0u;
#pragma unroll
        for (unsigned j = 0; j < 16; ++j) { const unsigned c = xb_ld(&bar[XB_XCNT(j)]); sum += c; cnt += (c > 0u) ? 1u : 0u; mine = (j == x) ? c : mine; }
        if (sum == G) break;
        __builtin_amdgcn_s_sleep(1);
        if ((++sp & 255u) == 0u) { if (xb_ld(&bar[XB_TMO])) break; if (sp > XB_SPIN_CAP) { atomicAdd(&bar[XB_TMO], 1u); break; } }
    }
    nloc = mine > 0u ? mine : 1u; nx = cnt > 0u ? cnt : 1u;
}
__device__ __forceinline__ void xcd_barrier(const XcdBarrier& b) {
    asm volatile("s_waitcnt vmcnt(0)" ::: "memory");
    __syncthreads();
    if (threadIdx.x == 0) {
        unsigned* bar = b.bar;
        __builtin_amdgcn_s_waitcnt(0);
        unsigned nloc = b.st[0], nx = b.st[1];
        if (nloc == 0u) { xcd_barrier_complete(bar, b.x, nloc, nx); b.st[0] = nloc; b.st[1] = nx; }
        const unsigned old = xb_add(&bar[XB_XSUB(b.x)], 1u);
        const unsigned gen = old / nloc;
        if (old + 1u == (gen + 1u) * nloc) {
            __builtin_amdgcn_fence(__ATOMIC_RELEASE, "agent");
            asm volatile("s_waitcnt vmcnt(0)" ::: "memory");
            const unsigned og = xb_add(&bar[XB_TOP], 1u);
            const unsigned tg = og / nx;
            if (og + 1u == (tg + 1u) * nx) xb_add(&bar[XB_TOPGEN], 1u);
            else XB_SPIN(xb_ld(&bar[XB_TOPGEN]) == tg, bar);
            __builtin_amdgcn_fence(__ATOMIC_ACQUIRE, "agent");
            xb_add(&bar[XB_XGEN(b.x)], 1u);
            asm volatile("s_waitcnt vmcnt(0)" ::: "memory");
        } else {
            XB_SPIN(xb_ld(&bar[XB_XGEN(b.x)]) == gen, bar);
            __builtin_amdgcn_fence(__ATOMIC_ACQUIRE, "agent");
            asm volatile("s_waitcnt vmcnt(0)" ::: "memory");
        }
    }
    __syncthreads();
}

struct Args { const float* in[29]; float* out; unsigned char* ws; int ph_lo, ph_hi, use_cg, pad; };
struct Frame {
    LAS unsigned char* lds; int tid, lane, wave, G, vcu;
    float* out; unsigned char* ws;
    __device__ __forceinline__ void refresh() { int t = threadIdx.x; asm volatile("" : "+v"(t)); tid = t; lane = t & 63; wave = __builtin_amdgcn_readfirstlane(t >> 6); }
};
__device__ __forceinline__ const float* kin(int i) {
    const char __attribute__((address_space(4)))* p = (const char __attribute__((address_space(4)))*)__builtin_amdgcn_kernarg_segment_ptr();
    asm volatile("" : "+s"(p));
    return *(const float* const __attribute__((address_space(4)))*)(p + 8 * i);
}
#define WSP(T_, off) ((T_*)(F.ws + (off)))

struct TrDesc { const float* W; bf16_t* WT; const float* scale; int N, dK, k0, n0, drow0; };
__device__ __forceinline__ void tr_load(const TrDesc& d, int lane, f32x4 (&v)[16], float (&sc)[16]) {
    const int kr = lane >> 4, nc = 4 * (lane & 15);
#pragma unroll
    for (int i = 0; i < 16; ++i) v[i] = __builtin_nontemporal_load((const f32x4*)(d.W + (size_t)(d.k0 + 4 * i + kr) * d.N + d.n0 + nc));
#pragma unroll
    for (int i = 0; i < 16; ++i) sc[i] = d.scale ? d.scale[d.k0 + 4 * i + kr] : 1.0f;
}
__device__ __forceinline__ void tr_store(const TrDesc& d, int lane, const f32x4 (&v)[16], const float (&sc)[16], LAS float* scr) {
    const int kr = lane >> 4, nc = 4 * (lane & 15);
#pragma unroll
    for (int i = 0; i < 16; ++i) { LAS float* s = scr + (4 * i + kr) * 65 + nc; s[0] = v[i][0] * sc[i]; s[1] = v[i][1] * sc[i]; s[2] = v[i][2] * sc[i]; s[3] = v[i][3] * sc[i]; }
    LDS_WAIT(); asm volatile("" ::: "memory");
    const int c = lane & 7;
#pragma unroll
    for (int it = 0; it < 8; ++it) { const int n = (lane >> 3) + 8 * it; const LAS float* s = scr + (8 * c) * 65 + n;
        u32x4 o; o.x = pk2(s[0 * 65], s[1 * 65]); o.y = pk2(s[2 * 65], s[3 * 65]); o.z = pk2(s[4 * 65], s[5 * 65]); o.w = pk2(s[6 * 65], s[7 * 65]);
        __builtin_nontemporal_store(o, (u32x4*)(d.WT + (size_t)(d.drow0 + n) * d.dK + d.k0 + 8 * c)); }
    LDS_WAIT(); asm volatile("" ::: "memory");
}
__device__ __forceinline__ int win_src(int np) { if (np >= 512 && np < 1536) { const int t = (np - 512) >> 8, i = (np - 512) & 255; return i < 128 ? 512 + 128 * t + i : 1024 + 128 * t + (i - 128); } return np; }
__device__ __forceinline__ int win_dst64(int n0) { if (n0 >= 512 && n0 < 1024) { const int c = n0 - 512; return 512 + 256 * (c >> 7) + (c & 127); } if (n0 >= 1024 && n0 < 1536) { const int c = n0 - 1024; return 512 + 256 * (c >> 7) + 128 + (c & 127); } return n0; }
__device__ __forceinline__ int up_src(int np) { const int t = np >> 8, i = np & 255; return i < 128 ? 128 * t + i : 1024 + 128 * t + (i - 128); }
__device__ __forceinline__ int up_dst64(int n0) { if (n0 < 1024) return 256 * (n0 >> 7) + (n0 & 127); const int c = n0 - 1024; return 256 * (c >> 7) + 128 + (c & 127); }

__device__ __forceinline__ void row_load(const float* xr, int lane, f32x4 (&v)[4]) {
#pragma unroll
    for (int j = 0; j < 4; ++j) v[j] = *(const f32x4*)(xr + 4 * lane + 256 * j);
}
__device__ __forceinline__ void row_store_bf16(bf16_t* o, int lane, const f32x4 (&v)[4], float sc) {
#pragma unroll
    for (int j = 0; j < 4; ++j) { u32x2 w; w.x = pk2(v[j][0] * sc, v[j][1] * sc); w.y = pk2(v[j][2] * sc, v[j][3] * sc); *(u32x2*)(o + 4 * lane + 256 * j) = w; }
}
__device__ __forceinline__ void row_load_bf(const bf16_t* xr, int lane, u32x2 (&p)[4]) {
#pragma unroll
    for (int j = 0; j < 4; ++j) p[j] = *(const u32x2*)(xr + 4 * lane + 256 * j);
}
__device__ __forceinline__ void row_unpack(const u32x2 (&p)[4], f32x4 (&v)[4]) {
#pragma unroll
    for (int j = 0; j < 4; ++j) { v[j][0] = bflo(p[j].x); v[j][1] = bfhi(p[j].x); v[j][2] = bflo(p[j].y); v[j][3] = bfhi(p[j].y); }
}
__device__ __forceinline__ float row_sumsq(const f32x4 (&v)[4]) {
    float s = 0.f;
#pragma unroll
    for (int j = 0; j < 4; ++j) s += (v[j][0] * v[j][0] + v[j][1] * v[j][1]) + (v[j][2] * v[j][2] + v[j][3] * v[j][3]);
    return wave_sum(s);
}
__device__ __forceinline__ void phase_final(Frame& F, const bf16_t* xb, const rs_t* rsf, float* out, const float* g) {
    const int gw = F.vcu * 8 + F.wave, NGW = F.G * 8;
    for (int m = gw; m < T; m += NGW) { u32x2 p[4]; f32x4 v[4]; row_load_bf(xb + (size_t)m * D, F.lane, p); row_unpack(p, v); const float rs = rstd_of(rsf[m]);
#pragma unroll
        for (int j = 0; j < 4; ++j) { const f32x4 gg = *(const f32x4*)(g + 4 * F.lane + 256 * j); *(f32x4*)(out + (size_t)m * D + 4 * F.lane + 256 * j) = v[j] * rs * gg; } }
}

#ifndef TAIL_XF
#define TAIL_XF 12288
#endif
#ifndef TAIL_L1A
#define TAIL_L1A 5120
#endif
#ifndef TAIL_L1B
#define TAIL_L1B 3072
#endif
#ifndef TAIL_XF4
#define TAIL_XF4 4096
#endif
constexpr int I_WIN = 16 * 88, I_BR = 8 * 16, I_SQ = 16 * 16, I_UP = 16 * 32, I_PP = 4 * 16, I_POOL = 4;
constexpr int CONV_PER_LAYER = I_WIN + 3 * I_BR + I_SQ + 32 * I_UP + 32 * I_SQ + I_SQ + I_PP + 4 * I_POOL, CONV_NEXP = 32 * I_UP + 32 * I_SQ;
__device__ __forceinline__ TrDesc conv_desc(Frame& F, int l, int r) {
    if (r < 32 * I_UP) { const int e = r / I_UP, q = r % I_UP, kb = q / 32, nb = q % 32;
        return TrDesc{kin(21) + ((size_t)l * NE + e) * D * 2048, WSP(bf16_t, WS_WUP) + ((size_t)l * NE + e) * 2048 * D, kin(18) + l * D, 2048, D, 64 * kb, 64 * nb, up_dst64(64 * nb)}; } r -= 32 * I_UP;
    if (r < 32 * I_SQ) { const int e = r / I_SQ, q = r % I_SQ, kb = q / 16, nb = q % 16;
        return TrDesc{kin(23) + ((size_t)l * NE + e) * D * D, WSP(bf16_t, WS_WDN) + ((size_t)l * NE + e) * D * D, nullptr, D, D, 64 * kb, 64 * nb, 64 * nb}; } r -= 32 * I_SQ;
    if (r < I_WIN) { const int kb = r / 88, nb = r % 88;
        return TrDesc{kin(3) + (size_t)l * D * NZ, WSP(bf16_t, WS_WIN) + (size_t)l * NZ * D, kin(2) + l * D, NZ, D, 64 * kb, 64 * nb, win_dst64(64 * nb)}; } r -= I_WIN;
    if (r < 3 * I_BR) { const int k = r / I_BR, q = r % I_BR, kb = q / 16, nb = q % 16;
        return TrDesc{kin(15) + ((size_t)l * 3 + k) * 512 * D, WSP(bf16_t, WS_WBR) + ((size_t)l * 3 + k) * D * 512, nullptr, D, 512, 64 * kb, 64 * nb, 64 * nb}; } r -= 3 * I_BR;
    if (r < I_SQ) { const int kb = r / 16, nb = r % 16;
        return TrDesc{kin(17) + (size_t)l * D * D, WSP(bf16_t, WS_WOUT) + (size_t)l * D * D, nullptr, D, D, 64 * kb, 64 * nb, 64 * nb}; } r -= I_SQ;
    if (r < I_SQ) { const int kb = r / 16, nb = r % 16;
        return TrDesc{kin(26) + (size_t)l * D * D, WSP(bf16_t, WS_WPG) + (size_t)l * D * D, kin(25) + l * D, D, D, 64 * kb, 64 * nb, 64 * nb}; } r -= I_SQ;
    if (r < I_PP) { const int kb = r / 16, nb = r % 16;
        return TrDesc{kin(27) + (size_t)l * PLE * D, WSP(bf16_t, WS_WPP) + (size_t)l * D * PLE, nullptr, D, PLE, 64 * kb, 64 * nb, 64 * nb}; } r -= I_PP;
    { const int g = r / I_POOL, q = r % I_POOL, kb = q / 2, nb = q % 2;
        return TrDesc{kin(5) + ((size_t)l * 4 + g) * 128 * 128, WSP(bf16_t, WS_SMALLW + l * SW_LAYER + SW_WPT) + (size_t)g * 128 * 128, nullptr, 128, 128, 64 * kb, 64 * nb, 64 * nb}; }
}
template <class Map> __device__ __forceinline__ void conv_stream(Frame& F, int first, int stride, int count, const Map& map) {
    LAS float* scr = (LAS float*)(F.lds + F.wave * 16640);
    if (first >= count) return;
    f32x4 va[16], vb[16]; float sa[16], sb[16];
    int l, r; map(first, l, r); TrDesc da = conv_desc(F, l, r), db = da;
    tr_load(da, F.lane, va, sa);
    for (int it = first; it < count; it += 2 * stride) {
        const bool hb = it + stride < count;
        if (hb) { map(it + stride, l, r); db = conv_desc(F, l, r); tr_load(db, F.lane, vb, sb); }
        tr_store(da, F.lane, va, sa, scr);
        const bool ha = it + 2 * stride < count;
        if (ha) { map(it + 2 * stride, l, r); da = conv_desc(F, l, r); tr_load(da, F.lane, va, sa); }
        if (hb) tr_store(db, F.lane, vb, sb, scr);
    }
}
__device__ __forceinline__ void phase_weights(Frame& F) {
    const int gw = F.vcu * 8 + F.wave, NGW = F.G * 8;
    conv_stream(F, gw, NGW, I_WIN, [](int it, int& l, int& r) { l = 0; r = CONV_NEXP + it; });
    const size_t gt = (size_t)F.vcu * 512 + F.tid, NGT = (size_t)F.G * 512;
    { const float* sguw = kin(13);
      for (size_t i = gt; i < (size_t)NL * 4 * 128 * 128; i += NGT) { const int l = (int)(i >> 16), r = (int)(i & 65535), t = (r >> 7) & 127, s = r & 127;
        WSP(bf16_t, WS_SMALLW + l * SW_LAYER + SW_WSGU)[r] = (bf16_t)f2bf(s <= t ? sguw[i] : 0.f); } }
    { const float* rw = kin(19); const float* mn = kin(18);
      for (size_t i = gt; i < (size_t)NL * NE * D; i += NGT) { const int l = (int)(i >> 15), r = (int)(i & 32767), e = r >> 10, k = r & 1023;
        const float w = rw[((size_t)l * D + k) * NE + e] * mn[l * D + k]; const unsigned hi = f2bf(w); const float wl = w - __builtin_bit_cast(float, hi << 16);
        WSP(bf16_t, WS_SMALLW + l * SW_LAYER + SW_WRT)[r] = (bf16_t)hi; WSP(bf16_t, WS_SMALLW + l * SW_LAYER + SW_WRT + 65536)[r] = (bf16_t)f2bf(wl); } }
    { const float* bi = kin(4);
      for (size_t i = gt; i < (size_t)NL * NZ; i += NGT) { const int l = (int)(i / NZ), np = (int)(i % NZ);
        WSP(float, WS_SMALLW + l * SW_LAYER + SW_BIN)[np] = bi[l * NZ + win_src(np)]; } }
    { const float* bu = kin(22);
      for (size_t i = gt; i < (size_t)NL * NE * 2048; i += NGT) { const int l = (int)(i >> 16), r = (int)(i & 65535), e = r >> 11, np = r & 2047;
        WSP(float, WS_SMALLW + l * SW_LAYER + SW_BUP)[r] = bu[((size_t)l * NE + e) * 2048 + up_src(np)]; } }
    { rs_t* rsz = WSP(rs_t, WS_RS) + T; for (size_t i = gt; i < (size_t)3 * NL * T; i += NGT) rsz[i] = 0ull; }
    { const float* x = kin(0); bf16_t* X0 = WSP(bf16_t, WS_X0); rs_t* rs0 = WSP(rs_t, WS_RS);
      for (int m = gw; m < T; m += NGW) { f32x4 v[4]; row_load(x + (size_t)m * D, F.lane, v); const float ss = row_sumsq(v); row_store_bf16(X0 + (size_t)m * D, F.lane, v, 1.0f); if (F.lane == 0) rs0[m] = rs_fix(ss); } }
}
__device__ __forceinline__ void phase_convert_rest(Frame& F, int nb0) {
    const int nb = F.G - nb0, gw = ((int)blockIdx.x - nb0) * 8 + F.wave, NGW = nb * 8;
    constexpr int L0REST = CONV_PER_LAYER - CONV_NEXP - I_WIN, L0ALL = L0REST + CONV_NEXP;
    conv_stream(F, gw, NGW, L0ALL + CONV_PER_LAYER - TAIL_XF - TAIL_XF4 - TAIL_L1A - TAIL_L1B, [](int it, int& l, int& r) { if (it < L0REST) { l = 0; r = CONV_NEXP + I_WIN + it; } else if (it < L0ALL) { l = 0; r = it - L0REST; } else { l = 1; r = it - L0ALL + TAIL_XF + TAIL_XF4; if (r >= 32 * I_UP) r += TAIL_L1A + TAIL_L1B; } });
    const size_t gt = (size_t)((int)blockIdx.x - nb0) * 512 + F.tid, NGT = (size_t)nb * 512;
    { const float* pp = kin(1);
      for (size_t i = gt; i < (size_t)NL * T * PLE / 4; i += NGT) { const f32x4 v = *(const f32x4*)(pp + 4 * i); u32x2 w; w.x = pk2(v[0], v[1]); w.y = pk2(v[2], v[3]); *(u32x2*)(WSP(bf16_t, WS_PB) + 4 * i) = w; } }
}
__device__ __forceinline__ void conv_tail(Frame& F, int j, int n, int first, int count) {
    conv_stream(F, j * 8 + F.wave, n * 8, count, [first](int it, int& l, int& r) { l = 1; r = first + it; });
}

__device__ __forceinline__ float reduce_scatter64(float (&v)[64], int lane) {
#pragma unroll
    for (int m = 32, n = 32; m >= 1; m >>= 1, n >>= 1) {
        const bool up = (lane & m) != 0; float rcv[32];
#pragma unroll
        for (int i = 0; i < n; ++i) { const float a = v[i], b = v[i + n]; const float send = up ? a : b; v[i] = up ? b : a; rcv[i] = __shfl_xor(send, m); }
        __builtin_amdgcn_sched_barrier(0);
#pragma unroll
        for (int i = 0; i < n; ++i) v[i] += rcv[i];
    }
    return v[0];
}
__device__ __forceinline__ float reduce_scatter32(float (&v)[32], int lane) {
#pragma unroll
    for (int m = 32, n = 16; m >= 2; m >>= 1, n >>= 1) {
        const bool up = (lane & m) != 0; float rcv[16];
#pragma unroll
        for (int i = 0; i < n; ++i) { const float a = v[i], b = v[i + n]; const float send = up ? a : b; v[i] = up ? b : a; rcv[i] = __shfl_xor(send, m); }
        __builtin_amdgcn_sched_barrier(0);
#pragma unroll
        for (int i = 0; i < n; ++i) v[i] += rcv[i];
    }
    return v[0] + __shfl_xor(v[0], 1);
}
__device__ __forceinline__ void conv_unit(Frame& F, int l, int u) {
    const int t0 = 64 * u, s0 = t0 & (SEQ - 1);
    const bf16_t* ZP = WSP(bf16_t, WS_ZP);
    LAS unsigned char* in = F.lds;
    {
        u32x4 cv[12];
#pragma unroll
        for (int q = 0; q < 12; ++q) { const int idx = F.tid + 512 * q, r = idx >> 6, c16 = idx & 63; const int pos = s0 - 30 + r, rr = pos >= 0 ? t0 - 30 + r : t0 - s0;
            cv[q] = (idx < 94 * 64) ? *(const u32x4*)(ZP + (size_t)rr * ZPW + ZP_GLU + 8 * c16) : (u32x4){0u, 0u, 0u, 0u}; }
        __builtin_amdgcn_sched_barrier(0);
#pragma unroll
        for (int q = 0; q < 12; ++q) { const int idx = F.tid + 512 * q, r = idx >> 6, c16 = idx & 63; const bool ok = (s0 - 30 + r >= 0);
            u32x4 v = cv[q]; v.x = ok ? v.x : 0u; v.y = ok ? v.y : 0u; v.z = ok ? v.z : 0u; v.w = ok ? v.w : 0u;
            if (idx < 94 * 64) *(LAS u32x4*)(in + r * 1024 + c16 * 16) = v; }
    }
    const int cp = F.tid & 255, half = F.tid >> 8;
    f32x2 w[CONVK]; const float* cwp = kin(7);
#pragma unroll
    for (int j = 0; j < CONVK; ++j) w[j] = *(const f32x2*)(cwp + ((size_t)l * CONVK + j) * 512 + 2 * cp);
    const f32x2 cb = *(const f32x2*)(kin(8) + l * 512 + 2 * cp);
    f32x2 acc[32];
#pragma unroll
    for (int o = 0; o < 32; ++o) acc[o] = cb;
    __syncthreads();
    const LAS unsigned char* ip = in + (32 * half) * 1024 + cp * 4;
    unsigned pvl[62];
#pragma unroll
    for (int rr = 0; rr < 62; ++rr) pvl[rr] = *(const LAS unsigned*)(ip + rr * 1024);
    __builtin_amdgcn_sched_barrier(0);
#pragma unroll
    for (int rr = 0; rr < 62; ++rr) { const unsigned pv = pvl[rr]; const f32x2 v = (f32x2){bflo(pv), bfhi(pv)};
#pragma unroll
        for (int o = (rr > 30 ? rr - 30 : 0); o <= (rr < 31 ? rr : 31); ++o) acc[o] = acc[o] + w[rr - o] * v; }
    float st[64];
#pragma unroll
    for (int o = 0; o < 32; ++o) { st[o] = acc[o].x + acc[o].y; st[32 + o] = acc[o].x * acc[o].x + acc[o].y * acc[o].y; }
    const float tot = reduce_scatter64(st, F.lane);
    LAS float* red = (LAS float*)(F.lds + LDS_TAB);
    red[F.wave * 64 + F.lane] = tot;
    __syncthreads();
    if (F.tid < 128) { const int h = F.tid >> 6, i = F.tid & 63; red[512 + F.tid] = (red[(4 * h) * 64 + i] + red[(4 * h + 1) * 64 + i]) + (red[(4 * h + 2) * 64 + i] + red[(4 * h + 3) * 64 + i]); }
    __syncthreads();
    const f32x2 ng = *(const f32x2*)(kin(9) + l * 512 + 2 * cp), nb = *(const f32x2*)(kin(10) + l * 512 + 2 * cp);
    bf16_t* Y = WSP(bf16_t, WS_Y) + (size_t)(t0 + 32 * half) * YW + 512 + 2 * cp;
#pragma unroll
    for (int o = 0; o < 32; ++o) { const float mean = red[512 + half * 64 + o] * (1.0f / 512.0f), var = red[512 + half * 64 + 32 + o] * (1.0f / 512.0f) - mean * mean; const float rs = 1.0f / sqrtf(fmaxf(var, 0.f) + EPS);
        float y0 = (acc[o].x - mean) * rs * ng.x + nb.x, y1 = (acc[o].y - mean) * rs * ng.y + nb.y; y0 = y0 * sigmoidf_(y0); y1 = y1 * sigmoidf_(y1);
        *(unsigned*)(Y + (size_t)o * YW) = pk2(y0, y1); }
    __syncthreads();
}
template <int W> __device__ __forceinline__ void pool_window(const f32x2 (&f)[47], const f32x2 (&pre)[48], int s_first, LAS unsigned char* pa) {
#pragma unroll
    for (int o = 0; o < 32; ++o) { const f32x2 s = pre[o + 16] - pre[o + 16 - W];
        const int pos = s_first + o; const float inv = 1.0f / (float)(pos + 1 < W ? pos + 1 : W);
        const f32x2 p = s * inv - f[o + 15];
        *(LAS unsigned*)(pa + o * 1040) = pk2(p.x, p.y); }
}
__device__ __forceinline__ void pool_unit(Frame& F, int l, int u) {
    const int t0 = 64 * u, s0 = t0 & (SEQ - 1);
    const bf16_t* ZP = WSP(bf16_t, WS_ZP);
    LAS unsigned char* pA = F.lds;
    const int cp = F.tid & 255, half = F.tid >> 8, first = t0 + 32 * half;
    f32x2 f[47]; unsigned pvr[47];
#pragma unroll
    for (int i = 0; i < 47; ++i) { const int pos = s0 + 32 * half - 15 + i; const int rr = pos >= 0 ? first - 15 + i : t0 - s0;
        pvr[i] = *(const unsigned*)(ZP + (size_t)rr * ZPW + ZP_ZA + 2 * cp); }
    __builtin_amdgcn_sched_barrier(0);
#pragma unroll
    for (int i = 0; i < 47; ++i) { const int pos = s0 + 32 * half - 15 + i; const unsigned pv = pos >= 0 ? pvr[i] : 0u; f[i] = (f32x2){bflo(pv), bfhi(pv)}; }
    LAS unsigned char* pa = pA + (32 * half) * 1040 + cp * 4;
    const int g = (F.wave & 3);
    f32x2 pre[48]; pre[0] = (f32x2){0.f, 0.f};
#pragma unroll
    for (int i = 0; i < 47; ++i) pre[i + 1] = pre[i] + f[i];
    if (g == 0) pool_window<2>(f, pre, s0 + 32 * half, pa); else if (g == 1) pool_window<4>(f, pre, s0 + 32 * half, pa); else if (g == 2) pool_window<8>(f, pre, s0 + 32 * half, pa); else pool_window<16>(f, pre, s0 + 32 * half, pa);
    __syncthreads();
    const int gg = F.wave >> 1, dh = F.wave & 1, r = F.lane & 31, h = F.lane >> 5;
    const bf16_t* WPT = WSP(bf16_t, WS_SMALLW + l * SW_LAYER + SW_WPT) + (size_t)gg * 128 * 128;
    f32x16 acc[2][2];
#pragma unroll
    for (int mi = 0; mi < 2; ++mi)
#pragma unroll
        for (int ni = 0; ni < 2; ++ni)
#pragma unroll
            for (int q = 0; q < 16; ++q) acc[mi][ni][q] = 0.f;
    bf16x8 bw[8][2];
#pragma unroll
    for (int s = 0; s < 8; ++s)
#pragma unroll
        for (int ni = 0; ni < 2; ++ni) bw[s][ni] = *(const bf16x8*)(WPT + (size_t)(64 * dh + 32 * ni + r) * 128 + 16 * s + 8 * h);
#pragma unroll
    for (int s = 0; s < 8; ++s) { bf16x8 a[2];
#pragma unroll
        for (int mi = 0; mi < 2; ++mi) a[mi] = *(const LAS bf16x8*)(pA + (32 * mi + r) * 1040 + (128 * gg + 16 * s + 8 * h) * 2);
#pragma unroll
        for (int mi = 0; mi < 2; ++mi)
#pragma unroll
            for (int ni = 0; ni < 2; ++ni) acc[mi][ni] = __builtin_amdgcn_mfma_f32_32x32x16_bf16(bw[s][ni], a[mi], acc[mi][ni], 0, 0, 0); }
    bf16_t* Y = WSP(bf16_t, WS_Y); const float* psc = kin(6);
#pragma unroll
    for (int ni = 0; ni < 2; ++ni)
#pragma unroll
        for (int g = 0; g < 4; ++g) { const int d = 128 * gg + 64 * dh + 32 * ni + 8 * g + 4 * h; const f32x4 sc = *(const f32x4*)(psc + l * 512 + d);
#pragma unroll
            for (int mi = 0; mi < 2; ++mi) { u32x2 o; o.x = pk2(acc[mi][ni][4 * g + 0] * sc[0], acc[mi][ni][4 * g + 1] * sc[1]); o.y = pk2(acc[mi][ni][4 * g + 2] * sc[2], acc[mi][ni][4 * g + 3] * sc[3]);
                *(u32x2*)(Y + (size_t)(t0 + 32 * mi + r) * YW + d) = o; } }
    __syncthreads();
}
__device__ __forceinline__ void sgu_unit(Frame& F, int l, int u) {
    const int chunk = u >> 1, hp = u & 1, t0 = 128 * chunk;
    const bf16_t* ZP = WSP(bf16_t, WS_ZP);
    LAS unsigned char* vT = F.lds;
    {
        const float* lng = kin(11) + l * 512 + 8 * F.lane; const float* lnb = kin(12) + l * 512 + 8 * F.lane;
        const f32x4 g0 = *(const f32x4*)lng, g1 = *(const f32x4*)(lng + 4);
        const f32x4 b0 = *(const f32x4*)lnb, b1 = *(const f32x4*)(lnb + 4);
        u32x4 pvv[16];
#pragma unroll
        for (int i = 0; i < 16; ++i) pvv[i] = *(const u32x4*)(ZP + (size_t)(t0 + 16 * F.wave + i) * ZPW + ZP_ZV + 8 * F.lane);
        float st[32];
#pragma unroll
        for (int i = 0; i < 16; ++i) { const u32x4 pv = pvv[i]; const float x0 = bflo(pv.x), x1 = bfhi(pv.x), x2 = bflo(pv.y), x3 = bfhi(pv.y), x4 = bflo(pv.z), x5 = bfhi(pv.z), x6 = bflo(pv.w), x7 = bfhi(pv.w);
            st[i] = ((x0 + x1) + (x2 + x3)) + ((x4 + x5) + (x6 + x7)); st[16 + i] = ((x0 * x0 + x1 * x1) + (x2 * x2 + x3 * x3)) + ((x4 * x4 + x5 * x5) + (x6 * x6 + x7 * x7)); }
        const float tot = reduce_scatter32(st, F.lane);
        LAS float* wst = (LAS float*)(F.lds + LDS_TAB) + 32 * F.wave;
        if ((F.lane & 1) == 0) wst[F.lane >> 1] = tot;
        LDS_WAIT(); asm volatile("" ::: "memory");
        if ((F.lane >> 5) == hp) { const int cl = 8 * (F.lane & 31);
            float mu[16], rsd[16];
#pragma unroll
            for (int i = 0; i < 16; ++i) { const float mean = wst[i] * (1.0f / 512.0f), var = wst[16 + i] * (1.0f / 512.0f) - mean * mean; mu[i] = mean; rsd[i] = 1.0f / sqrtf(fmaxf(var, 0.f) + EPS); }
#pragma unroll
            for (int j = 0; j < 8; ++j) { const float gg = j < 4 ? g0[j & 3] : g1[j & 3], bb = j < 4 ? b0[j & 3] : b1[j & 3]; unsigned w[8];
#pragma unroll
                for (int i2 = 0; i2 < 8; ++i2) { const unsigned pa = pvv[2 * i2][j >> 1], pb = pvv[2 * i2 + 1][j >> 1];
                    const float xa = (j & 1) ? bfhi(pa) : bflo(pa), xb = (j & 1) ? bfhi(pb) : bflo(pb);
                    w[i2] = pk2((xa - mu[2 * i2]) * rsd[2 * i2] * gg + bb, (xb - mu[2 * i2 + 1]) * rsd[2 * i2 + 1] * gg + bb); }
                LAS unsigned char* dst = vT + (cl + j) * 272 + (16 * F.wave) * 2;
                *(LAS u32x4*)dst = (u32x4){w[0], w[1], w[2], w[3]}; *(LAS u32x4*)(dst + 16) = (u32x4){w[4], w[5], w[6], w[7]}; }
        }
    }
    const int hl = F.wave >> 2, ti = F.wave & 3, hh = 2 * hp + hl, r = F.lane & 31, h = F.lane >> 5;
    const bf16_t* WS_ = WSP(bf16_t, WS_SMALLW + l * SW_LAYER + SW_WSGU) + (size_t)hh * 128 * 128;
    bf16x8 af[8];
#pragma unroll
    for (int k = 0; k < 8; ++k) if (k < 2 * (ti + 1)) af[k] = *(const bf16x8*)(WS_ + (size_t)(32 * ti + r) * 128 + 16 * k + 8 * h);
    __syncthreads();
    f32x16 acc[4];
#pragma unroll
    for (int ci = 0; ci < 4; ++ci)
#pragma unroll
        for (int q = 0; q < 16; ++q) acc[ci][q] = 0.f;
#pragma unroll
    for (int k = 0; k < 8; ++k) if (k < 2 * (ti + 1)) {
#pragma unroll
        for (int ci = 0; ci < 4; ++ci) { const bf16x8 b = *(const LAS bf16x8*)(vT + (128 * hl + 32 * ci + r) * 272 + (16 * k + 8 * h) * 2);
            acc[ci] = __builtin_amdgcn_mfma_f32_32x32x16_bf16(b, af[k], acc[ci], 0, 0, 0); }
    }
    bf16_t* Y = WSP(bf16_t, WS_Y);
    { const int tl = 32 * ti + r; const float sb = kin(14)[((size_t)l * 4 + hh) * 128 + tl];
      const bf16_t* zr = ZP + (size_t)(t0 + tl) * ZPW + ZP_ZU + 128 * hh + 4 * h; bf16_t* yr = Y + (size_t)(t0 + tl) * YW + 1024 + 128 * hh + 4 * h;
      u32x2 zu[4][4];
#pragma unroll
      for (int ci = 0; ci < 4; ++ci)
#pragma unroll
          for (int g = 0; g < 4; ++g) zu[ci][g] = *(const u32x2*)(zr + 32 * ci + 8 * g);
#pragma unroll
      for (int ci = 0; ci < 4; ++ci)
#pragma unroll
          for (int g = 0; g < 4; ++g) { const u32x2 z = zu[ci][g]; u32x2 o;
              o.x = pk2(bflo(z.x) * (acc[ci][4 * g + 0] + sb), bfhi(z.x) * (acc[ci][4 * g + 1] + sb)); o.y = pk2(bflo(z.y) * (acc[ci][4 * g + 2] + sb), bfhi(z.y) * (acc[ci][4 * g + 3] + sb));
              *(u32x2*)(yr + 32 * ci + 8 * g) = o; } }
    __syncthreads();
}
#ifndef MIX_DUP
#define MIX_DUP 0
#endif
__device__ __forceinline__ void phase_mix(Frame& F, int l) {
    for (int rep = 0; rep < ((MIX_DUP & 1) ? 2 : 1); ++rep) for (int u = F.vcu; u < 256; u += F.G) sgu_unit(F, l, u);
    for (int rep = 0; rep < ((MIX_DUP & 2) ? 2 : 1); ++rep) for (int u = F.vcu; u < 256; u += F.G) conv_unit(F, l, u);
    for (int rep = 0; rep < ((MIX_DUP & 4) ? 2 : 1); ++rep) for (int u = F.vcu; u < 256; u += F.G) pool_unit(F, l, u);
}

__device__ __forceinline__ void phase_router(Frame& F, int l, const bf16_t* x, const rs_t* rs) {
    LAS float* P = (LAS float*)F.lds;
    LAS int* hist = (LAS int*)(F.lds + LDS_TAB);
    const bf16_t* WH = WSP(bf16_t, WS_SMALLW + l * SW_LAYER + SW_WRT); const bf16_t* WL = WH + 32768;
    float* TW = WSP(float, WS_TOPW); int* TOKL = WSP(int, WS_TOKL); int* SO = WSP(int, WS_SLOTOF);
    unsigned* gcnt = (unsigned*)(F.ws + WS_CTL) + CW_GCNT + 32 * l;
    const float* rbias = kin(20) + l * NE;
    if (F.tid < 32) hist[F.tid] = 0;
    const int rb = F.wave & 1, kq = F.wave >> 1, r = F.lane & 31, h = F.lane >> 5;
    for (int blk = F.vcu; blk < 256; blk += F.G) {
        const bf16_t* xr = x + (size_t)(64 * blk + 32 * rb + r) * D + 256 * kq + 8 * h;
        const bf16_t* whp = WH + (size_t)r * D + 256 * kq + 8 * h; const bf16_t* wlp = WL + (size_t)r * D + 256 * kq + 8 * h;
        bf16x8 xa[16];
#pragma unroll
        for (int s2 = 0; s2 < 16; ++s2) xa[s2] = *(const bf16x8*)(xr + 16 * s2);
        f32x16 acc;
#pragma unroll
        for (int q = 0; q < 16; ++q) acc[q] = 0.f;
#pragma unroll
        for (int sb = 0; sb < 4; ++sb) { bf16x8 ha[4], la[4];
#pragma unroll
            for (int s2 = 0; s2 < 4; ++s2) { ha[s2] = *(const bf16x8*)(whp + 16 * (4 * sb + s2)); la[s2] = *(const bf16x8*)(wlp + 16 * (4 * sb + s2)); }
#pragma unroll
            for (int s2 = 0; s2 < 4; ++s2) { acc = __builtin_amdgcn_mfma_f32_32x32x16_bf16(xa[4 * sb + s2], ha[s2], acc, 0, 0, 0); acc = __builtin_amdgcn_mfma_f32_32x32x16_bf16(xa[4 * sb + s2], la[s2], acc, 0, 0, 0); } }
#pragma unroll
        for (int q = 0; q < 16; ++q) P[(kq * 64 + 32 * rb + (q & 3) + 8 * (q >> 2) + 4 * h) * 33 + r] = acc[q];
        __syncthreads();
        if (F.lane < 8) {
            const int rl = 8 * F.wave + F.lane, row = 64 * blk + rl; const float rstd = rstd_of(rs[row]);
            float v0 = -3.0e38f, v1 = -3.0e38f, v2 = -3.0e38f, v3 = -3.0e38f; int i0 = 0, i1 = 0, i2 = 0, i3 = 0;
#pragma unroll
            for (int e = 0; e < 32; ++e) { const float v = ((P[(0 * 64 + rl) * 33 + e] + P[(1 * 64 + rl) * 33 + e]) + (P[(2 * 64 + rl) * 33 + e] + P[(3 * 64 + rl) * 33 + e])) * rstd + rbias[e];
                const bool c0 = v > v0, c1 = v > v1, c2 = v > v2, c3 = v > v3;
                v3 = c2 ? v2 : (c3 ? v : v3); i3 = c2 ? i2 : (c3 ? e : i3);
                v2 = c1 ? v1 : (c2 ? v : v2); i2 = c1 ? i1 : (c2 ? e : i2);
                v1 = c0 ? v0 : (c1 ? v : v1); i1 = c0 ? i0 : (c1 ? e : i1);
                v0 = c0 ? v : v0;             i0 = c0 ? e : i0; }
            const f32x4 tw = (f32x4){1.0f, __expf(v1 - v0), __expf(v2 - v0), __expf(v3 - v0)};
            *(f32x4*)(TW + row * 4) = tw;
            const int ie[4] = {i0, i1, i2, i3};
#pragma unroll
            for (int k = 0; k < 4; ++k) { const int rk = __hip_atomic_fetch_add((int*)(hist + ie[k]), 1, __ATOMIC_RELAXED, __HIP_MEMORY_SCOPE_WORKGROUP);
                hist[64 + rl * 4 + k] = ie[k] | (rk << 8); }
        }
        __syncthreads();
        if (F.tid < 32) { hist[32 + F.tid] = (int)__hip_atomic_fetch_add(gcnt + F.tid, (unsigned)hist[F.tid], __ATOMIC_RELAXED, __HIP_MEMORY_SCOPE_AGENT); hist[F.tid] = 0; }
        __syncthreads();
        if (F.tid < 256) { const int pk = hist[64 + F.tid], e = pk & 255, pos = hist[32 + e] + (pk >> 8), tok = 64 * blk + (F.tid >> 2);
            TOKL[e * T + pos] = tok; SO[tok * 4 + (F.tid & 3)] = e | (pos << 5); }
        __syncthreads();
    }
}
__device__ __forceinline__ void moe_tables(Frame& F, int l, bool split_tail = false) {
    LAS int* tab = (LAS int*)(F.lds + LDS_TAB);
    const unsigned* gcnt = (const unsigned*)(F.ws + WS_CTL) + CW_GCNT + 32 * l;
    if (F.tid < 64) { const int e = F.lane & 31; const int c = (int)gcnt[e]; const int pt = (c + 255) >> 8; int incl = pt;
#pragma unroll
        for (int o = 1; o < 32; o <<= 1) { const int v = __shfl_up(incl, o, 32); if (e >= o) incl += v; }
        if (F.lane < 32) { tab[MT_CNT + e] = c; tab[MT_TSTART + e] = incl - pt;
            if (e == 31) { tab[MT_NTILE] = incl;
                const int nu = incl * 4, nf = (nu / F.G) * F.G, rem = nu - nf; const int sp = (!split_tail || rem == 0) ? 1 : (rem * 4 <= F.G ? 4 : (rem * 2 <= F.G ? 2 : 1));
                tab[MT_SPLIT] = sp; tab[MT_NFULL] = nf; tab[MT_TAILROW] = (nf / 4) * 256; } } }
    __syncthreads();
    if (F.tid <= MAXTILES) { int e = 0;
#pragma unroll
        for (int q = 0; q < 31; ++q) e += (int)(((unsigned)(F.tid - tab[MT_TSTART + q + 1])) >> 31) ^ 1;
        tab[MT_TE + F.tid] = e; }
    __syncthreads();
}
__device__ __forceinline__ void phase_combine(Frame& F, int l, const bf16_t* xin, bf16_t* xout, rs_t* rsout) {
    moe_tables(F, l, SPLITK_TAIL && l == NL - 1);
    const int gw = F.vcu * 8 + F.wave, NGW = F.G * 8;
    const int* SO = WSP(int, WS_SLOTOF); const float* TW = WSP(float, WS_TOPW); const bf16_t* YE = WSP(bf16_t, WS_YE);
    const LAS int* tab = (const LAS int*)(F.lds + LDS_TAB); const int sp = tab[MT_SPLIT], trow = tab[MT_TAILROW]; const bf16_t* YEX = WSP(bf16_t, WS_YEX);
    for (int m = gw; m < T; m += NGW) {
        u32x2 p[4]; f32x4 v[4]; row_load_bf(xin + (size_t)m * D, F.lane, p);
        const f32x4 tw = *(const f32x4*)(TW + m * 4); const float twi = 1.0f / ((tw[0] + tw[1]) + (tw[2] + tw[3]));
        u32x2 y[4][4]; int slots[4];
#pragma unroll
        for (int k = 0; k < 4; ++k) { const int pk = SO[m * 4 + k]; slots[k] = tab[MT_TSTART + (pk & 31)] * 256 + (pk >> 5); row_load_bf(YE + (size_t)slots[k] * D, F.lane, y[k]); }
        row_unpack(p, v);
        if (sp > 1) {
#pragma unroll
            for (int k = 0; k < 4; ++k) if (slots[k] >= trow) { const float w = tw[k] * twi;
                for (int q = 1; q < sp; ++q) { u32x2 z[4]; row_load_bf(YEX + ((size_t)(q - 1) * YEX_ROWS + (size_t)(slots[k] - trow)) * D, F.lane, z);
#pragma unroll
                    for (int j = 0; j < 4; ++j) { v[j][0] += w * bflo(z[j].x); v[j][1] += w * bfhi(z[j].x); v[j][2] += w * bflo(z[j].y); v[j][3] += w * bfhi(z[j].y); } } } }
#pragma unroll
        for (int k = 0; k < 4; ++k) { const float w = tw[k] * twi;
#pragma unroll
            for (int j = 0; j < 4; ++j) { v[j][0] += w * bflo(y[k][j].x); v[j][1] += w * bfhi(y[k][j].x); v[j][2] += w * bflo(y[k][j].y); v[j][3] += w * bfhi(y[k][j].y); } }
        const float ss = row_sumsq(v); row_store_bf16(xout + (size_t)m * D, F.lane, v, 1.0f); if (F.lane == 0) rsout[m] = rs_fix(ss);
    }
}

__device__ __forceinline__ void idle_set(int n_units, int G, int c, int& j, int& n) {
    const int rem = n_units % G; if (rem == 0 || G - rem < 32) { j = c; n = G; } else { j = c - rem; n = G - rem; }
}
constexpr int PH_PER_LAYER = 9, N_PHASES = 1 + NL * PH_PER_LAYER + 1;
__global__ void __launch_bounds__(512, 2) mega_fwd(Args args) {
    extern __shared__ __attribute__((aligned(16))) unsigned char lds_raw[];
    Frame F;
    F.lds = (LAS unsigned char*)lds_raw; F.tid = threadIdx.x; F.lane = F.tid & 63; F.wave = __builtin_amdgcn_readfirstlane(F.tid >> 6);
    F.G = gridDim.x; { const int bx = blockIdx.x; F.vcu = (F.G % 8 == 0) ? (bx % 8) * (F.G / 8) + bx / 8 : bx; }
    F.out = args.out; F.ws = args.ws;
    volatile LAS unsigned* MISC = (volatile LAS unsigned*)(F.lds + LDS_MISC);
    if (F.tid < 64) MISC[F.tid] = 0u;
    __syncthreads();
    XcdBarrier bar; bar.bar = (unsigned*)(F.ws + WS_CTL) + CW_BAR; bar.x = 0; bar.st = nullptr;
    const int lo = args.ph_lo, hi = args.ph_hi;
    if (hi - lo > 1 && !args.use_cg) bar = xcd_barrier_post((unsigned*)(F.ws + WS_CTL) + CW_BAR, MISC + 8);
#ifndef BAR_DUP
#define BAR_DUP 0
#endif
#define SEAM(ph) do { if ((ph) + 1 < hi) { if (args.use_cg) cg::this_grid().sync(); else { xcd_barrier(bar); if (BAR_DUP) xcd_barrier(bar); } } } while (0)
#ifndef PH_MASK
#define PH_MASK 0xffff
#endif
#define PHT(k) ((k) == 0 ? 11 : (k) == N_PHASES - 1 ? 12 : ((k) - 1) % PH_PER_LAYER)
#define IN(k) (((PH_MASK >> PHT(k)) & 1) && lo <= (k) && (k) < hi)
#ifndef KDUP_MASK
#define KDUP_MASK 0
#endif
#ifndef SPLIT_GC
#define SPLIT_GC 160
#endif
#ifndef DUP_MASK
#define DUP_MASK 0
#endif
#define REPEAT(k) for (int rep_ = 0, nrep_ = (((DUP_MASK >> PHT(k)) & 1) ? 2 : 1); rep_ < nrep_; ++rep_, (rep_ < nrep_ ? xcd_barrier(bar) : (void)0))
    if (IN(0)) { REPEAT(0) { F.refresh(); phase_weights(F); } SEAM(0); }
    bf16_t* const X0 = WSP(bf16_t, WS_X0); bf16_t* const X1 = WSP(bf16_t, WS_X1); bf16_t* const X2 = WSP(bf16_t, WS_X2);
    for (int l = 0; l < NL; ++l) {
        const int pb = 1 + l * PH_PER_LAYER;
        const unsigned char* sw = F.ws + WS_SMALLW + l * SW_LAYER;
        rs_t* const rs0 = WSP(rs_t, WS_RS) + (size_t)(3 * l) * T;
        if (IN(pb + 0)) { REPEAT(pb + 0) { F.refresh();
            const int gc = (l == 0 && F.G > SPLIT_GC) ? SPLIT_GC : F.G;
            if ((int)blockIdx.x < gc) {
                DenseOrder S{(const char*)X0, (const char*)(WSP(bf16_t, WS_WIN) + (size_t)l * NZ * D), 64, 22, gc, (int)blockIdx.x, (size_t)256 * D * 2, (size_t)256 * D * 2, (KDUP_MASK >> 0) & 1};
                { const float* bin = (const float*)(sw + SW_BIN);
                  rs_t rv[5]; float bq[5];
#pragma unroll
                  for (int i = 0; i < 5; ++i) { const int q = F.tid + 512 * i, ui = __builtin_amdgcn_readfirstlane(q >> 8); Unit uu; const bool in = (ui < MAX_UNITS_PER_WG) && S.next(ui, uu);
                      rv[i] = rs0[in ? uu.pm * 256 + (q & 255) : 0]; bq[i] = bin[in ? uu.pn * 256 + (q & 255) : 0]; }
#pragma unroll
                  for (int i = 0; i < 5; ++i) { const int q = F.tid + 512 * i; if (q < MAX_UNITS_PER_WG * 256) { ((LAS float*)(F.lds + LDS_RST))[q] = rstd_of(rv[i]); ((LAS float*)(F.lds + LDS_BIAS))[q] = bq[i]; } } }
                __syncthreads();
                EpiIn E{WSP(bf16_t, WS_ZP), (const LAS float*)(F.lds + LDS_RST), (const LAS float*)(F.lds + LDS_BIAS)};
                pg8::gemm_phase(F.lds, D, D, D, S, E);
                if (l == 0 && gc == F.G) { F.refresh(); phase_convert_rest(F, 0); }
                if (l == 1 && TAIL_L1A > 0) { int j, n; idle_set(64 * 22, F.G, (int)blockIdx.x, j, n); if (j >= 0) { F.refresh(); conv_tail(F, j, n, 32 * I_UP, TAIL_L1A); } }
            } else phase_convert_rest(F, gc); } SEAM(pb + 0); }
        if (IN(pb + 1)) { REPEAT(pb + 1) { F.refresh(); phase_mix(F, l); } SEAM(pb + 1); }
        if (IN(pb + 2)) { REPEAT(pb + 2) { F.refresh();
            BranchOrder S{(const char*)WSP(bf16_t, WS_Y), (const char*)(WSP(bf16_t, WS_WBR) + (size_t)l * 3 * D * 512), F.G, (int)blockIdx.x};
            EpiBranch E{WSP(bf16_t, WS_ZP), kin(16) + (size_t)l * 3 * D, WSP(bf16_t, WS_MG)};
            pg8::gemm_phase(F.lds, 512, YW, 512, S, E); } SEAM(pb + 2); }
        if (IN(pb + 3)) { F.refresh();
            DenseOrder S{(const char*)WSP(bf16_t, WS_MG), (const char*)(WSP(bf16_t, WS_WOUT) + (size_t)l * D * D), 64, 4, F.G, (int)blockIdx.x, (size_t)256 * D * 2, (size_t)256 * D * 2, 0};
            EpiRes E{X0, X1, rs0 + T};
            pg8::gemm_phase(F.lds, D, D, D, S, E); SEAM(pb + 3); }
        if (IN(pb + 4)) { F.refresh(); phase_router(F, l, X1, rs0 + T); SEAM(pb + 4); }
        if (IN(pb + 5)) { REPEAT(pb + 5) { F.refresh();
            moe_tables(F, l);
            LAS int* tab = (LAS int*)(F.lds + LDS_TAB); const int ntile = tab[MT_NTILE]; const int* TOKL = WSP(int, WS_TOKL);
            { int tk[5]; bool ok[5]; float bq[5]; rs_t rv[5]; const float* bup = (const float*)(sw + SW_BUP); const rs_t* rsx = rs0 + T;
#pragma unroll
              for (int i = 0; i < 5; ++i) { const int q = F.tid + 512 * i, ui = q >> 8, r = q & 255, L = ui * F.G + F.vcu; const bool in = (q < MAX_UNITS_PER_WG * 256) && (L < ntile * 8);
                  const int tile = in ? (L >> 3) : 0, e = tab[MT_TE + tile], lr = (tile - tab[MT_TSTART + e]) * 256 + r; ok[i] = in && lr < tab[MT_CNT + e];
                  tk[i] = TOKL[e * T + (ok[i] ? lr : 0)]; bq[i] = bup[e * 2048 + (in ? (L & 7) : 0) * 256 + r]; }
#pragma unroll
              for (int i = 0; i < 5; ++i) rv[i] = rsx[ok[i] ? tk[i] : 0];
#pragma unroll
              for (int i = 0; i < 5; ++i) { const int q = F.tid + 512 * i; if (q < MAX_UNITS_PER_WG * 256) { ((LAS unsigned*)tab)[MT_TOKOFF + q] = ok[i] ? (unsigned)tk[i] * (unsigned)(D * 2) : 0u;
                  ((LAS float*)(F.lds + LDS_RST))[q] = rstd_of(rv[i]); ((LAS float*)(F.lds + LDS_BIAS))[q] = bq[i]; } } }
            __syncthreads();
            MoeOrder S{(const char*)X1, (const char*)(WSP(bf16_t, WS_WUP) + (size_t)l * NE * 2048 * D), tab + MT_TE, ntile * 8, 8, F.G, F.vcu, (size_t)2048 * D * 2, (size_t)256 * D * 2, 0, ntile * 8, 1};
            EpiUp E{WSP(bf16_t, WS_ACT), (const LAS float*)(F.lds + LDS_RST), (const LAS float*)(F.lds + LDS_BIAS)};
            pg8::gemm_phase<EpiUp, MoeOrder, true>(F.lds, D, D, D, S, E, (const LAS unsigned*)tab + MT_TOKOFF);
            { int j, n; idle_set(ntile * 8, F.G, F.vcu, j, n); F.refresh();
              DenseOrder S6{(const char*)(WSP(bf16_t, WS_PB) + (size_t)l * T * PLE), (const char*)(WSP(bf16_t, WS_WPP) + (size_t)l * D * PLE), 64, 4, n, j < 0 ? 256 : j, (size_t)256 * PLE * 2, (size_t)256 * PLE * 2, 0};
              EpiBf E6{WSP(bf16_t, WS_PP), nullptr, nullptr, 0};
              pg8::gemm_phase(F.lds, PLE, PLE, PLE, S6, E6);
              if (l == 0 && TAIL_XF4 > 0 && j >= 0) { F.refresh(); conv_tail(F, j, n, TAIL_XF, TAIL_XF4); }
              if (l == 1 && TAIL_L1B > 0 && j >= 0) { F.refresh(); conv_tail(F, j, n, 32 * I_UP + TAIL_L1A, TAIL_L1B); } } } SEAM(pb + 5); }
        if (IN(pb + 6)) { REPEAT(pb + 6) { F.refresh();
            moe_tables(F, l, SPLITK_TAIL && l == NL - 1);
            LAS int* tab = (LAS int*)(F.lds + LDS_TAB); const int ntile = tab[MT_NTILE];
            MoeOrder S{(const char*)WSP(bf16_t, WS_ACT), (const char*)(WSP(bf16_t, WS_WDN) + (size_t)l * NE * D * D), tab + MT_TE, ntile * 4, 4, F.G, F.vcu, (size_t)D * D * 2, (size_t)256 * D * 2, (size_t)256 * D * 2, tab[MT_NFULL], tab[MT_SPLIT]};
            { const float* bdn = kin(24) + (size_t)l * NE * D; float bq[5];
#pragma unroll
              for (int i = 0; i < 5; ++i) { const int q = F.tid + 512 * i, ui = __builtin_amdgcn_readfirstlane(q >> 8); Unit uu; const bool in = (ui < MAX_UNITS_PER_WG) && S.next(ui, uu) && ((uu.aux >> 8) == 0);
                  const float v = bdn[in ? (uu.aux & 255) * 1024 + uu.pn * 256 + (q & 255) : 0]; bq[i] = in ? v : 0.f; }
#pragma unroll
              for (int i = 0; i < 5; ++i) { const int q = F.tid + 512 * i; if (q < MAX_UNITS_PER_WG * 256) ((LAS float*)(F.lds + LDS_BIAS))[q] = bq[i]; } }
            __syncthreads();
            EpiBf E{WSP(bf16_t, WS_YE), (const LAS float*)(F.lds + LDS_BIAS), WSP(bf16_t, WS_YEX), tab[MT_TAILROW]};
            pg8::gemm_phase(F.lds, D, D, D, S, E);
            if (l == 0 && TAIL_XF > 0) { int j, n; idle_set(ntile * 4, F.G, F.vcu, j, n); if (j >= 0) { F.refresh(); conv_tail(F, j, n, 0, TAIL_XF); } } } SEAM(pb + 6); }
        if (IN(pb + 7)) { REPEAT(pb + 7) { F.refresh(); phase_combine(F, l, X1, X2, rs0 + 2 * T); } SEAM(pb + 7); }
        if (IN(pb + 8)) { F.refresh();
            DenseOrder S{(const char*)X2, (const char*)(WSP(bf16_t, WS_WPG) + (size_t)l * D * D), 64, 4, F.G, (int)blockIdx.x, (size_t)256 * D * 2, (size_t)256 * D * 2, 0};
            EpiPle E{X2, X0, WSP(bf16_t, WS_PP), rs0 + 2 * T, rs0 + 3 * T};
            pg8::gemm_phase(F.lds, D, D, D, S, E); SEAM(pb + 8); }
    }
    if (IN(N_PHASES - 1)) { F.refresh(); phase_final(F, X0, WSP(rs_t, WS_RS) + (size_t)(3 * NL) * T, F.out, kin(28)); }
#undef REPEAT
#undef IN
#undef SEAM
}

extern "C" void kernel_launch(void* const* d_in, const int* in_sizes, int n_in, void* d_out, int out_size, void* d_ws, size_t ws_size, hipStream_t stream) {
    static int grid = 0;
    if (grid == 0) {
        if (n_in != 29 || out_size != T * D || ws_size < WS_END) { fprintf(stderr, "kernel_launch: unexpected shapes (n_in %d out %d ws %zu)\n", n_in, out_size, ws_size); grid = -1; return; }
        int dev = 0, cus = 0, per_cu = 0;
        hipGetDevice(&dev); hipDeviceGetAttribute(&cus, hipDeviceAttributeMultiprocessorCount, dev);
        if (hipFuncSetAttribute((const void*)mega_fwd, hipFuncAttributeMaxDynamicSharedMemorySize, LDS_BYTES) != hipSuccess) { fprintf(stderr, "kernel_launch: hipFuncSetAttribute failed\n"); grid = -1; return; }
        if (hipOccupancyMaxActiveBlocksPerMultiprocessor(&per_cu, (const void*)mega_fwd, 512, LDS_BYTES) != hipSuccess || per_cu < 1) { fprintf(stderr, "kernel_launch: occupancy query says %d\n", per_cu); per_cu = 1; }
        (void)hipGetLastError();
        grid = cus;
    }
    if (grid < 0) return;
    hipMemsetAsync((char*)d_ws + WS_CTL, 0, CTL_ZERO_BYTES, stream);
    Args a{};
    for (int i = 0; i < 29; ++i) a.in[i] = (const float*)d_in[i];
    a.out = (float*)d_out; a.ws = (unsigned char*)d_ws;
#if MK_N_LAUNCHES == 1
    a.ph_lo = 0; a.ph_hi = N_PHASES; a.use_cg = 0;
    void* kargs[] = {&a};
    hipError_t e = hipLaunchCooperativeKernel((const void*)mega_fwd, dim3(grid), dim3(512), kargs, LDS_BYTES, stream);
    if (e != hipSuccess) fprintf(stderr, "cooperative launch failed: %s (grid %d)\n", hipGetErrorString(e), grid);
#else
    for (int ph = 0; ph < N_PHASES; ++ph) { a.ph_lo = ph; a.ph_hi = ph + 1; a.use_cg = 0;
        hipLaunchKernelGGL(mega_fwd, dim3(grid), dim3(512), LDS_BYTES, stream, a); }
#endif
}
```

```cpp
#include <hip/hip_runtime.h>
#include <hip/hip_cooperative_groups.h>
#include <cstdio>
#include <cstdint>
namespace cg = cooperative_groups;

#ifndef MK_N_LAUNCHES
#define MK_N_LAUNCHES 1
#endif

#define LAS __attribute__((address_space(3)))
#define GAS __attribute__((address_space(1)))
typedef unsigned short bf16_t;
typedef short bf16x8 __attribute__((ext_vector_type(8)));
typedef float f32x4 __attribute__((ext_vector_type(4)));
typedef float f32x16 __attribute__((ext_vector_type(16)));
typedef float f32x2 __attribute__((ext_vector_type(2)));
typedef int i32x4 __attribute__((ext_vector_type(4)));
typedef double f64x2 __attribute__((ext_vector_type(2)));
typedef unsigned u32x4 __attribute__((ext_vector_type(4)));
typedef unsigned u32x2 __attribute__((ext_vector_type(2)));

#ifndef SPLITK_TAIL
#define SPLITK_TAIL 1
#endif
constexpr int T = 16384, D = 1024, SEQ = 8192, NL = 2;
constexpr int NZ = 5632;
constexpr int ZPW = 5120;
constexpr int ZP_ZA = 0, ZP_GLU = 512, ZP_ZU = 1024, ZP_ZV = 1536, ZP_G = 2048;
constexpr int YW = 1536;
constexpr int NE = 32, TOPK = 4, PLE = 256, CONVK = 31;
constexpr int MAXTILES = 288, MAXROWS = MAXTILES * 256;
constexpr float EPS = 1e-6f;

constexpr size_t MiB = 1u << 20;
constexpr size_t WS_CTL = 0;
constexpr size_t WS_META = 1 * MiB;
constexpr size_t WS_TOPE = 2 * MiB;
constexpr size_t WS_TOPW = 3 * MiB;
constexpr size_t WS_SLOTOF = 4 * MiB;
constexpr size_t WS_SMALLW = 5 * MiB;
constexpr size_t SW_LAYER = 1 * MiB, SW_WPT = 0, SW_WSGU = 128 * 1024, SW_WRT = 256 * 1024, SW_BIN = 384 * 1024, SW_BUP = 512 * 1024;
constexpr size_t WS_WIN = 8 * MiB;
constexpr size_t WS_WBR = 32 * MiB;
constexpr size_t WS_WOUT = 40 * MiB;
constexpr size_t WS_WPG = 44 * MiB;
constexpr size_t WS_WPP = 48 * MiB;
constexpr size_t WS_PB = 50 * MiB;
constexpr size_t WS_WUP = 72 * MiB;
constexpr size_t WS_WDN = 328 * MiB;
constexpr size_t WS_XN = 456 * MiB;
constexpr size_t WS_ZP = 488 * MiB;
constexpr size_t WS_Y = 648 * MiB;
constexpr size_t WS_MG = 696 * MiB;
constexpr size_t WS_XG = 728 * MiB;
constexpr size_t WS_ACT = 872 * MiB;
constexpr size_t WS_YE = 1016 * MiB;
constexpr size_t WS_PP = 1160 * MiB;
constexpr size_t WS_YEX = 1192 * MiB;
constexpr size_t WS_END = 1288 * MiB;
constexpr size_t CTL_ZERO_BYTES = 32768;
constexpr int CW_BAR = 4096;
constexpr int CW_GCNT = 128;
constexpr size_t WS_TOKL = WS_XG;
constexpr size_t WS_X0 = WS_XN, WS_X1 = WS_XG + 16 * MiB, WS_X2 = WS_XG + 48 * MiB;
constexpr size_t WS_RS = WS_TOPE;

constexpr int RING_BYTES = 131072;
constexpr int LDS_TAB = RING_BYTES;
constexpr int LDS_RST = RING_BYTES + 11264;
constexpr int LDS_BIAS = LDS_RST + 9216;
constexpr int LDS_MISC = LDS_BIAS + 9216;
constexpr int LDS_BYTES = LDS_MISC + 256;
constexpr int MT_CNT = 0, MT_TSTART = 32, MT_NTILE = 96, MT_SPLIT = 97, MT_TAILROW = 98, MT_NFULL = 99, MT_TE = 128, MT_TOKOFF = 512, MAX_UNITS_PER_WG = 9;
constexpr int YEX_ROWS = 16384;

__device__ __forceinline__ unsigned f2bf(float f) { unsigned u = __builtin_bit_cast(unsigned, f); return (u + 0x7fffu + ((u >> 16) & 1u)) >> 16; }
__device__ __forceinline__ unsigned pk2(float lo, float hi) { unsigned r; asm("v_cvt_pk_bf16_f32 %0, %1, %2" : "=v"(r) : "v"(lo), "v"(hi)); return r; }
__device__ __forceinline__ float bflo(unsigned u) { return __builtin_bit_cast(float, u << 16); }
__device__ __forceinline__ float bfhi(unsigned u) { return __builtin_bit_cast(float, u & 0xffff0000u); }
typedef unsigned long long rs_t;
__device__ __forceinline__ rs_t rs_fix(float ss) { return (rs_t)(ss * 1048576.0f + 0.5f); }
__device__ __forceinline__ float rstd_of(rs_t q) { return __builtin_amdgcn_rsqf((float)q * (1.0f / (1048576.0f * 1024.0f)) + 1e-6f); }
__device__ __forceinline__ float sigmoidf_(float v) { return __builtin_amdgcn_rcpf(1.0f + __builtin_amdgcn_exp2f(-1.44269504089f * v)); }
__device__ __forceinline__ float vmin1e30(float x) { float r; asm("v_min_f32 %0, 0x7149f2ca, %1" : "=v"(r) : "v"(x)); return r; }
__device__ __forceinline__ float sig_t(float t) { return __builtin_amdgcn_rcpf(1.0f + __builtin_amdgcn_exp2f(t)); }
__device__ __forceinline__ float wave_sum(float v) {
#pragma unroll
    for (int o = 1; o < 64; o <<= 1) v += __shfl_xor(v, o);
    return v;
}
#ifndef WT_STORES
#define WT_STORES 0
#endif
__device__ __forceinline__ void st16(void* p, u32x4 v) {
#if WT_STORES
    asm volatile("global_store_dwordx4 %0, %1, off sc1\n\ts_nop 1" :: "v"(p), "v"(v) : "memory");
#else
    *(u32x4*)p = v;
#endif
}
#define LDS_WAIT() asm volatile("s_waitcnt lgkmcnt(0)" ::: "memory")
#define VM_WAIT() asm volatile("s_waitcnt vmcnt(0)" ::: "memory")

namespace pg8 {
constexpr int BM = 256, BK = 64, HALF = 128, HTB = HALF * BK * 2, NXCD = 8, WGM = 8;
__host__ __device__ __forceinline__ int lds_byte(int r, int c) { const int st = (r >> 4) * 2 + (c >> 5), rr = r & 15, cc = c & 31, ob = rr * 64 + cc * 2; return st * 1024 + (ob ^ (((ob >> 9) & 1) << 5)); }
__host__ __device__ __forceinline__ void stage_rc(int b, int& R, int& C) { const int st = b / 1024, sb = b % 1024, swz = sb ^ (((sb >> 9) & 1) << 5); R = (st >> 1) * 16 + swz / 64; C = (st & 1) * 32 + (swz % 64) / 2; }
__host__ __device__ __forceinline__ int perm32(int rho) { const int n = rho >> 4, i = rho & 15; return 8 * (i >> 2) + 4 * n + (i & 3); }

struct Unit { const char* A; const char* B; int pm, pn, aux, ord, nt; };

__device__ __forceinline__ void static_tile(int L, int nM, int nN, int& pm, int& pn) {
    const int nwg = nM * nN; int wgid = L;
    { const int q = nwg / NXCD, r = nwg % NXCD, xcd = wgid % NXCD, off = wgid / NXCD; wgid = (xcd < r ? xcd * (q + 1) : r * (q + 1) + (xcd - r) * q) + off; }
    const int nig = WGM * nN, gid = wgid / nig, fm = gid * WGM, gsz = (nM - fm) < WGM ? (nM - fm) : WGM;
    pm = fm + ((wgid % nig) % gsz); pn = (wgid % nig) / gsz;
}

template <class Epi, class Sched, bool GATHER = false>
__device__ __forceinline__ void gemm_phase(LAS unsigned char* lds, const int K_, const int lda, const int ldb, const Sched& S, const Epi& E, const LAS unsigned* gtab = nullptr) {
    int K = K_; asm volatile("" : "+s"(K));
    int tid_ = threadIdx.x; asm volatile("" : "+v"(tid_));
    const int tid = tid_, wid = __builtin_amdgcn_readfirstlane(tid >> 6), lane = tid & 63, wr = wid >> 2, wc = wid & 3, fr = lane & 15, fq = lane >> 4;
    const int nt0 = K / BK;
    unsigned voffA[2], voffB[2], gR[2], gC[2], vC[2][2], vN[2][2], vs[2][2];
#pragma unroll
    for (int i = 0; i < 2; ++i) { int R, C; stage_rc(tid * 16 + i * 8192, R, C); const int Rb = Epi::PERM ? ((R & ~31) + perm32(R & 31)) : R;
        voffA[i] = (unsigned)(R * lda + C) * 2u; voffB[i] = (unsigned)(Rb * ldb + C) * 2u; gR[i] = (unsigned)R; gC[i] = (unsigned)C * 2u; }
#define PG8_GLOAD(dst, u) do { _Pragma("unroll") for (int _h = 0; _h < 2; ++_h) _Pragma("unroll") for (int _i = 0; _i < 2; ++_i) dst[_h][_i] = gtab[(u) * 256 + _h * 128 + gR[_i]] + gC[_i]; } while (0)
#define PG8_STAGE_A(bufoff, h, gbase, VO) do { if constexpr (GATHER) { PG8_STAGE(bufoff, gbase, VO[h]); } else { PG8_STAGE(bufoff, (gbase) + (h) * hstepA, voffA); } } while (0)
    const size_t kstep = (size_t)(BK * 2);
    const size_t hstepA = (size_t)HALF * lda * 2, hstepB = (size_t)HALF * ldb * 2;
    const unsigned ldsw = (unsigned)wid * 1024u;
    const int aoff = lds_byte(wr * 64 + fr, fq * 8), boff = lds_byte(wc * 32 + fr, fq * 8);
#define PG8_SA(b, h) (((b) * 2 + (h)) * HTB)
#define PG8_SB(b, h) ((4 + (b) * 2 + (h)) * HTB)
#define PG8_STAGE(bufoff, gbase, voff) do { _Pragma("unroll") for (int _i = 0; _i < 2; ++_i) \
        __builtin_amdgcn_global_load_lds((const unsigned*)((const char*)(gbase) + (voff)[_i]), (LAS unsigned*)(lds + (bufoff) + ldsw + _i * 8192), 16, 0, 0); } while (0)
#define PG8_LDA(dst, b, h) do { _Pragma("unroll") for (int m = 0; m < 4; ++m) _Pragma("unroll") for (int k = 0; k < 2; ++k) dst[m][k] = *(const LAS bf16x8*)(lds + PG8_SA(b, h) + aoff + m * 2048 + k * 1024); } while (0)
#define PG8_LDB(dst, b, h) do { _Pragma("unroll") for (int n = 0; n < 2; ++n) _Pragma("unroll") for (int k = 0; k < 2; ++k) dst[n][k] = *(const LAS bf16x8*)(lds + PG8_SB(b, h) + boff + n * 2048 + k * 1024); } while (0)
#define PG8_MMA(ai, bj, At, Bt) do { __builtin_amdgcn_s_setprio(1); _Pragma("unroll") for (int m = 0; m < 4; ++m) _Pragma("unroll") for (int n = 0; n < 2; ++n) _Pragma("unroll") for (int k = 0; k < 2; ++k) \
        acc[ai][bj][m][n] = __builtin_amdgcn_mfma_f32_16x16x32_bf16(Bt[n][k], At[m][k], acc[ai][bj][m][n], 0, 0, 0); __builtin_amdgcn_s_setprio(0); } while (0)
#define PG8_WAIT_V(n) asm volatile("s_waitcnt vmcnt(" #n ")" ::: "memory")
#define PG8_WAIT_L(n) asm volatile("s_waitcnt lgkmcnt(" #n ")" ::: "memory")
#define PG8_BAR __builtin_amdgcn_s_barrier()
#define PG8_SCHED __builtin_amdgcn_sched_barrier(0)
    Unit cur, nxt; int ui = 0;
    if (!S.next(0, cur)) return;
    f32x4 acc[2][2][4][2];
#pragma unroll
    for (int a = 0; a < 2; ++a)
#pragma unroll
        for (int b = 0; b < 2; ++b)
#pragma unroll
            for (int m = 0; m < 4; ++m)
#pragma unroll
                for (int n = 0; n < 2; ++n) acc[a][b][m][n] = (f32x4){0.f, 0.f, 0.f, 0.f};
    bf16x8 At[4][2], B0[2][2], B1[2][2];
    const char* cA = cur.A; const char* cB = cur.B;
    if constexpr (GATHER) PG8_GLOAD(vC, 0);
    PG8_STAGE(PG8_SB(0, 0), cB, voffB); PG8_STAGE(PG8_SB(0, 1), cB + hstepB, voffB); PG8_STAGE_A(PG8_SA(0, 0), 0, cA, vC); PG8_STAGE_A(PG8_SA(0, 1), 1, cA, vC);
    if (wr == 1) PG8_BAR;
    PG8_WAIT_V(2); PG8_BAR;
    PG8_STAGE(PG8_SB(1, 0), cB + kstep, voffB); PG8_STAGE_A(PG8_SA(1, 0), 0, cA + kstep, vC); PG8_STAGE(PG8_SB(1, 1), cB + hstepB + kstep, voffB);
    PG8_WAIT_V(6); PG8_BAR;
    for (;;) {
        const bool has_next = S.next(ui + 1, nxt);
        const char* nA = has_next ? nxt.A : cA; const char* nB = has_next ? nxt.B : cB;
        if constexpr (GATHER) { if (has_next) PG8_GLOAD(vN, ui + 1); else {
#pragma unroll
            for (int _h = 0; _h < 2; ++_h)
#pragma unroll
                for (int _i = 0; _i < 2; ++_i) vN[_h][_i] = vC[_h][_i]; } }
        const int nt = cur.nt > 0 ? cur.nt : nt0;
        for (int t = 0; t < nt; t += 2) {
            const bool last = (t == nt - 2);
            if constexpr (GATHER) {
#pragma unroll
                for (int _h = 0; _h < 2; ++_h)
#pragma unroll
                    for (int _i = 0; _i < 2; ++_i) vs[_h][_i] = last ? vN[_h][_i] : vC[_h][_i]; }
            const char* a1 = cA + (size_t)(t + 1) * kstep;
            const char* a2 = last ? nA : cA + (size_t)(t + 2) * kstep; const char* b2 = last ? nB : cB + (size_t)(t + 2) * kstep;
            const char* a3 = a2 + kstep; const char* b3 = b2 + kstep;
            PG8_LDB(B0, 0, 0); PG8_LDB(B1, 0, 1); PG8_SCHED; PG8_LDA(At, 0, 0); PG8_STAGE_A(PG8_SA(1, 1), 1, a1, vC);
            PG8_WAIT_V(8); PG8_WAIT_L(0); PG8_BAR; PG8_MMA(0, 0, At, B0); PG8_MMA(0, 1, At, B1); PG8_BAR; PG8_SCHED;
            PG8_LDA(At, 0, 1); PG8_STAGE(PG8_SB(0, 0), b2, voffB); PG8_STAGE(PG8_SB(0, 1), b2 + hstepB, voffB); PG8_STAGE_A(PG8_SA(0, 0), 0, a2, vs);
            PG8_WAIT_V(8); PG8_WAIT_L(0); PG8_BAR; PG8_MMA(1, 0, At, B0); PG8_MMA(1, 1, At, B1); PG8_BAR; PG8_SCHED;
            PG8_LDB(B0, 1, 0); PG8_LDB(B1, 1, 1); PG8_SCHED; PG8_LDA(At, 1, 0); PG8_STAGE_A(PG8_SA(0, 1), 1, a2, vs);
            PG8_WAIT_V(8); PG8_WAIT_L(0); PG8_BAR; PG8_MMA(0, 0, At, B0); PG8_MMA(0, 1, At, B1); PG8_BAR; PG8_SCHED;
            PG8_LDA(At, 1, 1); PG8_STAGE(PG8_SB(1, 0), b3, voffB); PG8_STAGE(PG8_SB(1, 1), b3 + hstepB, voffB); PG8_STAGE_A(PG8_SA(1, 0), 0, a3, vs);
            PG8_WAIT_V(8); PG8_WAIT_L(0); PG8_BAR; PG8_MMA(1, 0, At, B0); PG8_MMA(1, 1, At, B1); PG8_BAR; PG8_SCHED;
        }
        if (wr == 0) PG8_BAR;
        bool zero = true; if (cur.aux >= 0) { if constexpr (Epi::EDUP) { (void)E(acc, cur, wr, wc, fr, fq); asm volatile("" ::: "memory"); } zero = E(acc, cur, wr, wc, fr, fq); }
        if constexpr (Epi::DRAIN) __builtin_amdgcn_s_waitcnt(0x0F70);
        if (!has_next) break;
        if (zero) {
#pragma unroll
            for (int a = 0; a < 2; ++a)
#pragma unroll
                for (int b = 0; b < 2; ++b)
#pragma unroll
                    for (int m = 0; m < 4; ++m)
#pragma unroll
                        for (int n = 0; n < 2; ++n) { f64x2 z; asm volatile("v_mov_b64 %0, 0\n\tv_mov_b64 %1, 0" : "=v"(z.x), "=v"(z.y)); acc[a][b][m][n] = __builtin_bit_cast(f32x4, z); }
        }
        cur = nxt; cA = nA; cB = nB; ++ui;
        if constexpr (GATHER) {
#pragma unroll
            for (int _h = 0; _h < 2; ++_h)
#pragma unroll
                for (int _i = 0; _i < 2; ++_i) vC[_h][_i] = vN[_h][_i]; }
        if (wr == 1) PG8_BAR;
    }
    PG8_WAIT_V(0);
    PG8_BAR;
#undef PG8_SA
#undef PG8_SB
#undef PG8_STAGE
#undef PG8_STAGE_A
#undef PG8_GLOAD
#undef PG8_LDA
#undef PG8_LDB
#undef PG8_MMA
#undef PG8_WAIT_V
#undef PG8_WAIT_L
#undef PG8_BAR
#undef PG8_SCHED
}
}
using pg8::Unit;


struct DenseOrder {
    const char* A; const char* B; int nM, nN, G, c; size_t astep, bstep; int dup;
    __device__ __forceinline__ bool next(int i, Unit& u) const {
        const int L = (dup ? (i >> 1) : i) * G + c; if (L >= nM * nN) return false;
        int pm, pn; pg8::static_tile(L, nM, nN, pm, pn);
        u.pm = pm; u.pn = pn; u.ord = i; u.nt = 0; u.aux = (dup && !(i & 1)) ? -1 : 0; u.A = A + (size_t)pm * astep; u.B = B + (size_t)pn * bstep; return true;
    }
};
struct BranchOrder {
    const char* Y; const char* W; int G, c;
    __device__ __forceinline__ bool next(int i, Unit& u) const {
        const int tl = (i / 3) * G + c; if (tl >= 256) return false;
        int pm, pn; pg8::static_tile(tl, 64, 4, pm, pn); const int br = i % 3;
        u.pm = pm; u.pn = pn; u.ord = i; u.nt = 0; u.aux = br; u.A = Y + ((size_t)pm * 256 * YW + (size_t)br * 512) * 2; u.B = W + ((size_t)br * 1024 * 512 + (size_t)pn * 256 * 512) * 2; return true;
    }
};
struct MoeOrder {
    const char* A; const char* W; const LAS int* tile_e; int n_units, NP, G, c; size_t wstride, bstep, astep;
    int n_full, split;
    __device__ __forceinline__ bool next(int i, Unit& u) const {
        int L = i * G + c, q = 0, nq = 1;
        if (L >= n_full && split > 1) { const int j = L - n_full; L = n_full + j / split; q = j % split; nq = split; }
        if (L >= n_units) return false;
        const int tile = L / NP, pn = L - tile * NP; const int e = tile_e[tile];
        const size_t koff = (size_t)q * (1024 / nq) * 2;
        u.pm = tile; u.pn = pn; u.ord = i; u.aux = e | (q << 8); u.nt = 16 / nq; u.A = A + (size_t)tile * astep + koff; u.B = W + (size_t)e * wstride + (size_t)pn * bstep + koff; return true;
    }
};

typedef f32x4 Acc[2][2][4][2];
#ifndef EDUP_IN
#define EDUP_IN 0
#endif
#ifndef EDUP_UP
#define EDUP_UP 0
#endif
struct EpiIn {
    static constexpr bool PERM = true, DRAIN = false, EDUP = (EDUP_IN != 0);
    bf16_t* ZP; const LAS float* rst; const LAS float* bia; bf16_t* GB;
    __device__ __forceinline__ bool operator()(Acc& acc, const Unit& u, int wr, int wc, int fr, int fq) const {
        const int row0 = u.pm * 256 + wr * 64 + fr, pn = u.pn, cl = wc * 32 + 8 * fq;
        float rsv[2][4];
#pragma unroll
        for (int ai = 0; ai < 2; ++ai)
#pragma unroll
            for (int m = 0; m < 4; ++m) rsv[ai][m] = rst[u.ord * 256 + wr * 64 + fr + ai * 128 + m * 16];
        const LAS float* bp = bia + u.ord * 256 + cl;
        f32x4 bv[2][2];
#pragma unroll
        for (int bj = 0; bj < 2; ++bj)
#pragma unroll
            for (int n = 0; n < 2; ++n) bv[bj][n] = *(const LAS f32x4*)(bp + bj * 128 + 4 * n);
        constexpr float NL2E = -1.44269504089f;
        if (pn >= 2 && pn < 6) {
            bf16_t* base = ZP + ZP_GLU + (pn - 2) * 128 + cl;
            const f32x4 bg0 = bv[1][0] * NL2E, bg1 = bv[1][1] * NL2E;
#pragma unroll
            for (int ai = 0; ai < 2; ++ai)
#pragma unroll
                for (int m = 0; m < 4; ++m) { float o[8]; const float rc = rsv[ai][m] * NL2E;
#pragma unroll
                    for (int n = 0; n < 2; ++n) { const f32x4 a = acc[ai][0][m][n] * rsv[ai][m] + bv[0][n], t = acc[ai][1][m][n] * rc + (n ? bg1 : bg0);
#pragma unroll
                        for (int j = 0; j < 4; ++j) o[4 * n + j] = a[j] * __builtin_amdgcn_rcpf(1.0f + __builtin_amdgcn_exp2f(t[j])); }
                    u32x4 w; w.x = pk2(o[0], o[1]); w.y = pk2(o[2], o[3]); w.z = pk2(o[4], o[5]); w.w = pk2(o[6], o[7]);
                    st16(base + (size_t)(row0 + ai * 128 + m * 16) * ZPW, w); }
        } else if (pn >= 10) {
            char* gblk = (char*)GB + (size_t)((u.pm * 3 + ((pn - 10) >> 2)) * 4 + ((pn - 10) & 3)) * 131072 + (wr * 4 + wc) * 1024 + (fq * 16 + fr) * 16;
            f32x4 bq[2][2];
#pragma unroll
            for (int bj = 0; bj < 2; ++bj)
#pragma unroll
                for (int n = 0; n < 2; ++n) bq[bj][n] = bv[bj][n] * NL2E;
#pragma unroll
            for (int ai = 0; ai < 2; ++ai)
#pragma unroll
                for (int m = 0; m < 4; ++m) { const float rc = rsv[ai][m] * NL2E;
#pragma unroll
                    for (int bj = 0; bj < 2; ++bj) { const f32x4 t0 = acc[ai][bj][m][0] * rc + bq[bj][0], t1 = acc[ai][bj][m][1] * rc + bq[bj][1]; f32x4 v0, v1;
#pragma unroll
                        for (int j = 0; j < 4; ++j) { v0[j] = __builtin_amdgcn_exp2f(t0[j]); v1[j] = __builtin_amdgcn_exp2f(t1[j]); }
                        v0 = v0 + 1.0f; v1 = v1 + 1.0f;
                        u32x4 w; w.x = pk2(v0[0], v0[1]); w.y = pk2(v0[2], v0[3]); w.z = pk2(v1[0], v1[1]); w.w = pk2(v1[2], v1[3]);
                        st16(gblk + ((ai * 4 + m) * 2 + bj) * 8192, w); } }
        } else {
            const int dc = (pn < 2 ? pn * 256 : (pn - 2) * 256 + 0) ;
            bf16_t* base = ZP + dc + cl;
#pragma unroll
            for (int ai = 0; ai < 2; ++ai)
#pragma unroll
                for (int m = 0; m < 4; ++m)
#pragma unroll
                    for (int bj = 0; bj < 2; ++bj) { const f32x4 v0 = acc[ai][bj][m][0] * rsv[ai][m] + bv[bj][0], v1 = acc[ai][bj][m][1] * rsv[ai][m] + bv[bj][1];
                        u32x4 w; w.x = pk2(v0[0], v0[1]); w.y = pk2(v0[2], v0[3]); w.z = pk2(v1[0], v1[1]); w.w = pk2(v1[2], v1[3]);
                        st16(base + (size_t)(row0 + ai * 128 + m * 16) * ZPW + bj * 128, w); }
        }
        return true;
    }
};
#ifndef GRND
#define GRND 3
#endif
struct EpiBranch {
    static constexpr bool PERM = true, DRAIN = false, EDUP = false;
    const bf16_t* ZP; const float* bb; bf16_t* MG;
    __device__ __forceinline__ bool operator()(Acc& acc, const Unit& u, int wr, int wc, int fr, int fq) const {
        const int row0 = u.pm * 256 + wr * 64 + fr, c0 = u.pn * 256 + wc * 32 + 8 * fq, br = u.aux;
        f32x4 bv[2][2];
#pragma unroll
        for (int bj = 0; bj < 2; ++bj)
#pragma unroll
            for (int n = 0; n < 2; ++n) bv[bj][n] = *(const f32x4*)(bb + br * 1024 + c0 + bj * 128 + 4 * n);
        const char* gp = (const char*)ZP + (size_t)((u.pm * 3 + br) * 4 + u.pn) * 131072 + (wr * 4 + wc) * 1024 + (fq * 16 + fr) * 16;
#pragma unroll
        for (int r0 = 0; r0 < 8; r0 += GRND) {
            u32x4 ga[GRND][2], gb[GRND][2];
#pragma unroll
            for (int rr = 0; rr < GRND; ++rr) if (r0 + rr < 8)
#pragma unroll
                for (int bj = 0; bj < 2; ++bj) { const size_t go = (size_t)((r0 + rr) * 2 + bj) * 8192;
                    ga[rr][bj] = *(const u32x4*)(gp + go); gb[rr][bj] = *(const u32x4*)(gp + (br < 2 ? 4 * 131072 : 0) + go); }
            __builtin_amdgcn_sched_barrier(0);
#pragma unroll
            for (int rr = 0; rr < GRND; ++rr) if (r0 + rr < 8) { const int ai = (r0 + rr) >> 2, m = (r0 + rr) & 3;
                const size_t ro = (size_t)(row0 + ai * 128 + m * 16);
#pragma unroll
                for (int bj = 0; bj < 2; ++bj) {
                    float f[8];
                    if (br < 2) {
#pragma unroll
                        for (int q = 0; q < 4; ++q) { f[2 * q] = vmin1e30(bflo(gb[rr][bj][q])) * __builtin_amdgcn_rcpf(bflo(ga[rr][bj][q])); f[2 * q + 1] = vmin1e30(bfhi(gb[rr][bj][q])) * __builtin_amdgcn_rcpf(bfhi(ga[rr][bj][q])); }
                    } else {
#pragma unroll
                        for (int q = 0; q < 4; ++q) { f[2 * q] = __builtin_amdgcn_rcpf(bflo(ga[rr][bj][q])); f[2 * q + 1] = __builtin_amdgcn_rcpf(bfhi(ga[rr][bj][q])); } }
#pragma unroll
                    for (int n = 0; n < 2; ++n)
#pragma unroll
                        for (int j = 0; j < 4; ++j) acc[ai][bj][m][n][j] = (acc[ai][bj][m][n][j] + bv[bj][n][j]) * f[4 * n + j];
                    if (br == 2) { const f32x4 v0 = acc[ai][bj][m][0], v1 = acc[ai][bj][m][1];
                        u32x4 w; w.x = pk2(v0[0], v0[1]); w.y = pk2(v0[2], v0[3]); w.z = pk2(v1[0], v1[1]); w.w = pk2(v1[2], v1[3]);
                        st16(MG + ro * D + c0 + bj * 128, w); }
                }
            }
            asm volatile("" ::: "memory");
        }
        return br == 2;
    }
};
struct EpiRes {
    static constexpr bool PERM = true, DRAIN = false, EDUP = false;
    const bf16_t* xin; bf16_t* xout; rs_t* rsout;
    __device__ __forceinline__ bool operator()(Acc& acc, const Unit& u, int wr, int wc, int fr, int fq) const {
        const int row0 = u.pm * 256 + wr * 64 + fr, c0 = u.pn * 256 + wc * 32 + 8 * fq;
#pragma unroll
        for (int ai = 0; ai < 2; ++ai) {
            u32x4 xv[4][2];
#pragma unroll
            for (int m = 0; m < 4; ++m)
#pragma unroll
                for (int bj = 0; bj < 2; ++bj) xv[m][bj] = *(const u32x4*)(xin + (size_t)(row0 + ai * 128 + m * 16) * D + c0 + bj * 128);
            __builtin_amdgcn_sched_barrier(0);
#pragma unroll
            for (int m = 0; m < 4; ++m) { const int r = row0 + ai * 128 + m * 16; float ss = 0.f;
#pragma unroll
                for (int bj = 0; bj < 2; ++bj) { const u32x4 x = xv[m][bj]; f32x4 v0 = acc[ai][bj][m][0], v1 = acc[ai][bj][m][1];
                    v0[0] += bflo(x.x); v0[1] += bfhi(x.x); v0[2] += bflo(x.y); v0[3] += bfhi(x.y); v1[0] += bflo(x.z); v1[1] += bfhi(x.z); v1[2] += bflo(x.w); v1[3] += bfhi(x.w);
                    ss += ((v0[0] * v0[0] + v0[1] * v0[1]) + (v0[2] * v0[2] + v0[3] * v0[3])) + ((v1[0] * v1[0] + v1[1] * v1[1]) + (v1[2] * v1[2] + v1[3] * v1[3]));
                    u32x4 w; w.x = pk2(v0[0], v0[1]); w.y = pk2(v0[2], v0[3]); w.z = pk2(v1[0], v1[1]); w.w = pk2(v1[2], v1[3]);
                    st16(xout + (size_t)r * D + c0 + bj * 128, w); }
                ss += __shfl_xor(ss, 16); ss += __shfl_xor(ss, 32);
                if (fq == 0) atomicAdd(rsout + r, rs_fix(ss)); }
            asm volatile("" ::: "memory"); }
        return true;
    }
};
struct EpiUp {
    static constexpr bool PERM = true, DRAIN = false, EDUP = (EDUP_UP != 0);
    bf16_t* ACT; const LAS float* rst; const LAS float* bia;
    __device__ __forceinline__ bool operator()(Acc& acc, const Unit& u, int wr, int wc, int fr, int fq) const {
        const int row0 = u.pm * 256 + wr * 64 + fr, cl = wc * 32 + 8 * fq;
        float rsv[2][4];
#pragma unroll
        for (int ai = 0; ai < 2; ++ai)
#pragma unroll
            for (int m = 0; m < 4; ++m) rsv[ai][m] = rst[u.ord * 256 + ai * 128 + wr * 64 + m * 16 + fr];
        const LAS float* bp = bia + u.ord * 256 + cl;
        f32x4 bg[2], bl[2];
#pragma unroll
        for (int n = 0; n < 2; ++n) { bg[n] = *(const LAS f32x4*)(bp + 4 * n); bl[n] = *(const LAS f32x4*)(bp + 128 + 4 * n); }
        bf16_t* base = ACT + u.pn * 128 + cl;
#pragma unroll
        for (int ai = 0; ai < 2; ++ai)
#pragma unroll
            for (int m = 0; m < 4; ++m) { unsigned o[4]; const f32x2 r2 = {rsv[ai][m], rsv[ai][m]};
#pragma unroll
                for (int n = 0; n < 2; ++n)
#pragma unroll
                    for (int h = 0; h < 2; ++h) {
                        const f32x2 a0 = {acc[ai][0][m][n][2 * h], acc[ai][0][m][n][2 * h + 1]}, a1 = {acc[ai][1][m][n][2 * h], acc[ai][1][m][n][2 * h + 1]};
                        const f32x2 b0 = {bg[n][2 * h], bg[n][2 * h + 1]}, b1 = {bl[n][2 * h], bl[n][2 * h + 1]};
                        f32x2 g = a0 * r2 + b0, l = a1 * r2 + b1;
                        g.x = fminf(g.x, 7.0f); g.y = fminf(g.y, 7.0f);
                        l.x = __builtin_amdgcn_fmed3f(l.x, -7.0f, 7.0f); l.y = __builtin_amdgcn_fmed3f(l.y, -7.0f, 7.0f);
                        const f32x2 t = g * (f32x2){-1.702f * 1.44269504089f, -1.702f * 1.44269504089f};
                        f32x2 d = {__builtin_amdgcn_exp2f(t.x), __builtin_amdgcn_exp2f(t.y)};
                        d = d + (f32x2){1.0f, 1.0f};
                        const f32x2 sg = {__builtin_amdgcn_rcpf(d.x), __builtin_amdgcn_rcpf(d.y)};
                        const f32x2 a = g * sg, ov = a * l + a;
                        o[2 * n + h] = pk2(ov.x, ov.y); }
                u32x4 w; w.x = o[0]; w.y = o[1]; w.z = o[2]; w.w = o[3];
                st16(base + (size_t)(row0 + ai * 128 + m * 16) * D, w); }
        return true;
    }
};
struct EpiBf {
    static constexpr bool PERM = true, DRAIN = false, EDUP = false;
    bf16_t* O; const LAS float* bia; bf16_t* OX; int tail_row0; int blk = 0;
    __device__ __forceinline__ bool operator()(Acc& acc, const Unit& u, int wr, int wc, int fr, int fq) const {
        const int row0 = u.pm * 256 + wr * 64 + fr, c0 = u.pn * 256 + wc * 32 + 8 * fq, e = u.aux & 255, q = (u.aux >> 8) & 3;
        f32x4 bv[2][2];
#pragma unroll
        for (int bj = 0; bj < 2; ++bj)
#pragma unroll
            for (int n = 0; n < 2; ++n) bv[bj][n] = bia ? *(const LAS f32x4*)(bia + u.ord * 256 + wc * 32 + 8 * fq + bj * 128 + 4 * n) : (f32x4){0.f, 0.f, 0.f, 0.f};
        bf16_t* ob = (q == 0) ? O + (size_t)row0 * D : OX + ((size_t)(q - 1) * YEX_ROWS + (size_t)(row0 - tail_row0)) * D;
#pragma unroll
        for (int ai = 0; ai < 2; ++ai)
#pragma unroll
            for (int m = 0; m < 4; ++m)
#pragma unroll
                for (int bj = 0; bj < 2; ++bj) { const f32x4 v0 = acc[ai][bj][m][0] + bv[bj][0], v1 = acc[ai][bj][m][1] + bv[bj][1];
                    u32x4 w; w.x = pk2(v0[0], v0[1]); w.y = pk2(v0[2], v0[3]); w.z = pk2(v1[0], v1[1]); w.w = pk2(v1[2], v1[3]);
                    if (blk) st16((char*)O + (size_t)(u.pm * 4 + u.pn) * 131072 + ((ai * 4 + m) * 2 + bj) * 8192 + (wr * 4 + wc) * 1024 + (fq * 16 + fr) * 16, w);
                    else st16(ob + (size_t)(ai * 128 + m * 16) * D + c0 + bj * 128, w); }
        return true;
    }
};
struct EpiPle {
    static constexpr bool PERM = true, DRAIN = false, EDUP = false;
    const bf16_t* xin; bf16_t* xout; const bf16_t* PP; const rs_t* rs; rs_t* rsout;
    __device__ __forceinline__ bool operator()(Acc& acc, const Unit& u, int wr, int wc, int fr, int fq) const {
        const int row0 = u.pm * 256 + wr * 64 + fr, c0 = u.pn * 256 + wc * 32 + 8 * fq;
#pragma unroll
        for (int am = 0; am < 4; ++am) { const int ai = am >> 1, m0 = (am & 1) * 2;
            u32x4 xv[2][2], pv[2][2]; float rsv[2];
#pragma unroll
            for (int mm = 0; mm < 2; ++mm) { const int r = row0 + ai * 128 + (m0 + mm) * 16; rsv[mm] = rstd_of(rs[r]) * -1.44269504089f;
#pragma unroll
                for (int bj = 0; bj < 2; ++bj) { xv[mm][bj] = *(const u32x4*)(xin + (size_t)r * D + c0 + bj * 128); pv[mm][bj] = *(const u32x4*)((const char*)PP + (size_t)(u.pm * 4 + u.pn) * 131072 + ((ai * 4 + m0 + mm) * 2 + bj) * 8192 + (wr * 4 + wc) * 1024 + (fq * 16 + fr) * 16); } }
            __builtin_amdgcn_sched_barrier(0);
#pragma unroll
            for (int mm = 0; mm < 2; ++mm) { const int m = m0 + mm, r = row0 + ai * 128 + m * 16; float ss = 0.f;
#pragma unroll
                for (int bj = 0; bj < 2; ++bj) { const u32x4 x = xv[mm][bj], p = pv[mm][bj]; const f32x4 a0 = acc[ai][bj][m][0] * rsv[mm], a1 = acc[ai][bj][m][1] * rsv[mm]; float v[8];
                    v[0] = bflo(x.x) + sig_t(a0[0]) * bflo(p.x); v[1] = bfhi(x.x) + sig_t(a0[1]) * bfhi(p.x); v[2] = bflo(x.y) + sig_t(a0[2]) * bflo(p.y); v[3] = bfhi(x.y) + sig_t(a0[3]) * bfhi(p.y);
                    v[4] = bflo(x.z) + sig_t(a1[0]) * bflo(p.z); v[5] = bfhi(x.z) + sig_t(a1[1]) * bfhi(p.z); v[6] = bflo(x.w) + sig_t(a1[2]) * bflo(p.w); v[7] = bfhi(x.w) + sig_t(a1[3]) * bfhi(p.w);
                    ss += ((v[0] * v[0] + v[1] * v[1]) + (v[2] * v[2] + v[3] * v[3])) + ((v[4] * v[4] + v[5] * v[5]) + (v[6] * v[6] + v[7] * v[7]));
                    u32x4 w; w.x = pk2(v[0], v[1]); w.y = pk2(v[2], v[3]); w.z = pk2(v[4], v[5]); w.w = pk2(v[6], v[7]);
                    st16(xout + (size_t)r * D + c0 + bj * 128, w); }
                ss += __shfl_xor(ss, 16); ss += __shfl_xor(ss, 32);
                if (fq == 0) atomicAdd(rsout + r, rs_fix(ss)); }
            asm volatile("" ::: "memory"); }
        return true;
    }
};

#define XB_TMO      128
#define XB_XCNT(j)  (256  + 64 * (j))
#define XB_XSUB(j)  (1280 + 64 * (j))
#define XB_XGEN(j)  (2304 + 64 * (j))
#define XB_TOP      3328
#define XB_TOPGEN   3392
#define XCD_BAR_WORDS 3456
#define XB_SPIN_CAP (1u << 22)
__device__ __forceinline__ unsigned xb_ld(unsigned* p)              { return __hip_atomic_load(p, __ATOMIC_RELAXED, __HIP_MEMORY_SCOPE_AGENT); }
__device__ __forceinline__ unsigned xb_add(unsigned* p, unsigned v) { return __hip_atomic_fetch_add(p, v, __ATOMIC_RELAXED, __HIP_MEMORY_SCOPE_AGENT); }
__device__ __forceinline__ unsigned xb_xcc_id() { return (unsigned)__builtin_amdgcn_s_getreg((3 << 11) | 20) & 0xFu; }
#define XB_SPIN(cond, bar) do { unsigned _sp = 0; while (cond) { __builtin_amdgcn_s_sleep(1); \
    if ((++_sp & 255u) == 0u) { if (xb_ld(&(bar)[XB_TMO])) break; if (_sp > XB_SPIN_CAP) { atomicAdd(&(bar)[XB_TMO], 1u); break; } } } } while (0)
struct XcdBarrier { unsigned* bar; unsigned x; volatile LAS unsigned* st; };
__device__ __forceinline__ XcdBarrier xcd_barrier_post(unsigned* bar, volatile LAS unsigned* st) {
    XcdBarrier b; b.bar = bar; b.x = xb_xcc_id(); b.st = st;
    if (threadIdx.x == 0) (void)xb_add(&bar[XB_XCNT(b.x)], 1u);
    return b;
}
__device__ __forceinline__ void xcd_barrier_complete(unsigned* bar, unsigned x, unsigned& nloc, unsigned& nx) {
    const unsigned G = gridDim.x * gridDim.y * gridDim.z;
    unsigned sum, cnt, mine, sp = 0u;
    for (;;) {
        sum = 0u; cnt = 0u; mine = 0u;
#pragma unroll
        for (unsigned j = 0; j < 16; ++j) { const unsigned c = xb_ld(&bar[XB_XCNT(j)]); sum += c; cnt += (c > 0u) ? 1u : 0u; mine = (j == x) ? c : mine; }
        if (sum == G) break;
        __builtin_amdgcn_s_sleep(1);
        if ((++sp & 255u) == 0u) { if (xb_ld(&bar[XB_TMO])) break; if (sp > XB_SPIN_CAP) { atomicAdd(&bar[XB_TMO], 1u); break; } }
    }
    nloc = mine > 0u ? mine : 1u; nx = cnt > 0u ? cnt : 1u;
}
__device__ __forceinline__ void xcd_barrier(const XcdBarrier& b) {
    asm volatile("s_waitcnt vmcnt(0)" ::: "memory");
    __syncthreads();
    if (threadIdx.x == 0) {
        unsigned* bar = b.bar;
        __builtin_amdgcn_s_waitcnt(0);
        unsigned nloc = b.st[0], nx = b.st[1];
        if (nloc == 0u) { xcd_barrier_complete(bar, b.x, nloc, nx); b.st[0] = nloc; b.st[1] = nx; }
        const unsigned old = xb_add(&bar[XB_XSUB(b.x)], 1u);
        const unsigned gen = old / nloc;
        if (old + 1u == (gen + 1u) * nloc) {
            __builtin_amdgcn_fence(__ATOMIC_RELEASE, "agent");
            asm volatile("s_waitcnt vmcnt(0)" ::: "memory");
            const unsigned og = xb_add(&bar[XB_TOP], 1u);
            const unsigned tg = og / nx;
            if (og + 1u == (tg + 1u) * nx) xb_add(&bar[XB_TOPGEN], 1u);
            else XB_SPIN(xb_ld(&bar[XB_TOPGEN]) == tg, bar);
            __builtin_amdgcn_fence(__ATOMIC_ACQUIRE, "agent");
            xb_add(&bar[XB_XGEN(b.x)], 1u);
            asm volatile("s_waitcnt vmcnt(0)" ::: "memory");
        } else {
            XB_SPIN(xb_ld(&bar[XB_XGEN(b.x)]) == gen, bar);
            __builtin_amdgcn_fence(__ATOMIC_ACQUIRE, "agent");
            asm volatile("s_waitcnt vmcnt(0)" ::: "memory");
        }
    }
    __syncthreads();
}

struct Args { const float* in[29]; float* out; unsigned char* ws; int ph_lo, ph_hi, use_cg, pad; };
struct Frame {
    LAS unsigned char* lds; int tid, lane, wave, G, vcu;
    float* out; unsigned char* ws;
    __device__ __forceinline__ void refresh() { int t = threadIdx.x; asm volatile("" : "+v"(t)); tid = t; lane = t & 63; wave = __builtin_amdgcn_readfirstlane(t >> 6); }
};
__device__ __forceinline__ const float* kin(int i) {
    const char __attribute__((address_space(4)))* p = (const char __attribute__((address_space(4)))*)__builtin_amdgcn_kernarg_segment_ptr();
    asm volatile("" : "+s"(p));
    return *(const float* const __attribute__((address_space(4)))*)(p + 8 * i);
}
#define WSP(T_, off) ((T_*)(F.ws + (off)))

struct TrDesc { const float* W; bf16_t* WT; const float* scale; int N, dK, k0, n0, drow0; };
__device__ __forceinline__ void tr_load(const TrDesc& d, int lane, f32x4 (&v)[16], float (&sc)[16]) {
    const int kr = lane >> 4, nc = 4 * (lane & 15);
#pragma unroll
    for (int i = 0; i < 16; ++i) v[i] = __builtin_nontemporal_load((const f32x4*)(d.W + (size_t)(d.k0 + 4 * i + kr) * d.N + d.n0 + nc));
#pragma unroll
    for (int i = 0; i < 16; ++i) sc[i] = d.scale ? d.scale[d.k0 + 4 * i + kr] : 1.0f;
}
__device__ __forceinline__ void tr_store(const TrDesc& d, int lane, const f32x4 (&v)[16], const float (&sc)[16], LAS float* scr) {
    const int kr = lane >> 4, nc = 4 * (lane & 15);
#pragma unroll
    for (int i = 0; i < 16; ++i) { LAS float* s = scr + (4 * i + kr) * 65 + nc; s[0] = v[i][0] * sc[i]; s[1] = v[i][1] * sc[i]; s[2] = v[i][2] * sc[i]; s[3] = v[i][3] * sc[i]; }
    LDS_WAIT(); asm volatile("" ::: "memory");
    const int c = lane & 7;
#pragma unroll
    for (int it = 0; it < 8; ++it) { const int n = (lane >> 3) + 8 * it; const LAS float* s = scr + (8 * c) * 65 + n;
        u32x4 o; o.x = pk2(s[0 * 65], s[1 * 65]); o.y = pk2(s[2 * 65], s[3 * 65]); o.z = pk2(s[4 * 65], s[5 * 65]); o.w = pk2(s[6 * 65], s[7 * 65]);
        __builtin_nontemporal_store(o, (u32x4*)(d.WT + (size_t)(d.drow0 + n) * d.dK + d.k0 + 8 * c)); }
    LDS_WAIT(); asm volatile("" ::: "memory");
}
__device__ __forceinline__ int win_src(int np) { if (np >= 512 && np < 1536) { const int t = (np - 512) >> 8, i = (np - 512) & 255; return i < 128 ? 512 + 128 * t + i : 1024 + 128 * t + (i - 128); } return np; }
__device__ __forceinline__ int win_dst64(int n0) { if (n0 >= 512 && n0 < 1024) { const int c = n0 - 512; return 512 + 256 * (c >> 7) + (c & 127); } if (n0 >= 1024 && n0 < 1536) { const int c = n0 - 1024; return 512 + 256 * (c >> 7) + 128 + (c & 127); } return n0; }
__device__ __forceinline__ int up_src(int np) { const int t = np >> 8, i = np & 255; return i < 128 ? 128 * t + i : 1024 + 128 * t + (i - 128); }
__device__ __forceinline__ int up_dst64(int n0) { if (n0 < 1024) return 256 * (n0 >> 7) + (n0 & 127); const int c = n0 - 1024; return 256 * (c >> 7) + 128 + (c & 127); }

__device__ __forceinline__ void row_load(const float* xr, int lane, f32x4 (&v)[4]) {
#pragma unroll
    for (int j = 0; j < 4; ++j) v[j] = *(const f32x4*)(xr + 4 * lane + 256 * j);
}
__device__ __forceinline__ void row_store_bf16(bf16_t* o, int lane, const f32x4 (&v)[4], float sc) {
#pragma unroll
    for (int j = 0; j < 4; ++j) { u32x2 w; w.x = pk2(v[j][0] * sc, v[j][1] * sc); w.y = pk2(v[j][2] * sc, v[j][3] * sc); *(u32x2*)(o + 4 * lane + 256 * j) = w; }
}
__device__ __forceinline__ void row_load_bf(const bf16_t* xr, int lane, u32x2 (&p)[4]) {
#pragma unroll
    for (int j = 0; j < 4; ++j) p[j] = *(const u32x2*)(xr + 4 * lane + 256 * j);
}
__device__ __forceinline__ void row_unpack(const u32x2 (&p)[4], f32x4 (&v)[4]) {
#pragma unroll
    for (int j = 0; j < 4; ++j) { v[j][0] = bflo(p[j].x); v[j][1] = bfhi(p[j].x); v[j][2] = bflo(p[j].y); v[j][3] = bfhi(p[j].y); }
}
__device__ __forceinline__ float row_sumsq(const f32x4 (&v)[4]) {
    float s = 0.f;
#pragma unroll
    for (int j = 0; j < 4; ++j) s += (v[j][0] * v[j][0] + v[j][1] * v[j][1]) + (v[j][2] * v[j][2] + v[j][3] * v[j][3]);
    return wave_sum(s);
}
__device__ __forceinline__ void phase_final(Frame& F, const bf16_t* xb, const rs_t* rsf, float* out, const float* g) {
    const int gw = F.vcu * 8 + F.wave, NGW = F.G * 8;
    for (int m = gw; m < T; m += NGW) { u32x2 p[4]; f32x4 v[4]; row_load_bf(xb + (size_t)m * D, F.lane, p); row_unpack(p, v); const float rs = rstd_of(rsf[m]);
#pragma unroll
        for (int j = 0; j < 4; ++j) { const f32x4 gg = *(const f32x4*)(g + 4 * F.lane + 256 * j); *(f32x4*)(out + (size_t)m * D + 4 * F.lane + 256 * j) = v[j] * rs * gg; } }
}

#ifndef TAIL_XF
#define TAIL_XF 10240
#endif
#ifndef TAIL_L1A
#define TAIL_L1A 5120
#endif
#ifndef TAIL_L1B
#define TAIL_L1B 3072
#endif
#ifndef TAIL_XF4
#define TAIL_XF4 6144
#endif
constexpr int I_WIN = 16 * 88, I_BR = 8 * 16, I_SQ = 16 * 16, I_UP = 16 * 32, I_PP = 4 * 16, I_POOL = 4;
constexpr int CONV_PER_LAYER = I_WIN + 3 * I_BR + I_SQ + 32 * I_UP + 32 * I_SQ + I_SQ + I_PP + 4 * I_POOL, CONV_NEXP = 32 * I_UP + 32 * I_SQ;
__device__ __forceinline__ TrDesc conv_desc(Frame& F, int l, int r) {
    if (r < 32 * I_UP) { const int e = r / I_UP, q = r % I_UP, kb = q / 32, nb = q % 32;
        return TrDesc{kin(21) + ((size_t)l * NE + e) * D * 2048, WSP(bf16_t, WS_WUP) + ((size_t)l * NE + e) * 2048 * D, kin(18) + l * D, 2048, D, 64 * kb, 64 * nb, up_dst64(64 * nb)}; } r -= 32 * I_UP;
    if (r < 32 * I_SQ) { const int e = r / I_SQ, q = r % I_SQ, kb = q / 16, nb = q % 16;
        return TrDesc{kin(23) + ((size_t)l * NE + e) * D * D, WSP(bf16_t, WS_WDN) + ((size_t)l * NE + e) * D * D, nullptr, D, D, 64 * kb, 64 * nb, 64 * nb}; } r -= 32 * I_SQ;
    if (r < I_WIN) { const int kb = r / 88, nb = r % 88;
        return TrDesc{kin(3) + (size_t)l * D * NZ, WSP(bf16_t, WS_WIN) + (size_t)l * NZ * D, kin(2) + l * D, NZ, D, 64 * kb, 64 * nb, win_dst64(64 * nb)}; } r -= I_WIN;
    if (r < 3 * I_BR) { const int k = r / I_BR, q = r % I_BR, kb = q / 16, nb = q % 16;
        return TrDesc{kin(15) + ((size_t)l * 3 + k) * 512 * D, WSP(bf16_t, WS_WBR) + ((size_t)l * 3 + k) * D * 512, nullptr, D, 512, 64 * kb, 64 * nb, 64 * nb}; } r -= 3 * I_BR;
    if (r < I_SQ) { const int kb = r / 16, nb = r % 16;
        return TrDesc{kin(17) + (size_t)l * D * D, WSP(bf16_t, WS_WOUT) + (size_t)l * D * D, nullptr, D, D, 64 * kb, 64 * nb, 64 * nb}; } r -= I_SQ;
    if (r < I_SQ) { const int kb = r / 16, nb = r % 16;
        return TrDesc{kin(26) + (size_t)l * D * D, WSP(bf16_t, WS_WPG) + (size_t)l * D * D, kin(25) + l * D, D, D, 64 * kb, 64 * nb, 64 * nb}; } r -= I_SQ;
    if (r < I_PP) { const int kb = r / 16, nb = r % 16;
        return TrDesc{kin(27) + (size_t)l * PLE * D, WSP(bf16_t, WS_WPP) + (size_t)l * D * PLE, nullptr, D, PLE, 64 * kb, 64 * nb, 64 * nb}; } r -= I_PP;
    { const int g = r / I_POOL, q = r % I_POOL, kb = q / 2, nb = q % 2;
        return TrDesc{kin(5) + ((size_t)l * 4 + g) * 128 * 128, WSP(bf16_t, WS_SMALLW + l * SW_LAYER + SW_WPT) + (size_t)g * 128 * 128, nullptr, 128, 128, 64 * kb, 64 * nb, 64 * nb}; }
}
template <class Map> __device__ __forceinline__ void conv_stream(Frame& F, int first, int stride, int count, const Map& map) {
    LAS float* scr = (LAS float*)(F.lds + F.wave * 16640);
    if (first >= count) return;
    f32x4 va[16], vb[16]; float sa[16], sb[16];
    int l, r; map(first, l, r); TrDesc da = conv_desc(F, l, r), db = da;
    tr_load(da, F.lane, va, sa);
    for (int it = first; it < count; it += 2 * stride) {
        const bool hb = it + stride < count;
        if (hb) { map(it + stride, l, r); db = conv_desc(F, l, r); tr_load(db, F.lane, vb, sb); }
        tr_store(da, F.lane, va, sa, scr);
        const bool ha = it + 2 * stride < count;
        if (ha) { map(it + 2 * stride, l, r); da = conv_desc(F, l, r); tr_load(da, F.lane, va, sa); }
        if (hb) tr_store(db, F.lane, vb, sb, scr);
    }
}
__device__ __forceinline__ void phase_weights(Frame& F) {
    const int gw = F.vcu * 8 + F.wave, NGW = F.G * 8;
    conv_stream(F, gw, NGW, I_WIN, [](int it, int& l, int& r) { l = 0; r = CONV_NEXP + it; });
    const size_t gt = (size_t)F.vcu * 512 + F.tid, NGT = (size_t)F.G * 512;
    { const float* sguw = kin(13);
      for (size_t i = gt; i < (size_t)NL * 4 * 128 * 128; i += NGT) { const int l = (int)(i >> 16), r = (int)(i & 65535), t = (r >> 7) & 127, s = r & 127;
        WSP(bf16_t, WS_SMALLW + l * SW_LAYER + SW_WSGU)[r] = (bf16_t)f2bf(s <= t ? sguw[i] : 0.f); } }
    { const float* rw = kin(19); const float* mn = kin(18);
      for (size_t i = gt; i < (size_t)NL * NE * D; i += NGT) { const int l = (int)(i >> 15), r = (int)(i & 32767), e = r >> 10, k = r & 1023;
        const float w = rw[((size_t)l * D + k) * NE + e] * mn[l * D + k]; const unsigned hi = f2bf(w); const float wl = w - __builtin_bit_cast(float, hi << 16);
        WSP(bf16_t, WS_SMALLW + l * SW_LAYER + SW_WRT)[r] = (bf16_t)hi; WSP(bf16_t, WS_SMALLW + l * SW_LAYER + SW_WRT + 65536)[r] = (bf16_t)f2bf(wl); } }
    { const float* bi = kin(4);
      for (size_t i = gt; i < (size_t)NL * NZ; i += NGT) { const int l = (int)(i / NZ), np = (int)(i % NZ);
        WSP(float, WS_SMALLW + l * SW_LAYER + SW_BIN)[np] = bi[l * NZ + win_src(np)]; } }
    { const float* bu = kin(22);
      for (size_t i = gt; i < (size_t)NL * NE * 2048; i += NGT) { const int l = (int)(i >> 16), r = (int)(i & 65535), e = r >> 11, np = r & 2047;
        WSP(float, WS_SMALLW + l * SW_LAYER + SW_BUP)[r] = bu[((size_t)l * NE + e) * 2048 + up_src(np)]; } }
    { rs_t* rsz = WSP(rs_t, WS_RS) + T; for (size_t i = gt; i < (size_t)3 * NL * T; i += NGT) rsz[i] = 0ull; }
    { const float* x = kin(0); bf16_t* X0 = WSP(bf16_t, WS_X0); rs_t* rs0 = WSP(rs_t, WS_RS);
      for (int m = gw; m < T; m += NGW) { f32x4 v[4]; row_load(x + (size_t)m * D, F.lane, v); const float ss = row_sumsq(v); row_store_bf16(X0 + (size_t)m * D, F.lane, v, 1.0f); if (F.lane == 0) rs0[m] = rs_fix(ss); } }
}
__device__ __forceinline__ void phase_convert_rest(Frame& F, int nb0) {
    const int nb = F.G - nb0, gw = ((int)blockIdx.x - nb0) * 8 + F.wave, NGW = nb * 8;
    constexpr int L0REST = CONV_PER_LAYER - CONV_NEXP - I_WIN, L0ALL = L0REST + CONV_NEXP;
    conv_stream(F, gw, NGW, L0ALL + CONV_PER_LAYER - TAIL_XF - TAIL_XF4 - TAIL_L1A - TAIL_L1B, [](int it, int& l, int& r) { if (it < L0REST) { l = 0; r = CONV_NEXP + I_WIN + it; } else if (it < L0ALL) { l = 0; r = it - L0REST; } else { l = 1; r = it - L0ALL + TAIL_XF + TAIL_XF4; if (r >= 32 * I_UP) r += TAIL_L1A + TAIL_L1B; } });
    const size_t gt = (size_t)((int)blockIdx.x - nb0) * 512 + F.tid, NGT = (size_t)nb * 512;
    { const float* pp = kin(1);
      for (size_t i = gt; i < (size_t)NL * T * PLE / 4; i += NGT) { const f32x4 v = *(const f32x4*)(pp + 4 * i); u32x2 w; w.x = pk2(v[0], v[1]); w.y = pk2(v[2], v[3]); *(u32x2*)(WSP(bf16_t, WS_PB) + 4 * i) = w; } }
}
__device__ __forceinline__ void conv_tail(Frame& F, int j, int n, int first, int count) {
    conv_stream(F, j * 8 + F.wave, n * 8, count, [first](int it, int& l, int& r) { l = 1; r = first + it; });
}

__device__ __forceinline__ float reduce_scatter64(float (&v)[64], int lane) {
#pragma unroll
    for (int m = 32, n = 32; m >= 1; m >>= 1, n >>= 1) {
        const bool up = (lane & m) != 0; float rcv[32];
#pragma unroll
        for (int i = 0; i < n; ++i) { const float a = v[i], b = v[i + n]; const float send = up ? a : b; v[i] = up ? b : a; rcv[i] = __shfl_xor(send, m); }
        __builtin_amdgcn_sched_barrier(0);
#pragma unroll
        for (int i = 0; i < n; ++i) v[i] += rcv[i];
    }
    return v[0];
}
__device__ __forceinline__ float reduce_scatter32(float (&v)[32], int lane) {
#pragma unroll
    for (int m = 32, n = 16; m >= 2; m >>= 1, n >>= 1) {
        const bool up = (lane & m) != 0; float rcv[16];
#pragma unroll
        for (int i = 0; i < n; ++i) { const float a = v[i], b = v[i + n]; const float send = up ? a : b; v[i] = up ? b : a; rcv[i] = __shfl_xor(send, m); }
        __builtin_amdgcn_sched_barrier(0);
#pragma unroll
        for (int i = 0; i < n; ++i) v[i] += rcv[i];
    }
    return v[0] + __shfl_xor(v[0], 1);
}
__device__ __forceinline__ void conv_unit(Frame& F, int l, int u) {
    const int t0 = 64 * u, s0 = t0 & (SEQ - 1);
    const bf16_t* ZP = WSP(bf16_t, WS_ZP);
    LAS unsigned char* in = F.lds;
    {
        u32x4 cv[12];
#pragma unroll
        for (int q = 0; q < 12; ++q) { const int idx = F.tid + 512 * q, r = idx >> 6, c16 = idx & 63; const int pos = s0 - 30 + r, rr = pos >= 0 ? t0 - 30 + r : t0 - s0;
            cv[q] = (idx < 94 * 64) ? *(const u32x4*)(ZP + (size_t)rr * ZPW + ZP_GLU + 8 * c16) : (u32x4){0u, 0u, 0u, 0u}; }
        __builtin_amdgcn_sched_barrier(0);
#pragma unroll
        for (int q = 0; q < 12; ++q) { const int idx = F.tid + 512 * q, r = idx >> 6, c16 = idx & 63; const bool ok = (s0 - 30 + r >= 0);
            u32x4 v = cv[q]; v.x = ok ? v.x : 0u; v.y = ok ? v.y : 0u; v.z = ok ? v.z : 0u; v.w = ok ? v.w : 0u;
            if (idx < 94 * 64) *(LAS u32x4*)(in + r * 1024 + c16 * 16) = v; }
    }
    const int cp = F.tid & 255, half = F.tid >> 8;
    f32x2 w[CONVK]; const float* cwp = kin(7);
#pragma unroll
    for (int j = 0; j < CONVK; ++j) w[j] = *(const f32x2*)(cwp + ((size_t)l * CONVK + j) * 512 + 2 * cp);
    const f32x2 cb = *(const f32x2*)(kin(8) + l * 512 + 2 * cp);
    f32x2 acc[32];
#pragma unroll
    for (int o = 0; o < 32; ++o) acc[o] = cb;
    __syncthreads();
    const LAS unsigned char* ip = in + (32 * half) * 1024 + cp * 4;
    unsigned pvl[62];
#pragma unroll
    for (int rr = 0; rr < 62; ++rr) pvl[rr] = *(const LAS unsigned*)(ip + rr * 1024);
    __builtin_amdgcn_sched_barrier(0);
#pragma unroll
    for (int rr = 0; rr < 62; ++rr) { const unsigned pv = pvl[rr]; const f32x2 v = (f32x2){bflo(pv), bfhi(pv)};
#pragma unroll
        for (int o = (rr > 30 ? rr - 30 : 0); o <= (rr < 31 ? rr : 31); ++o) acc[o] = acc[o] + w[rr - o] * v; }
    float st[64];
#pragma unroll
    for (int o = 0; o < 32; ++o) { st[o] = acc[o].x + acc[o].y; st[32 + o] = acc[o].x * acc[o].x + acc[o].y * acc[o].y; }
    const float tot = reduce_scatter64(st, F.lane);
    LAS float* red = (LAS float*)(F.lds + LDS_TAB);
    red[F.wave * 64 + F.lane] = tot;
    __syncthreads();
    if (F.tid < 128) { const int h = F.tid >> 6, i = F.tid & 63; red[512 + F.tid] = (red[(4 * h) * 64 + i] + red[(4 * h + 1) * 64 + i]) + (red[(4 * h + 2) * 64 + i] + red[(4 * h + 3) * 64 + i]); }
    __syncthreads();
    const f32x2 ng = *(const f32x2*)(kin(9) + l * 512 + 2 * cp), nb = *(const f32x2*)(kin(10) + l * 512 + 2 * cp);
    bf16_t* Y = WSP(bf16_t, WS_Y) + (size_t)(t0 + 32 * half) * YW + 512 + 2 * cp;
#pragma unroll
    for (int o = 0; o < 32; ++o) { const float mean = red[512 + half * 64 + o] * (1.0f / 512.0f), var = red[512 + half * 64 + 32 + o] * (1.0f / 512.0f) - mean * mean; const float rs = 1.0f / sqrtf(fmaxf(var, 0.f) + EPS);
        float y0 = (acc[o].x - mean) * rs * ng.x + nb.x, y1 = (acc[o].y - mean) * rs * ng.y + nb.y; y0 = y0 * sigmoidf_(y0); y1 = y1 * sigmoidf_(y1);
        *(unsigned*)(Y + (size_t)o * YW) = pk2(y0, y1); }
    __syncthreads();
}
template <int W> __device__ __forceinline__ void pool_window(const f32x2 (&f)[47], const f32x2 (&pre)[48], int s_first, LAS unsigned char* pa) {
#pragma unroll
    for (int o = 0; o < 32; ++o) { const f32x2 s = pre[o + 16] - pre[o + 16 - W];
        const int pos = s_first + o; const float inv = 1.0f / (float)(pos + 1 < W ? pos + 1 : W);
        const f32x2 p = s * inv - f[o + 15];
        *(LAS unsigned*)(pa + o * 1040) = pk2(p.x, p.y); }
}
__device__ __forceinline__ void pool_unit(Frame& F, int l, int u) {
    const int t0 = 64 * u, s0 = t0 & (SEQ - 1);
    const bf16_t* ZP = WSP(bf16_t, WS_ZP);
    LAS unsigned char* pA = F.lds;
    const int cp = F.tid & 255, half = F.tid >> 8, first = t0 + 32 * half;
    f32x2 f[47]; unsigned pvr[47];
#pragma unroll
    for (int i = 0; i < 47; ++i) { const int pos = s0 + 32 * half - 15 + i; const int rr = pos >= 0 ? first - 15 + i : t0 - s0;
        pvr[i] = *(const unsigned*)(ZP + (size_t)rr * ZPW + ZP_ZA + 2 * cp); }
    __builtin_amdgcn_sched_barrier(0);
#pragma unroll
    for (int i = 0; i < 47; ++i) { const int pos = s0 + 32 * half - 15 + i; const unsigned pv = pos >= 0 ? pvr[i] : 0u; f[i] = (f32x2){bflo(pv), bfhi(pv)}; }
    LAS unsigned char* pa = pA + (32 * half) * 1040 + cp * 4;
    const int g = (F.wave & 3);
    f32x2 pre[48]; pre[0] = (f32x2){0.f, 0.f};
#pragma unroll
    for (int i = 0; i < 47; ++i) pre[i + 1] = pre[i] + f[i];
    if (g == 0) pool_window<2>(f, pre, s0 + 32 * half, pa); else if (g == 1) pool_window<4>(f, pre, s0 + 32 * half, pa); else if (g == 2) pool_window<8>(f, pre, s0 + 32 * half, pa); else pool_window<16>(f, pre, s0 + 32 * half, pa);
    __syncthreads();
    const int gg = F.wave >> 1, dh = F.wave & 1, r = F.lane & 31, h = F.lane >> 5;
    const bf16_t* WPT = WSP(bf16_t, WS_SMALLW + l * SW_LAYER + SW_WPT) + (size_t)gg * 128 * 128;
    f32x16 acc[2][2];
#pragma unroll
    for (int mi = 0; mi < 2; ++mi)
#pragma unroll
        for (int ni = 0; ni < 2; ++ni)
#pragma unroll
            for (int q = 0; q < 16; ++q) acc[mi][ni][q] = 0.f;
    bf16x8 bw[8][2];
#pragma unroll
    for (int s = 0; s < 8; ++s)
#pragma unroll
        for (int ni = 0; ni < 2; ++ni) bw[s][ni] = *(const bf16x8*)(WPT + (size_t)(64 * dh + 32 * ni + r) * 128 + 16 * s + 8 * h);
#pragma unroll
    for (int s = 0; s < 8; ++s) { bf16x8 a[2];
#pragma unroll
        for (int mi = 0; mi < 2; ++mi) a[mi] = *(const LAS bf16x8*)(pA + (32 * mi + r) * 1040 + (128 * gg + 16 * s + 8 * h) * 2);
#pragma unroll
        for (int mi = 0; mi < 2; ++mi)
#pragma unroll
            for (int ni = 0; ni < 2; ++ni) acc[mi][ni] = __builtin_amdgcn_mfma_f32_32x32x16_bf16(bw[s][ni], a[mi], acc[mi][ni], 0, 0, 0); }
    __syncthreads();
    bf16_t* Y = WSP(bf16_t, WS_Y); const float* psc = kin(6);
#pragma unroll
    for (int ni = 0; ni < 2; ++ni)
#pragma unroll
        for (int g = 0; g < 4; ++g) { const int d = 128 * gg + 64 * dh + 32 * ni + 8 * g + 4 * h; const f32x4 sc = *(const f32x4*)(psc + l * 512 + d);
#pragma unroll
            for (int mi = 0; mi < 2; ++mi) { u32x2 o; o.x = pk2(acc[mi][ni][4 * g + 0] * sc[0], acc[mi][ni][4 * g + 1] * sc[1]); o.y = pk2(acc[mi][ni][4 * g + 2] * sc[2], acc[mi][ni][4 * g + 3] * sc[3]);
                *(LAS u32x2*)(pA + (32 * mi + r) * 1040 + d * 2) = o; } }
    __syncthreads();
    { u32x4 ov[8];
#pragma unroll
      for (int i = 0; i < 8; ++i) { const int q = F.tid + 512 * i; ov[i] = *(const LAS u32x4*)(pA + (q >> 6) * 1040 + (q & 63) * 16); }
#pragma unroll
      for (int i = 0; i < 8; ++i) { const int q = F.tid + 512 * i; *(u32x4*)(Y + (size_t)(t0 + (q >> 6)) * YW + (q & 63) * 8) = ov[i]; } }
    __syncthreads();
}
__device__ __forceinline__ void sgu_unit(Frame& F, int l, int u) {
    const int chunk = u >> 1, hp = u & 1, t0 = 128 * chunk;
    const bf16_t* ZP = WSP(bf16_t, WS_ZP);
    LAS unsigned char* vT = F.lds;
    {
        const float* lng = kin(11) + l * 512 + 8 * F.lane; const float* lnb = kin(12) + l * 512 + 8 * F.lane;
        const f32x4 g0 = *(const f32x4*)lng, g1 = *(const f32x4*)(lng + 4);
        const f32x4 b0 = *(const f32x4*)lnb, b1 = *(const f32x4*)(lnb + 4);
        u32x4 pvv[16];
#pragma unroll
        for (int i = 0; i < 16; ++i) pvv[i] = *(const u32x4*)(ZP + (size_t)(t0 + 16 * F.wave + i) * ZPW + ZP_ZV + 8 * F.lane);
        float st[32];
#pragma unroll
        for (int i = 0; i < 16; ++i) { const u32x4 pv = pvv[i]; const float x0 = bflo(pv.x), x1 = bfhi(pv.x), x2 = bflo(pv.y), x3 = bfhi(pv.y), x4 = bflo(pv.z), x5 = bfhi(pv.z), x6 = bflo(pv.w), x7 = bfhi(pv.w);
            st[i] = ((x0 + x1) + (x2 + x3)) + ((x4 + x5) + (x6 + x7)); st[16 + i] = ((x0 * x0 + x1 * x1) + (x2 * x2 + x3 * x3)) + ((x4 * x4 + x5 * x5) + (x6 * x6 + x7 * x7)); }
        const float tot = reduce_scatter32(st, F.lane);
        LAS float* wst = (LAS float*)(F.lds + LDS_TAB) + 32 * F.wave;
        if ((F.lane & 1) == 0) wst[F.lane >> 1] = tot;
        LDS_WAIT(); asm volatile("" ::: "memory");
        if ((F.lane >> 5) == hp) { const int cl = 8 * (F.lane & 31);
            float mu[16], rsd[16];
#pragma unroll
            for (int i = 0; i < 16; ++i) { const float mean = wst[i] * (1.0f / 512.0f), var = wst[16 + i] * (1.0f / 512.0f) - mean * mean; mu[i] = mean; rsd[i] = 1.0f / sqrtf(fmaxf(var, 0.f) + EPS); }
#pragma unroll
            for (int j = 0; j < 8; ++j) { const float gg = j < 4 ? g0[j & 3] : g1[j & 3], bb = j < 4 ? b0[j & 3] : b1[j & 3]; unsigned w[8];
#pragma unroll
                for (int i2 = 0; i2 < 8; ++i2) { const unsigned pa = pvv[2 * i2][j >> 1], pb = pvv[2 * i2 + 1][j >> 1];
                    const float xa = (j & 1) ? bfhi(pa) : bflo(pa), xb = (j & 1) ? bfhi(pb) : bflo(pb);
                    w[i2] = pk2((xa - mu[2 * i2]) * rsd[2 * i2] * gg + bb, (xb - mu[2 * i2 + 1]) * rsd[2 * i2 + 1] * gg + bb); }
                LAS unsigned char* dst = vT + (cl + j) * 272 + (16 * F.wave) * 2;
                *(LAS u32x4*)dst = (u32x4){w[0], w[1], w[2], w[3]}; *(LAS u32x4*)(dst + 16) = (u32x4){w[4], w[5], w[6], w[7]}; }
        }
    }
    const int hl = F.wave >> 2, ti = F.wave & 3, hh = 2 * hp + hl, r = F.lane & 31, h = F.lane >> 5;
    const bf16_t* WS_ = WSP(bf16_t, WS_SMALLW + l * SW_LAYER + SW_WSGU) + (size_t)hh * 128 * 128;
    bf16x8 af[8];
#pragma unroll
    for (int k = 0; k < 8; ++k) if (k < 2 * (ti + 1)) af[k] = *(const bf16x8*)(WS_ + (size_t)(32 * ti + r) * 128 + 16 * k + 8 * h);
    __syncthreads();
    f32x16 acc[4];
#pragma unroll
    for (int ci = 0; ci < 4; ++ci)
#pragma unroll
        for (int q = 0; q < 16; ++q) acc[ci][q] = 0.f;
#pragma unroll
    for (int k = 0; k < 8; ++k) if (k < 2 * (ti + 1)) {
#pragma unroll
        for (int ci = 0; ci < 4; ++ci) { const bf16x8 b = *(const LAS bf16x8*)(vT + (128 * hl + 32 * ci + r) * 272 + (16 * k + 8 * h) * 2);
            acc[ci] = __builtin_amdgcn_mfma_f32_32x32x16_bf16(b, af[k], acc[ci], 0, 0, 0); }
    }
    __syncthreads();
    bf16_t* Y = WSP(bf16_t, WS_Y);
    { const int tl = 32 * ti + r; const float sb = kin(14)[((size_t)l * 4 + hh) * 128 + tl];
      const bf16_t* zr = ZP + (size_t)(t0 + tl) * ZPW + ZP_ZU + 128 * hh + 4 * h; bf16_t* yr = Y + (size_t)(t0 + tl) * YW + 1024 + 128 * hh + 4 * h;
      u32x2 zu[4][4];
#pragma unroll
      for (int ci = 0; ci < 4; ++ci)
#pragma unroll
          for (int g = 0; g < 4; ++g) zu[ci][g] = *(const u32x2*)(zr + 32 * ci + 8 * g);
#pragma unroll
      for (int ci = 0; ci < 4; ++ci)
#pragma unroll
          for (int g = 0; g < 4; ++g) { const u32x2 z = zu[ci][g]; u32x2 o;
              o.x = pk2(bflo(z.x) * (acc[ci][4 * g + 0] + sb), bfhi(z.x) * (acc[ci][4 * g + 1] + sb)); o.y = pk2(bflo(z.y) * (acc[ci][4 * g + 2] + sb), bfhi(z.y) * (acc[ci][4 * g + 3] + sb));
              *(LAS u32x2*)(vT + tl * 528 + (128 * hl + 32 * ci + 8 * g + 4 * h) * 2) = o; }
      (void)yr; }
    __syncthreads();
    { u32x4 ov[8];
#pragma unroll
      for (int i = 0; i < 8; ++i) { const int q = F.tid + 512 * i; ov[i] = *(const LAS u32x4*)(vT + (q >> 5) * 528 + (q & 31) * 16); }
#pragma unroll
      for (int i = 0; i < 8; ++i) { const int q = F.tid + 512 * i; *(u32x4*)(Y + (size_t)(t0 + (q >> 5)) * YW + 1024 + 256 * hp + (q & 31) * 8) = ov[i]; } }
    __syncthreads();
}
#ifndef MIX_DUP
#define MIX_DUP 0
#endif
__device__ __forceinline__ void phase_mix(Frame& F, int l) {
    for (int rep = 0; rep < ((MIX_DUP & 1) ? 2 : 1); ++rep) for (int u = F.vcu; u < 256; u += F.G) sgu_unit(F, l, u);
    for (int rep = 0; rep < ((MIX_DUP & 2) ? 2 : 1); ++rep) for (int u = F.vcu; u < 256; u += F.G) conv_unit(F, l, u);
    for (int rep = 0; rep < ((MIX_DUP & 4) ? 2 : 1); ++rep) for (int u = F.vcu; u < 256; u += F.G) pool_unit(F, l, u);
}

__device__ __forceinline__ void phase_router(Frame& F, int l, const bf16_t* x, const rs_t* rs) {
    LAS float* P = (LAS float*)F.lds;
    LAS int* hist = (LAS int*)(F.lds + LDS_TAB);
    const bf16_t* WH = WSP(bf16_t, WS_SMALLW + l * SW_LAYER + SW_WRT); const bf16_t* WL = WH + 32768;
    float* TW = WSP(float, WS_TOPW); int* TOKL = WSP(int, WS_TOKL); int* SO = WSP(int, WS_SLOTOF);
    unsigned* gcnt = (unsigned*)(F.ws + WS_CTL) + CW_GCNT + 32 * l;
    const float* rbias = kin(20) + l * NE;
    if (F.tid < 32) hist[F.tid] = 0;
    const int rb = F.wave & 1, kq = F.wave >> 1, r = F.lane & 31, h = F.lane >> 5;
    for (int blk = F.vcu; blk < 256; blk += F.G) {
        const bf16_t* xr = x + (size_t)(64 * blk + 32 * rb + r) * D + 256 * kq + 8 * h;
        const bf16_t* whp = WH + (size_t)r * D + 256 * kq + 8 * h; const bf16_t* wlp = WL + (size_t)r * D + 256 * kq + 8 * h;
        bf16x8 xa[16];
#pragma unroll
        for (int s2 = 0; s2 < 16; ++s2) xa[s2] = *(const bf16x8*)(xr + 16 * s2);
        f32x16 acc;
#pragma unroll
        for (int q = 0; q < 16; ++q) acc[q] = 0.f;
#pragma unroll
        for (int sb = 0; sb < 4; ++sb) { bf16x8 ha[4], la[4];
#pragma unroll
            for (int s2 = 0; s2 < 4; ++s2) { ha[s2] = *(const bf16x8*)(whp + 16 * (4 * sb + s2)); la[s2] = *(const bf16x8*)(wlp + 16 * (4 * sb + s2)); }
#pragma unroll
            for (int s2 = 0; s2 < 4; ++s2) { acc = __builtin_amdgcn_mfma_f32_32x32x16_bf16(xa[4 * sb + s2], ha[s2], acc, 0, 0, 0); acc = __builtin_amdgcn_mfma_f32_32x32x16_bf16(xa[4 * sb + s2], la[s2], acc, 0, 0, 0); } }
#pragma unroll
        for (int q = 0; q < 16; ++q) P[(kq * 64 + 32 * rb + (q & 3) + 8 * (q >> 2) + 4 * h) * 33 + r] = acc[q];
        __syncthreads();
        if (F.lane < 8) {
            const int rl = 8 * F.wave + F.lane, row = 64 * blk + rl; const float rstd = rstd_of(rs[row]);
            float v0 = -3.0e38f, v1 = -3.0e38f, v2 = -3.0e38f, v3 = -3.0e38f; int i0 = 0, i1 = 0, i2 = 0, i3 = 0;
#pragma unroll
            for (int e = 0; e < 32; ++e) { const float v = ((P[(0 * 64 + rl) * 33 + e] + P[(1 * 64 + rl) * 33 + e]) + (P[(2 * 64 + rl) * 33 + e] + P[(3 * 64 + rl) * 33 + e])) * rstd + rbias[e];
                const bool c0 = v > v0, c1 = v > v1, c2 = v > v2, c3 = v > v3;
                v3 = c2 ? v2 : (c3 ? v : v3); i3 = c2 ? i2 : (c3 ? e : i3);
                v2 = c1 ? v1 : (c2 ? v : v2); i2 = c1 ? i1 : (c2 ? e : i2);
                v1 = c0 ? v0 : (c1 ? v : v1); i1 = c0 ? i0 : (c1 ? e : i1);
                v0 = c0 ? v : v0;             i0 = c0 ? e : i0; }
            const f32x4 tw = (f32x4){1.0f, __expf(v1 - v0), __expf(v2 - v0), __expf(v3 - v0)};
            *(f32x4*)(TW + row * 4) = tw;
            const int ie[4] = {i0, i1, i2, i3};
#pragma unroll
            for (int k = 0; k < 4; ++k) { const int rk = __hip_atomic_fetch_add((int*)(hist + ie[k]), 1, __ATOMIC_RELAXED, __HIP_MEMORY_SCOPE_WORKGROUP);
                hist[64 + rl * 4 + k] = ie[k] | (rk << 8); }
        }
        __syncthreads();
        if (F.tid < 32) { hist[32 + F.tid] = (int)__hip_atomic_fetch_add(gcnt + F.tid, (unsigned)hist[F.tid], __ATOMIC_RELAXED, __HIP_MEMORY_SCOPE_AGENT); hist[F.tid] = 0; }
        __syncthreads();
        if (F.tid < 256) { const int pk = hist[64 + F.tid], e = pk & 255, pos = hist[32 + e] + (pk >> 8), tok = 64 * blk + (F.tid >> 2);
            TOKL[e * T + pos] = tok; SO[tok * 4 + (F.tid & 3)] = e | (pos << 5); }
        __syncthreads();
    }
}
__device__ __forceinline__ void moe_tables(Frame& F, int l, bool split_tail = false) {
    LAS int* tab = (LAS int*)(F.lds + LDS_TAB);
    const unsigned* gcnt = (const unsigned*)(F.ws + WS_CTL) + CW_GCNT + 32 * l;
    if (F.tid < 64) { const int e = F.lane & 31; const int c = (int)gcnt[e]; const int pt = (c + 255) >> 8; int incl = pt;
#pragma unroll
        for (int o = 1; o < 32; o <<= 1) { const int v = __shfl_up(incl, o, 32); if (e >= o) incl += v; }
        if (F.lane < 32) { tab[MT_CNT + e] = c; tab[MT_TSTART + e] = incl - pt;
            if (e == 31) { tab[MT_NTILE] = incl;
                const int nu = incl * 4, nf = (nu / F.G) * F.G, rem = nu - nf; const int sp = (!split_tail || rem == 0) ? 1 : (rem * 4 <= F.G ? 4 : (rem * 2 <= F.G ? 2 : 1));
                tab[MT_SPLIT] = sp; tab[MT_NFULL] = nf; tab[MT_TAILROW] = (nf / 4) * 256; } } }
    __syncthreads();
    if (F.tid <= MAXTILES) { int e = 0;
#pragma unroll
        for (int q = 0; q < 31; ++q) e += (int)(((unsigned)(F.tid - tab[MT_TSTART + q + 1])) >> 31) ^ 1;
        tab[MT_TE + F.tid] = e; }
    __syncthreads();
}
__device__ __forceinline__ void phase_combine(Frame& F, int l, const bf16_t* xin, bf16_t* xout, rs_t* rsout) {
    moe_tables(F, l, SPLITK_TAIL && l == NL - 1);
    const int gw = F.vcu * 8 + F.wave, NGW = F.G * 8;
    const int* SO = WSP(int, WS_SLOTOF); const float* TW = WSP(float, WS_TOPW); const bf16_t* YE = WSP(bf16_t, WS_YE);
    const LAS int* tab = (const LAS int*)(F.lds + LDS_TAB); const int sp = tab[MT_SPLIT], trow = tab[MT_TAILROW]; const bf16_t* YEX = WSP(bf16_t, WS_YEX);
    const int c8 = 8 * F.lane;
    for (int m = gw; m < T; m += NGW) {
        u32x4 p[2];
#pragma unroll
        for (int h = 0; h < 2; ++h) p[h] = *(const u32x4*)(xin + (size_t)m * D + 512 * h + c8);
        const f32x4 tw = *(const f32x4*)(TW + m * 4); const float twi = 1.0f / ((tw[0] + tw[1]) + (tw[2] + tw[3]));
        const i32x4 so = *(const i32x4*)(SO + m * 4);
        u32x4 y[4][2]; int slots[4];
#pragma unroll
        for (int k = 0; k < 4; ++k) { const int pk = so[k]; slots[k] = tab[MT_TSTART + (pk & 31)] * 256 + (pk >> 5);
#pragma unroll
            for (int h = 0; h < 2; ++h) y[k][h] = *(const u32x4*)(YE + (size_t)slots[k] * D + 512 * h + c8); }
        float v[2][8];
#pragma unroll
        for (int h = 0; h < 2; ++h)
#pragma unroll
            for (int q = 0; q < 4; ++q) { v[h][2 * q] = bflo(p[h][q]); v[h][2 * q + 1] = bfhi(p[h][q]); }
        if (sp > 1) {
#pragma unroll
            for (int k = 0; k < 4; ++k) if (slots[k] >= trow) { const float w = tw[k] * twi;
                for (int q = 1; q < sp; ++q) {
#pragma unroll
                    for (int h = 0; h < 2; ++h) { const u32x4 z = *(const u32x4*)(YEX + ((size_t)(q - 1) * YEX_ROWS + (size_t)(slots[k] - trow)) * D + 512 * h + c8);
#pragma unroll
                        for (int e = 0; e < 4; ++e) { v[h][2 * e] += w * bflo(z[e]); v[h][2 * e + 1] += w * bfhi(z[e]); } } } } }
#pragma unroll
        for (int k = 0; k < 4; ++k) { const float w = tw[k] * twi;
#pragma unroll
            for (int h = 0; h < 2; ++h)
#pragma unroll
                for (int e = 0; e < 4; ++e) { v[h][2 * e] += w * bflo(y[k][h][e]); v[h][2 * e + 1] += w * bfhi(y[k][h][e]); } }
        float ss = 0.f;
#pragma unroll
        for (int h = 0; h < 2; ++h) { ss += ((v[h][0] * v[h][0] + v[h][1] * v[h][1]) + (v[h][2] * v[h][2] + v[h][3] * v[h][3])) + ((v[h][4] * v[h][4] + v[h][5] * v[h][5]) + (v[h][6] * v[h][6] + v[h][7] * v[h][7]));
            u32x4 o; o.x = pk2(v[h][0], v[h][1]); o.y = pk2(v[h][2], v[h][3]); o.z = pk2(v[h][4], v[h][5]); o.w = pk2(v[h][6], v[h][7]);
            *(u32x4*)(xout + (size_t)m * D + 512 * h + c8) = o; }
        ss = wave_sum(ss); if (F.lane == 0) rsout[m] = rs_fix(ss);
    }
}

__device__ __forceinline__ void idle_set(int n_units, int G, int c, int& j, int& n) {
    const int rem = n_units % G; if (rem == 0 || G - rem < 32) { j = c; n = G; } else { j = c - rem; n = G - rem; }
}
#ifndef TAIL_FIRST5
#define TAIL_FIRST5 1
#endif
#ifndef TAIL_FIRST4
#define TAIL_FIRST4 1
#endif
#ifndef TAIL_FIRST
#define TAIL_FIRST 1
#endif
constexpr int PH_PER_LAYER = 9, N_PHASES = 1 + NL * PH_PER_LAYER + 1;
__global__ void __launch_bounds__(512, 2) mega_fwd(Args args) {
    extern __shared__ __attribute__((aligned(16))) unsigned char lds_raw[];
    Frame F;
    F.lds = (LAS unsigned char*)lds_raw; F.tid = threadIdx.x; F.lane = F.tid & 63; F.wave = __builtin_amdgcn_readfirstlane(F.tid >> 6);
    F.G = gridDim.x; { const int bx = blockIdx.x; F.vcu = (F.G % 8 == 0) ? (bx % 8) * (F.G / 8) + bx / 8 : bx; }
    F.out = args.out; F.ws = args.ws;
    volatile LAS unsigned* MISC = (volatile LAS unsigned*)(F.lds + LDS_MISC);
    if (F.tid < 64) MISC[F.tid] = 0u;
    __syncthreads();
    XcdBarrier bar; bar.bar = (unsigned*)(F.ws + WS_CTL) + CW_BAR; bar.x = 0; bar.st = nullptr;
    const int lo = args.ph_lo, hi = args.ph_hi;
    if (hi - lo > 1 && !args.use_cg) bar = xcd_barrier_post((unsigned*)(F.ws + WS_CTL) + CW_BAR, MISC + 8);
#ifndef BAR_DUP
#define BAR_DUP 0
#endif
#define SEAM(ph) do { if ((ph) + 1 < hi) { if (args.use_cg) cg::this_grid().sync(); else { xcd_barrier(bar); if (BAR_DUP) xcd_barrier(bar); } } } while (0)
#ifndef PH_MASK
#define PH_MASK 0xffff
#endif
#define PHT(k) ((k) == 0 ? 11 : (k) == N_PHASES - 1 ? 12 : ((k) - 1) % PH_PER_LAYER)
#define IN(k) (((PH_MASK >> PHT(k)) & 1) && lo <= (k) && (k) < hi)
#ifndef KDUP_MASK
#define KDUP_MASK 0
#endif
#ifndef SPLIT_GC
#define SPLIT_GC 160
#endif
#ifndef DUP_MASK
#define DUP_MASK 0
#endif
#define REPEAT(k) for (int rep_ = 0, nrep_ = (((DUP_MASK >> PHT(k)) & 1) ? 2 : 1); rep_ < nrep_; ++rep_, (rep_ < nrep_ ? xcd_barrier(bar) : (void)0))
    if (IN(0)) { REPEAT(0) { F.refresh(); phase_weights(F); } SEAM(0); }
    bf16_t* const X0 = WSP(bf16_t, WS_X0); bf16_t* const X1 = WSP(bf16_t, WS_X1); bf16_t* const X2 = WSP(bf16_t, WS_X2);
    for (int l = 0; l < NL; ++l) {
        const int pb = 1 + l * PH_PER_LAYER;
        const unsigned char* sw = F.ws + WS_SMALLW + l * SW_LAYER;
        rs_t* const rs0 = WSP(rs_t, WS_RS) + (size_t)(3 * l) * T;
        if (IN(pb + 0)) { REPEAT(pb + 0) { F.refresh();
            const int gc = (l == 0 && F.G > SPLIT_GC) ? SPLIT_GC : F.G;
            if ((int)blockIdx.x < gc) {
                DenseOrder S{(const char*)X0, (const char*)(WSP(bf16_t, WS_WIN) + (size_t)l * NZ * D), 64, 22, gc, (int)blockIdx.x, (size_t)256 * D * 2, (size_t)256 * D * 2, (KDUP_MASK >> 0) & 1};
                if (TAIL_FIRST && l == 1 && TAIL_L1A > 0) { int j, n; idle_set(64 * 22, F.G, (int)blockIdx.x, j, n);
                    if (j >= 0) { F.refresh(); conv_tail(F, j, n, 32 * I_UP, TAIL_L1A); __syncthreads(); } }
                { const float* bin = (const float*)(sw + SW_BIN);
                  rs_t rv[5]; float bq[5];
#pragma unroll
                  for (int i = 0; i < 5; ++i) { const int q = F.tid + 512 * i, ui = __builtin_amdgcn_readfirstlane(q >> 8); Unit uu; const bool in = (ui < MAX_UNITS_PER_WG) && S.next(ui, uu);
                      rv[i] = rs0[in ? uu.pm * 256 + (q & 255) : 0]; bq[i] = bin[in ? uu.pn * 256 + (q & 255) : 0]; }
#pragma unroll
                  for (int i = 0; i < 5; ++i) { const int q = F.tid + 512 * i; if (q < MAX_UNITS_PER_WG * 256) { ((LAS float*)(F.lds + LDS_RST))[q] = rstd_of(rv[i]); ((LAS float*)(F.lds + LDS_BIAS))[q] = bq[i]; } } }
                __syncthreads();
                EpiIn E{WSP(bf16_t, WS_ZP), (const LAS float*)(F.lds + LDS_RST), (const LAS float*)(F.lds + LDS_BIAS), WSP(bf16_t, WS_ACT)};
                pg8::gemm_phase(F.lds, D, D, D, S, E);
                if (l == 0 && gc == F.G) { F.refresh(); phase_convert_rest(F, 0); }
                if (!TAIL_FIRST && l == 1 && TAIL_L1A > 0) { int j, n; idle_set(64 * 22, F.G, (int)blockIdx.x, j, n); if (j >= 0) { F.refresh(); conv_tail(F, j, n, 32 * I_UP, TAIL_L1A); } }
            } else phase_convert_rest(F, gc); } SEAM(pb + 0); }
        if (IN(pb + 1)) { REPEAT(pb + 1) { F.refresh(); phase_mix(F, l); } SEAM(pb + 1); }
        if (IN(pb + 2)) { REPEAT(pb + 2) { F.refresh();
            BranchOrder S{(const char*)WSP(bf16_t, WS_Y), (const char*)(WSP(bf16_t, WS_WBR) + (size_t)l * 3 * D * 512), F.G, (int)blockIdx.x};
            EpiBranch E{WSP(bf16_t, WS_ACT), kin(16) + (size_t)l * 3 * D, WSP(bf16_t, WS_MG)};
            pg8::gemm_phase(F.lds, 512, YW, 512, S, E); } SEAM(pb + 2); }
        if (IN(pb + 3)) { F.refresh();
            DenseOrder S{(const char*)WSP(bf16_t, WS_MG), (const char*)(WSP(bf16_t, WS_WOUT) + (size_t)l * D * D), 64, 4, F.G, (int)blockIdx.x, (size_t)256 * D * 2, (size_t)256 * D * 2, 0};
            EpiRes E{X0, X1, rs0 + T};
            pg8::gemm_phase(F.lds, D, D, D, S, E); SEAM(pb + 3); }
        if (IN(pb + 4)) { F.refresh(); phase_router(F, l, X1, rs0 + T); SEAM(pb + 4); }
        if (IN(pb + 5)) { REPEAT(pb + 5) { F.refresh();
            moe_tables(F, l);
            LAS int* tab = (LAS int*)(F.lds + LDS_TAB); const int ntile = tab[MT_NTILE]; const int* TOKL = WSP(int, WS_TOKL);
            auto g4_tail = [&]() { int j, n; idle_set(ntile * 8, F.G, F.vcu, j, n); F.refresh();
              DenseOrder S6{(const char*)(WSP(bf16_t, WS_PB) + (size_t)l * T * PLE), (const char*)(WSP(bf16_t, WS_WPP) + (size_t)l * D * PLE), 64, 4, n, j < 0 ? 256 : j, (size_t)256 * PLE * 2, (size_t)256 * PLE * 2, 0};
              EpiBf E6{WSP(bf16_t, WS_PP), nullptr, nullptr, 0, 1};
              pg8::gemm_phase(F.lds, PLE, PLE, PLE, S6, E6);
              if (l == 0 && TAIL_XF4 > 0 && j >= 0) { F.refresh(); conv_tail(F, j, n, TAIL_XF, TAIL_XF4); }
              if (l == 1 && TAIL_L1B > 0 && j >= 0) { F.refresh(); conv_tail(F, j, n, 32 * I_UP + TAIL_L1A, TAIL_L1B); } };
            bool tail_done = false;
            if (TAIL_FIRST4) { int j, n; idle_set(ntile * 8, F.G, F.vcu, j, n); if (j >= 0 && n < F.G) { g4_tail(); tail_done = true; __syncthreads(); F.refresh(); moe_tables(F, l); } }
            { int tk[5]; bool ok[5]; float bq[5]; rs_t rv[5]; const float* bup = (const float*)(sw + SW_BUP); const rs_t* rsx = rs0 + T;
#pragma unroll
              for (int i = 0; i < 5; ++i) { const int q = F.tid + 512 * i, ui = q >> 8, r = q & 255, L = ui * F.G + F.vcu; const bool in = (q < MAX_UNITS_PER_WG * 256) && (L < ntile * 8);
                  const int tile = in ? (L >> 3) : 0, e = tab[MT_TE + tile], lr = (tile - tab[MT_TSTART + e]) * 256 + r; ok[i] = in && lr < tab[MT_CNT + e];
                  tk[i] = TOKL[e * T + (ok[i] ? lr : 0)]; bq[i] = bup[e * 2048 + (in ? (L & 7) : 0) * 256 + r]; }
#pragma unroll
              for (int i = 0; i < 5; ++i) rv[i] = rsx[ok[i] ? tk[i] : 0];
#pragma unroll
              for (int i = 0; i < 5; ++i) { const int q = F.tid + 512 * i; if (q < MAX_UNITS_PER_WG * 256) { ((LAS unsigned*)tab)[MT_TOKOFF + q] = ok[i] ? (unsigned)tk[i] * (unsigned)(D * 2) : 0u;
                  ((LAS float*)(F.lds + LDS_RST))[q] = rstd_of(rv[i]); ((LAS float*)(F.lds + LDS_BIAS))[q] = bq[i]; } } }
            __syncthreads();
            MoeOrder S{(const char*)X1, (const char*)(WSP(bf16_t, WS_WUP) + (size_t)l * NE * 2048 * D), tab + MT_TE, ntile * 8, 8, F.G, F.vcu, (size_t)2048 * D * 2, (size_t)256 * D * 2, 0, ntile * 8, 1};
            EpiUp E{WSP(bf16_t, WS_ACT), (const LAS float*)(F.lds + LDS_RST), (const LAS float*)(F.lds + LDS_BIAS)};
            pg8::gemm_phase<EpiUp, MoeOrder, true>(F.lds, D, D, D, S, E, (const LAS unsigned*)tab + MT_TOKOFF);
            if (!tail_done) g4_tail();
            } SEAM(pb + 5); }
        if (IN(pb + 6)) { REPEAT(pb + 6) { F.refresh();
            moe_tables(F, l, SPLITK_TAIL && l == NL - 1);
            LAS int* tab = (LAS int*)(F.lds + LDS_TAB); const int ntile = tab[MT_NTILE];
            bool tail5_done = false;
            if (TAIL_FIRST5 && l == 0 && TAIL_XF > 0) { int j, n; idle_set(ntile * 4, F.G, F.vcu, j, n); if (j >= 0 && n < F.G) { F.refresh(); conv_tail(F, j, n, 0, TAIL_XF); tail5_done = true; __syncthreads(); F.refresh(); moe_tables(F, l, SPLITK_TAIL && l == NL - 1); } }
            MoeOrder S{(const char*)WSP(bf16_t, WS_ACT), (const char*)(WSP(bf16_t, WS_WDN) + (size_t)l * NE * D * D), tab + MT_TE, ntile * 4, 4, F.G, F.vcu, (size_t)D * D * 2, (size_t)256 * D * 2, (size_t)256 * D * 2, tab[MT_NFULL], tab[MT_SPLIT]};
            { const float* bdn = kin(24) + (size_t)l * NE * D; float bq[5];
#pragma unroll
              for (int i = 0; i < 5; ++i) { const int q = F.tid + 512 * i, ui = __builtin_amdgcn_readfirstlane(q >> 8); Unit uu; const bool in = (ui < MAX_UNITS_PER_WG) && S.next(ui, uu) && ((uu.aux >> 8) == 0);
                  const float v = bdn[in ? (uu.aux & 255) * 1024 + uu.pn * 256 + (q & 255) : 0]; bq[i] = in ? v : 0.f; }
#pragma unroll
              for (int i = 0; i < 5; ++i) { const int q = F.tid + 512 * i; if (q < MAX_UNITS_PER_WG * 256) ((LAS float*)(F.lds + LDS_BIAS))[q] = bq[i]; } }
            __syncthreads();
            EpiBf E{WSP(bf16_t, WS_YE), (const LAS float*)(F.lds + LDS_BIAS), WSP(bf16_t, WS_YEX), tab[MT_TAILROW]};
            pg8::gemm_phase(F.lds, D, D, D, S, E);
            if (l == 0 && TAIL_XF > 0 && !tail5_done) { int j, n; idle_set(ntile * 4, F.G, F.vcu, j, n); if (j >= 0) { F.refresh(); conv_tail(F, j, n, 0, TAIL_XF); } } } SEAM(pb + 6); }
        if (IN(pb + 7)) { REPEAT(pb + 7) { F.refresh(); phase_combine(F, l, X1, X2, rs0 + 2 * T); } SEAM(pb + 7); }
        if (IN(pb + 8)) { F.refresh();
            DenseOrder S{(const char*)X2, (const char*)(WSP(bf16_t, WS_WPG) + (size_t)l * D * D), 64, 4, F.G, (int)blockIdx.x, (size_t)256 * D * 2, (size_t)256 * D * 2, 0};
            EpiPle E{X2, X0, WSP(bf16_t, WS_PP), rs0 + 2 * T, rs0 + 3 * T};
            pg8::gemm_phase(F.lds, D, D, D, S, E); SEAM(pb + 8); }
    }
    if (IN(N_PHASES - 1)) { F.refresh(); phase_final(F, X0, WSP(rs_t, WS_RS) + (size_t)(3 * NL) * T, F.out, kin(28)); }
#undef REPEAT
#undef IN
#undef SEAM
}

extern "C" void kernel_launch(void* const* d_in, const int* in_sizes, int n_in, void* d_out, int out_size, void* d_ws, size_t ws_size, hipStream_t stream) {
    static int grid = 0;
    if (grid == 0) {
        if (n_in != 29 || out_size != T * D || ws_size < WS_END) { fprintf(stderr, "kernel_launch: unexpected shapes (n_in %d out %d ws %zu)\n", n_in, out_size, ws_size); grid = -1; return; }
        int dev = 0, cus = 0, per_cu = 0;
        hipGetDevice(&dev); hipDeviceGetAttribute(&cus, hipDeviceAttributeMultiprocessorCount, dev);
        if (hipFuncSetAttribute((const void*)mega_fwd, hipFuncAttributeMaxDynamicSharedMemorySize, LDS_BYTES) != hipSuccess) { fprintf(stderr, "kernel_launch: hipFuncSetAttribute failed\n"); grid = -1; return; }
        if (hipOccupancyMaxActiveBlocksPerMultiprocessor(&per_cu, (const void*)mega_fwd, 512, LDS_BYTES) != hipSuccess || per_cu < 1) { fprintf(stderr, "kernel_launch: occupancy query says %d\n", per_cu); per_cu = 1; }
        (void)hipGetLastError();
        grid = cus;
    }
    if (grid < 0) return;
    hipMemsetAsync((char*)d_ws + WS_CTL, 0, CTL_ZERO_BYTES, stream);
    Args a{};
    for (int i = 0; i < 29; ++i) a.in[i] = (const float*)d_in[i];
    a.out = (float*)d_out; a.ws = (unsigned char*)d_ws;
#if MK_N_LAUNCHES == 1
    a.ph_lo = 0; a.ph_hi = N_PHASES; a.use_cg = 0;
    void* kargs[] = {&a};
    hipError_t e = hipLaunchCooperativeKernel((const void*)mega_fwd, dim3(grid), dim3(512), kargs, LDS_BYTES, stream);
    if (e != hipSuccess) fprintf(stderr, "cooperative launch failed: %s (grid %d)\n", hipGetErrorString(e), grid);
#else
    for (int ph = 0; ph < N_PHASES; ++ph) { a.ph_lo = ph; a.ph_hi = ph + 1; a.use_cg = 0;
        hipLaunchKernelGGL(mega_fwd, dim3(grid), dim3(512), LDS_BYTES, stream, a); }
#endif
}
```
